# Optimizing an MI355X kernel written in HIP

```python
import jax
import jax.numpy as jnp
from jax import lax
import numpy as np

D_MODEL = 1024
BATCH = 4
SEQ = 4096
DEPTH = 4

GRID_W = 64
CTX_LEN = 256
N_EVEN = (DEPTH + 1) // 2
N_ODD = DEPTH // 2
EPS = 1e-6
ROPE_BASE = 10000.0

RET_HEADS = 4
RET_DK = 128
RET_DV = 128
RET_CHUNK = 128
RET_QK = RET_HEADS * RET_DK
RET_VW = RET_HEADS * RET_DV
LRU_WIDTH = 512
LRU_BLOCKS = 8
LRU_BLOCK = LRU_WIDTH // LRU_BLOCKS
LRU_CONV = 4
LRU_C = 8.0
AB_SPLITS = (RET_QK, 2 * RET_QK, 2 * RET_QK + RET_VW, 2 * RET_QK + 2 * RET_VW,
             2 * RET_QK + 2 * RET_VW + LRU_WIDTH)
AB_IN = 2 * RET_QK + 2 * RET_VW + 2 * LRU_WIDTH
AB_MIX = RET_VW + LRU_WIDTH
MLA_HEADS = 16
MLA_NOPE = 64
MLA_ROPE = 32
MLA_V = 64
MLA_Q_RANK = 384
MLA_KV_RANK = 256
MLA_IN = MLA_Q_RANK + MLA_KV_RANK + MLA_ROPE
MLA_Q_BLOCK = 128
MLA_SCALE = (MLA_NOPE + MLA_ROPE) ** -0.5
MOE_GROUPS = 4
MOE_PER_GROUP = 8
MOE_EXPERTS = MOE_GROUPS * MOE_PER_GROUP
MOE_TOPK = 2
MOE_HIDDEN = 512
MOE_BLOCK = 128

kernel_name = 'hybrid_retention_rglru_mla_hmoe_dit'


def rmsnorm(x, g):
    xf = x.astype(jnp.float32)
    y = xf * lax.rsqrt(jnp.mean(xf * xf, axis=-1, keepdims=True) + EPS)
    return (y * g.astype(jnp.float32)).astype(x.dtype)


def modulate(h, shift, scale):
    return h * (1.0 + scale) + shift


def rotate(x, cos, sin):
    x1, x2 = jnp.split(x, 2, axis=-1)
    return jnp.concatenate([x1 * cos - x2 * sin, x1 * sin + x2 * cos], axis=-1).astype(x.dtype)


def to_heads(t, d):
    b, n, _ = t.shape
    return t.reshape(b, n, RET_HEADS, d).transpose(0, 2, 1, 3)


def from_heads(t):
    b, h, n, d = t.shape
    return t.transpose(0, 2, 1, 3).reshape(b, n, h * d)


def head_rms(y):
    return y * lax.rsqrt(jnp.mean(y * y, axis=-1, keepdims=True) + EPS)


def retention_dir(q, k, v, log_gamma, state0, want_out):
    b, h, n, dk = q.shape
    dv = v.shape[-1]
    nc = n // RET_CHUNK
    qc = q.reshape(b, h, nc, RET_CHUNK, dk)
    kc = k.reshape(b, h, nc, RET_CHUNK, dk)
    vc = v.reshape(b, h, nc, RET_CHUNK, dv)
    j = jnp.arange(RET_CHUNK, dtype=jnp.float32)
    lg = log_gamma[:, None]
    zeta = jnp.exp(lg * (RET_CHUNK - 1.0 - j))
    u = jnp.einsum('bhncd,bhnce->bhnde', kc, vc * zeta[None, :, None, :, None])
    chunk_decay = jnp.exp(log_gamma * RET_CHUNK)[None, :, None, None]

    def step(s, u_n):
        return chunk_decay * s + u_n, (s if want_out else None)

    s_final, s_in = lax.scan(step, state0, jnp.moveaxis(u, 2, 0))
    if not want_out:
        return None, s_final
    s_in = jnp.moveaxis(s_in, 0, 2)
    xi = jnp.exp(lg * (j + 1.0))
    inter = jnp.einsum('bhncd,bhnde->bhnce', qc, s_in) * xi[None, :, None, :, None]
    diff = j[:, None] - j[None, :]
    dmat = jnp.where(diff >= 0, jnp.exp(log_gamma[:, None, None] * jnp.maximum(diff, 0.0)), 0.0)
    scores = jnp.einsum('bhncd,bhnmd->bhncm', qc, kc) * dmat[None, :, None]
    intra = jnp.einsum('bhncm,bhnme->bhnce', scores, vc)
    return (intra + inter).reshape(b, h, n, dv), s_final


def retention_bidir(q_c, k_c, v_c, q_l, k_l, v_l, decay_logit, want_ctx):
    b, h, _, dk = q_l.shape
    zero = jnp.zeros((b, h, dk, v_l.shape[-1]), jnp.float32)
    out_c, out_l = None, None
    for d in range(2):
        lg = jax.nn.log_sigmoid(decay_logit[d].astype(jnp.float32))
        f = (lambda t: jnp.flip(t, axis=2)) if d == 1 else (lambda t: t)
        oc, s_ctx = retention_dir(f(q_c), f(k_c), f(v_c), lg, zero, want_ctx)
        ol, _ = retention_dir(f(q_l), f(k_l), f(v_l), lg, s_ctx, True)
        out_l = f(ol) if out_l is None else out_l + f(ol)
        if want_ctx:
            out_c = f(oc) if out_c is None else out_c + f(oc)
    return out_c, out_l


def centred_dwconv(x, w, bias):
    kw = w.shape[0]
    n = x.shape[1]
    xp = jnp.pad(x, ((0, 0), (kw // 2, (kw - 1) // 2), (0, 0)))
    y = xp[:, 0:n] * w[0]
    for t in range(1, kw):
        y = y + xp[:, t:t + n] * w[t]
    return y + bias


def rglru_coeffs(x, gate_w, gate_b, lam):
    b, n, w = x.shape
    xb = x.reshape(b, n, LRU_BLOCKS, LRU_BLOCK)
    gates = jnp.einsum('bnki,gkij->gbnkj', xb, gate_w).reshape(2, b, n, w) + gate_b[:, None, None, :]
    r = jax.nn.sigmoid(gates[0])
    i = jax.nn.sigmoid(gates[1])
    log_a = -LRU_C * r * jax.nn.softplus(-lam.astype(jnp.float32))
    a = jnp.exp(log_a)
    bterm = jnp.sqrt(-jnp.expm1(2.0 * log_a)) * (i * x)
    return a, bterm


def linear_scan(a, bterm, h0):
    def comb(left, right):
        return left[0] * right[0], right[0] * left[1] + right[1]
    a_cum, h = lax.associative_scan(comb, (a, bterm), axis=1)
    return h + a_cum * h0[:, None, :]


def rglru_bidir(xc, xl, gate_w, gate_b, lam, want_ctx):
    b, _, w = xl.shape
    zero = jnp.zeros((b, w), jnp.float32)
    out_c, out_l = None, None
    for d in range(2):
        f = (lambda t: jnp.flip(t, axis=1)) if d == 1 else (lambda t: t)
        a, bt = rglru_coeffs(f(xc), gate_w[d], gate_b[d], lam[d])
        h_ctx = linear_scan(a, bt, zero)
        a, bt = rglru_coeffs(f(xl), gate_w[d], gate_b[d], lam[d])
        h_lat = f(linear_scan(a, bt, h_ctx[:, -1]))
        out_l = h_lat if out_l is None else out_l + h_lat
        if want_ctx:
            out_c = f(h_ctx) if out_c is None else out_c + f(h_ctx)
    return out_c, out_l


def ab_mixer(hc, hl, w_in, w_out, decay_logit, conv_w, conv_b, gate_w, gate_b, lam, ret_cs, want_ctx):
    cos, sin = ret_cs
    pc = jnp.split((hc @ w_in).astype(jnp.float32), AB_SPLITS, axis=-1)
    pl = jnp.split((hl @ w_in).astype(jnp.float32), AB_SPLITS, axis=-1)
    k_scale = RET_DK ** -0.5
    q_c = to_heads(pc[0], RET_DK)
    k_c = to_heads(pc[1], RET_DK) * k_scale
    v_c = to_heads(pc[2], RET_DV)
    q_l = rotate(to_heads(pl[0], RET_DK), cos, sin)
    k_l = rotate(to_heads(pl[1], RET_DK), cos, sin) * k_scale
    v_l = to_heads(pl[2], RET_DV)
    rc, rl = retention_bidir(q_c, k_c, v_c, q_l, k_l, v_l, decay_logit, want_ctx)
    uc = centred_dwconv(pc[4], conv_w, conv_b)
    ul = centred_dwconv(pl[4], conv_w, conv_b)
    lc, ll = rglru_bidir(uc, ul, gate_w, gate_b, lam, want_ctx)

    def merge(r, g, hrec, y, dtype):
        ret = from_heads(head_rms(r)) * jax.nn.silu(g)
        rec = hrec * jax.nn.gelu(y)
        return (jnp.concatenate([ret, rec], axis=-1) @ w_out).astype(dtype)

    ol = merge(rl, pl[3], ll, pl[5], hl.dtype)
    oc = merge(rc, pc[3], lc, pc[5], hc.dtype) if want_ctx else None
    return oc, ol


def mla_project(h, w_in, q_g, kv_g, w_uq, w_ukv, cs):
    b, n, _ = h.shape
    p = h @ w_in
    cq, ckv, kr = jnp.split(p, [MLA_Q_RANK, MLA_Q_RANK + MLA_KV_RANK], axis=-1)
    q = (rmsnorm(cq, q_g) @ w_uq).reshape(b, n, MLA_HEADS, MLA_NOPE + MLA_ROPE)
    kv = (rmsnorm(ckv, kv_g) @ w_ukv).reshape(b, n, MLA_HEADS, MLA_NOPE + MLA_V)
    q_nope, q_rope = jnp.split(q, [MLA_NOPE], axis=-1)
    k_nope, v = jnp.split(kv, [MLA_NOPE], axis=-1)
    if cs is not None:
        cos, sin = cs
        q_rope = rotate(q_rope, cos[:, None, :], sin[:, None, :])
        kr = rotate(kr, cos, sin)
    k = jnp.concatenate([k_nope, jnp.broadcast_to(kr[:, :, None, :], (b, n, MLA_HEADS, MLA_ROPE))], axis=-1)
    q = jnp.concatenate([q_nope, q_rope], axis=-1)
    return q.astype(jnp.float32), k.astype(jnp.float32), v.astype(jnp.float32)


def attend(q, k, v):
    s = jnp.einsum('bqhd,bkhd->bhqk', q, k) * MLA_SCALE
    p = jax.nn.softmax(s, axis=-1)
    return jnp.einsum('bhqk,bkhd->bqhd', p, v)


def mla_mixer(hc, hl, w_in, q_g, kv_g, w_uq, w_ukv, w_out, mla_cs, want_ctx):
    qc, kc, vc = mla_project(hc, w_in, q_g, kv_g, w_uq, w_ukv, None)
    ql, kl, vl = mla_project(hl, w_in, q_g, kv_g, w_uq, w_ukv, mla_cs)
    b, n = hl.shape[:2]
    k_all = jnp.concatenate([kc, kl], axis=1)
    v_all = jnp.concatenate([vc, vl], axis=1)
    nqb = n // MLA_Q_BLOCK
    qb = ql.reshape(b, nqb, MLA_Q_BLOCK, MLA_HEADS, MLA_NOPE + MLA_ROPE).transpose(1, 0, 2, 3, 4)
    ob = lax.map(lambda qq: attend(qq, k_all, v_all), qb)
    ol = (ob.transpose(1, 0, 2, 3, 4).reshape(b, n, MLA_HEADS * MLA_V) @ w_out).astype(hl.dtype)
    if not want_ctx:
        return None, ol
    oc = (attend(qc, kc, vc).reshape(b, hc.shape[1], MLA_HEADS * MLA_V) @ w_out).astype(hc.dtype)
    return oc, ol


def hier_moe(h, group_w, group_b, expert_w, expert_b, w_gate, w_up, w_down):
    t_count, d = h.shape
    hf = h.astype(jnp.float32)
    group_p = jax.nn.softmax(hf @ group_w + group_b, axis=-1)
    g_top, g_sel = lax.top_k(group_p, 1)
    e_logits = (hf @ expert_w + expert_b).reshape(t_count, MOE_GROUPS, MOE_PER_GROUP)
    within = jnp.take_along_axis(e_logits, g_sel[:, :, None], axis=1)[:, 0]
    e_p = jax.nn.softmax(within, axis=-1)
    top_p, top_i = lax.top_k(e_p, MOE_TOPK)
    top_p = top_p / jnp.sum(top_p, axis=-1, keepdims=True)
    weights = (g_top * top_p).reshape(-1)
    e_flat = (g_sel * MOE_PER_GROUP + top_i).reshape(-1)
    tok = jnp.repeat(jnp.arange(t_count, dtype=jnp.int32), MOE_TOPK)
    n_assign = t_count * MOE_TOPK
    order = jnp.argsort(e_flat)
    e_sorted = e_flat[order]
    counts = jnp.zeros((MOE_EXPERTS,), jnp.int32).at[e_flat].add(1)
    padded = (counts + MOE_BLOCK - 1) // MOE_BLOCK * MOE_BLOCK
    start = jnp.cumsum(counts) - counts
    pend = jnp.cumsum(padded)
    pstart = pend - padded
    dest = pstart[e_sorted] + (jnp.arange(n_assign, dtype=jnp.int32) - start[e_sorted])
    n_rows = (n_assign + MOE_EXPERTS * (MOE_BLOCK - 1) + MOE_BLOCK - 1) // MOE_BLOCK * MOE_BLOCK
    n_blocks = n_rows // MOE_BLOCK
    row_tok = jnp.zeros((n_rows,), jnp.int32).at[dest].set(tok[order])
    row_w = jnp.zeros((n_rows,), jnp.float32).at[dest].set(weights[order])
    block_e = jnp.minimum(jnp.searchsorted(pend, jnp.arange(n_blocks, dtype=jnp.int32) * MOE_BLOCK,
                                           side='right'), MOE_EXPERTS - 1)
    xin = h[row_tok].reshape(n_blocks, MOE_BLOCK, d)

    def expert_block(args):
        xb, e = args
        return (jax.nn.silu(xb @ w_gate[e]) * (xb @ w_up[e])) @ w_down[e]

    yb = lax.map(expert_block, (xin, block_e)).reshape(n_rows, d)
    y = jnp.zeros((t_count, d), jnp.float32).at[row_tok].add(yb * row_w[:, None])
    return y.astype(h.dtype)


def setup_inputs(seed: int = 0) -> dict:
    key = jax.random.key(seed)
    keys = iter(jax.random.split(key, 40))

    def nrm(shape, scale):
        return jax.random.normal(next(keys), shape, jnp.float32) * scale

    dm = D_MODEL
    decay_base = jnp.asarray(np.log(2.0 ** (5 + np.arange(RET_HEADS)) - 1.0), jnp.float32)
    a_init = jax.random.uniform(next(keys), (N_EVEN, 2, LRU_WIDTH), jnp.float32, 0.9, 0.999) ** (1.0 / LRU_C)
    return {
        'x': nrm((BATCH, SEQ, dm), 1.0),
        'c': nrm((BATCH, dm), 1.0),
        'ctx': nrm((BATCH, CTX_LEN, dm), 1.0),
        'c_ctx': nrm((dm,), 1.0),
        'ada_w': nrm((DEPTH, dm, 6 * dm), 0.5 * dm ** -0.5),
        'ada_b': nrm((DEPTH, 6 * dm), 0.01),
        'norm_g': 1.0 + nrm((DEPTH, 2, dm), 0.02),
        'ab_w_in': nrm((N_EVEN, dm, AB_IN), dm ** -0.5),
        'ab_w_out': nrm((N_EVEN, AB_MIX, dm), AB_MIX ** -0.5),
        'ret_decay_logit': decay_base + nrm((N_EVEN, 2, RET_HEADS), 0.1),
        'lru_conv_w': nrm((N_EVEN, LRU_CONV, LRU_WIDTH), LRU_CONV ** -0.5),
        'lru_conv_b': nrm((N_EVEN, LRU_WIDTH), 0.01),
        'lru_gate_w': nrm((N_EVEN, 2, 2, LRU_BLOCKS, LRU_BLOCK, LRU_BLOCK), LRU_BLOCK ** -0.5),
        'lru_gate_b': nrm((N_EVEN, 2, 2, LRU_WIDTH), 0.01),
        'lru_lambda': jnp.log(a_init) - jnp.log1p(-a_init),
        'mla_w_in': nrm((N_ODD, dm, MLA_IN), dm ** -0.5),
        'mla_q_norm_g': 1.0 + nrm((N_ODD, MLA_Q_RANK), 0.02),
        'mla_kv_norm_g': 1.0 + nrm((N_ODD, MLA_KV_RANK), 0.02),
        'mla_w_uq': nrm((N_ODD, MLA_Q_RANK, MLA_HEADS * (MLA_NOPE + MLA_ROPE)), MLA_Q_RANK ** -0.5),
        'mla_w_ukv': nrm((N_ODD, MLA_KV_RANK, MLA_HEADS * (MLA_NOPE + MLA_V)), MLA_KV_RANK ** -0.5),
        'mla_w_out': nrm((N_ODD, MLA_HEADS * MLA_V, dm), (MLA_HEADS * MLA_V) ** -0.5),
        'moe_group_w': nrm((DEPTH, dm, MOE_GROUPS), dm ** -0.5),
        'moe_group_b': nrm((DEPTH, MOE_GROUPS), 0.01),
        'moe_expert_w': nrm((DEPTH, dm, MOE_EXPERTS), dm ** -0.5),
        'moe_expert_b': nrm((DEPTH, MOE_EXPERTS), 0.01),
        'moe_w_gate': nrm((DEPTH, MOE_EXPERTS, dm, MOE_HIDDEN), dm ** -0.5),
        'moe_w_up': nrm((DEPTH, MOE_EXPERTS, dm, MOE_HIDDEN), dm ** -0.5),
        'moe_w_down': nrm((DEPTH, MOE_EXPERTS, MOE_HIDDEN, dm), MOE_HIDDEN ** -0.5),
        'final_norm_g': 1.0 + nrm((dm,), 0.02),
    }


def reference(x, c, ctx, c_ctx, ada_w, ada_b, norm_g, ab_w_in, ab_w_out, ret_decay_logit,
              lru_conv_w, lru_conv_b, lru_gate_w, lru_gate_b, lru_lambda, mla_w_in, mla_q_norm_g,
              mla_kv_norm_g, mla_w_uq, mla_w_ukv, mla_w_out, moe_group_w, moe_group_b, moe_expert_w,
              moe_expert_b, moe_w_gate, moe_w_up, moe_w_down, final_norm_g):
    b, n, _ = x.shape
    ctx_len = ctx.shape[1]
    rows = n // GRID_W
    t = jnp.arange(n, dtype=jnp.float32)
    inv1 = ROPE_BASE ** (-jnp.arange(0, RET_DK, 2, dtype=jnp.float32) / RET_DK)
    ang1 = t[:, None] * inv1[None, :]
    ret_cs = (jnp.cos(ang1), jnp.sin(ang1))
    r_pos = jnp.repeat(jnp.arange(rows, dtype=jnp.float32), GRID_W)
    c_pos = jnp.tile(jnp.arange(GRID_W, dtype=jnp.float32), rows)
    ax_dim = MLA_ROPE // 2
    inv2 = ROPE_BASE ** (-jnp.arange(0, ax_dim, 2, dtype=jnp.float32) / ax_dim)
    ang2 = jnp.concatenate([r_pos[:, None] * inv2[None, :], c_pos[:, None] * inv2[None, :]], axis=-1)
    mla_cs = (jnp.cos(ang2), jnp.sin(ang2))

    xl, xc = x, ctx
    s_lat = jax.nn.silu(c)
    s_ctx = jax.nn.silu(c_ctx)
    for layer in range(DEPTH):
        want_ctx = layer != DEPTH - 1
        mod_l = jnp.split((s_lat @ ada_w[layer] + ada_b[layer])[:, None, :], 6, axis=-1)
        mod_c = jnp.split((s_ctx @ ada_w[layer] + ada_b[layer])[None, None, :], 6, axis=-1)
        hl = modulate(rmsnorm(xl, norm_g[layer, 0]), mod_l[0], mod_l[1])
        hc = modulate(rmsnorm(xc, norm_g[layer, 0]), mod_c[0], mod_c[1])
        i = layer // 2
        if layer % 2 == 0:
            oc, ol = ab_mixer(hc, hl, ab_w_in[i], ab_w_out[i], ret_decay_logit[i], lru_conv_w[i],
                              lru_conv_b[i], lru_gate_w[i], lru_gate_b[i], lru_lambda[i], ret_cs, want_ctx)
        else:
            oc, ol = mla_mixer(hc, hl, mla_w_in[i], mla_q_norm_g[i], mla_kv_norm_g[i], mla_w_uq[i],
                               mla_w_ukv[i], mla_w_out[i], mla_cs, want_ctx)
        xl = xl + mod_l[2] * ol
        hl = modulate(rmsnorm(xl, norm_g[layer, 1]), mod_l[3], mod_l[4])
        moe_params = (moe_group_w[layer], moe_group_b[layer], moe_expert_w[layer], moe_expert_b[layer],
                      moe_w_gate[layer], moe_w_up[layer], moe_w_down[layer])
        if want_ctx:
            xc = xc + mod_c[2] * oc
            hc = modulate(rmsnorm(xc, norm_g[layer, 1]), mod_c[3], mod_c[4])
            tokens = jnp.concatenate([hc.reshape(b * ctx_len, -1), hl.reshape(b * n, -1)], axis=0)
            y = hier_moe(tokens, *moe_params)
            xc = xc + mod_c[5] * y[:b * ctx_len].reshape(b, ctx_len, -1)
            xl = xl + mod_l[5] * y[b * ctx_len:].reshape(b, n, -1)
        else:
            y = hier_moe(hl.reshape(b * n, -1), *moe_params)
            xl = xl + mod_l[5] * y.reshape(b, n, -1)
    return rmsnorm(xl, final_norm_g)
```

```cpp
#include <hip/hip_runtime.h>
#include <hip/hip_bf16.h>
#include <stdint.h>
#include <stdio.h>
#include <string.h>

#ifndef EXACT
#define EXACT 0
#endif
#ifndef ENGINE
#define ENGINE 1
#endif
#ifndef PHMASK
#define PHMASK 0x3ffff
#endif
#ifndef E1_FAST
#define E1_FAST 2
#endif
#ifndef MEGA
#define MEGA 1
#endif

constexpr int DM = 1024, NBAT = 4, SEQ = 4096, CTXL = 256, NLAY = 4;
constexpr int NCTX = NBAT * CTXL;
constexpr int NTOK = NCTX + NBAT * SEQ;
constexpr int NRT = NTOK / 128;
constexpr int NCH = 34;
constexpr int KVL = CTXL + SEQ;
constexpr float EPSF = 1e-6f;
constexpr int ST_LD = 132;
constexpr int P1LD = 768;
constexpr int QLD = 1536;
constexpr size_t WB_ABIN = 0, WB_ABOUT = WB_ABIN + 2ull * 1024 * 3072, WB_MIN = WB_ABOUT + 2ull * 1024 * 1024, WB_UQ = WB_MIN + 2ull * 1024 * 672,
                 WB_UKV = WB_UQ + 2ull * 384 * 1536, WB_MOUT = WB_UKV + 2ull * 256 * 2048, WB_TOTAL = WB_MOUT + 2ull * 1024 * 1024;
#if EXACT
#define KSCALE 0.08838834764831845f
#else
#define KSCALE 1.0f
#endif

#if EXACT
typedef float AT;
__device__ __forceinline__ float ldA(const AT* p) { return *p; }
__device__ __forceinline__ void stA(AT* p, float v) { *p = v; }
#else
typedef __hip_bfloat16 AT;
__device__ __forceinline__ float ldA(const AT* p) { return __bfloat162float(*p); }
__device__ __forceinline__ void stA(AT* p, float v) { *p = __float2bfloat16(v); }
#endif

struct Params {
  const float *x, *c, *ctx, *c_ctx, *ada_w, *ada_b, *norm_g, *ab_w_in, *ab_w_out, *ret_decay,
      *conv_w, *conv_b, *gate_w, *gate_b, *lam, *mla_w_in, *q_g, *kv_g, *w_uq, *w_ukv, *mla_w_out,
      *grp_w, *grp_b, *exp_w, *exp_b, *w_gate, *w_up, *w_down, *final_g;
  float* out;
  unsigned* bar; int* cnt;
  float *mod, *modp, *cs1c, *cs1s, *cs2c, *cs2s, *X;
  AT *H, *PROJ, *MIX;
  float *U, *HL, *AC, *CHA, *CHH, *CAR, *SCR;
  int* re; float* rw; int* list;
  AT *HB, *Y, *HU;
  float *RQ, *RKV;
  AT *Ql, *Qc, *Kb, *Vb, *Vt, *KR;
  AT* WB;
  AT* WM;
  AT* SB;
  float* SSQ;
  unsigned short* WR;
};

__device__ __forceinline__ int tidx() { int t = __builtin_amdgcn_workitem_id_x(); asm volatile("" : "+v"(t)); return t; }
__device__ __forceinline__ float silu_f(float x) { return x / (1.f + expf(-x)); }
__device__ __forceinline__ float sigmoid_f(float x) { return 1.f / (1.f + expf(-x)); }
__device__ __forceinline__ float gelu_tanh(float x) {
  float u = 0.7978845608028654f * (x + 0.044715f * x * x * x);
  return 0.5f * x * (1.f + tanhf(u));
}
__device__ __forceinline__ float silu_fast(float x) { return x * __builtin_amdgcn_rcpf(1.f + __builtin_amdgcn_exp2f(-1.4426950408889634f * x)); }
__device__ __forceinline__ float gelu_tanh_fast(float x) {
  float u = 0.7978845608028654f * (x + 0.044715f * x * x * x);
  return x * __builtin_amdgcn_rcpf(1.f + __builtin_amdgcn_exp2f(-2.f * 1.4426950408889634f * u));
}
__device__ __forceinline__ float softplus_f(float x) { return x > 20.f ? x : log1pf(expf(x)); }
__device__ __forceinline__ float wave_sum(float v) {
#pragma unroll
  for (int o = 32; o > 0; o >>= 1) v += __shfl_xor(v, o);
  return v;
}
__device__ __forceinline__ float wave_max(float v) {
#pragma unroll
  for (int o = 32; o > 0; o >>= 1) v = fmaxf(v, __shfl_xor(v, o));
  return v;
}
__device__ __forceinline__ float half_sum(float v) {
#pragma unroll
  for (int o = 16; o > 0; o >>= 1) v += __shfl_xor(v, o);
  return v;
}
__device__ __forceinline__ int tok_modrow(int tok) { return tok < NCTX ? 4 : ((tok - NCTX) >> 12); }
__device__ __forceinline__ int chunk_tok0(int b, int c) { return c < 2 ? b * CTXL + c * 128 : NCTX + b * SEQ + (c - 2) * 128; }
__device__ __forceinline__ void rt_to_bc(int rt, int& b, int& c) {
  if (rt < 8) { b = rt >> 1; c = rt & 1; } else { int r = rt - 8; b = r >> 5; c = 2 + (r & 31); }
}
__device__ __forceinline__ void sincos_acc(float ang, float& s, float& c) {
  double a = (double)ang;
  double q = rint(a * 0.6366197723675814);
  double r = a - q * 1.5707963267948966 - q * 6.123233995736766e-17;
  int qi = ((int)q) & 3;
  double r2 = r * r;
  double sn = r * (1.0 + r2 * (-1.0 / 6 + r2 * (1.0 / 120 + r2 * (-1.0 / 5040 + r2 * (1.0 / 362880 + r2 * (-1.0 / 39916800 + r2 * (1.0 / 6227020800.0)))))));
  double cn = 1.0 + r2 * (-0.5 + r2 * (1.0 / 24 + r2 * (-1.0 / 720 + r2 * (1.0 / 40320 + r2 * (-1.0 / 3628800 + r2 * (1.0 / 479001600 + r2 * (-1.0 / 87178291200.0)))))));
  double ss, cc;
  if (qi == 0) { ss = sn; cc = cn; } else if (qi == 1) { ss = cn; cc = -sn; } else if (qi == 2) { ss = -sn; cc = -cn; } else { ss = -cn; cc = sn; }
  s = (float)ss; c = (float)cc;
}

#define XB_TMO      128
#define XB_XCNT(j)  (256  + 64 * (j))
#define XB_XSUB(j)  (1280 + 64 * (j))
#define XB_XGEN(j)  (2304 + 64 * (j))
#define XB_TOP      3328
#define XB_TOPGEN   3392
#define XCD_BAR_WORDS 3456
#define XB_SPIN_CAP (1u << 22)
#define LAS __attribute__((address_space(3)))
__device__ __forceinline__ unsigned xb_ld(unsigned* p) { return __hip_atomic_load(p, __ATOMIC_RELAXED, __HIP_MEMORY_SCOPE_AGENT); }
__device__ __forceinline__ unsigned xb_add(unsigned* p, unsigned v) { return __hip_atomic_fetch_add(p, v, __ATOMIC_RELAXED, __HIP_MEMORY_SCOPE_AGENT); }
__device__ __forceinline__ unsigned xb_xcc_id() { return (unsigned)__builtin_amdgcn_s_getreg((3 << 11) | 20) & 0xFu; }
#define XB_SPIN(cond, bar) do { unsigned _sp = 0; while (cond) { __builtin_amdgcn_s_sleep(1); \
    if ((++_sp & 255u) == 0u) { if (xb_ld(&(bar)[XB_TMO])) break; if (_sp > XB_SPIN_CAP) { atomicAdd(&(bar)[XB_TMO], 1u); break; } } } } while (0)
struct XcdBarrier { unsigned* bar; unsigned x; volatile LAS unsigned* st; };
__device__ __forceinline__ XcdBarrier xcd_barrier_post(unsigned* bar, volatile LAS unsigned* st) {
  XcdBarrier b; b.bar = bar; b.x = xb_xcc_id(); b.st = st;
  if (tidx() == 0) (void)xb_add(&bar[XB_XCNT(b.x)], 1u);
  return b;
}
__device__ __forceinline__ void xcd_barrier_complete(unsigned* bar, unsigned x, unsigned& nloc, unsigned& nx) {
  const unsigned G = gridDim.x * gridDim.y * gridDim.z;
  unsigned sum, cnt, mine, sp = 0u;
  for (;;) {
    sum = 0u; cnt = 0u; mine = 0u;
#pragma unroll
    for (unsigned j = 0; j < 16; ++j) { const unsigned c = xb_ld(&bar[XB_XCNT(j)]); sum += c; cnt += (c > 0u) ? 1u : 0u; mine = (j == x) ? c : mine; }
    if (sum == G) break;
    __builtin_amdgcn_s_sleep(1);
    if ((++sp & 255u) == 0u) { if (xb_ld(&bar[XB_TMO])) break; if (sp > XB_SPIN_CAP) { atomicAdd(&bar[XB_TMO], 1u); break; } }
  }
  nloc = mine > 0u ? mine : 1u; nx = cnt > 0u ? cnt : 1u;
}
__device__ __forceinline__ void xcd_barrier(const XcdBarrier& b) {
  asm volatile("s_waitcnt vmcnt(0)" ::: "memory");
  __syncthreads();
  if (tidx() == 0) {
    unsigned* bar = b.bar;
    unsigned bx = b.x;
    asm volatile("" : "+s"(bar), "+s"(bx));
    __builtin_amdgcn_s_waitcnt(0);
    unsigned nloc = b.st[0], nx = b.st[1];
    if (nloc == 0u) { xcd_barrier_complete(bar, bx, nloc, nx); b.st[0] = nloc; b.st[1] = nx; }
    const unsigned old = xb_add(&bar[XB_XSUB(bx)], 1u);
    const unsigned gen = old / nloc;
    if (old + 1u == (gen + 1u) * nloc) {
      __builtin_amdgcn_fence(__ATOMIC_RELEASE, "agent");
      asm volatile("s_waitcnt vmcnt(0)" ::: "memory");
      const unsigned og = xb_add(&bar[XB_TOP], 1u);
      const unsigned tg = og / nx;
      if (og + 1u == (tg + 1u) * nx) xb_add(&bar[XB_TOPGEN], 1u);
      else XB_SPIN(xb_ld(&bar[XB_TOPGEN]) == tg, bar);
      __builtin_amdgcn_fence(__ATOMIC_ACQUIRE, "agent");
      xb_add(&bar[XB_XGEN(bx)], 1u);
      asm volatile("s_waitcnt vmcnt(0)" ::: "memory");
    } else {
      XB_SPIN(xb_ld(&bar[XB_XGEN(bx)]) == gen, bar);
      __builtin_amdgcn_fence(__ATOMIC_ACQUIRE, "agent");
      asm volatile("s_waitcnt vmcnt(0)" ::: "memory");
    }
  }
  __syncthreads();
}

constexpr int STAGE_BYTES = 128 * ST_LD * 4;
#if ENGINE == 0
constexpr int OPS_OFF = STAGE_BYTES;
#else
constexpr int OPS_OFF = 0;
#endif
#if EXACT
constexpr int MISC_OFF = STAGE_BYTES + 2 * 32 * ST_LD * 4;
#define LB2
#else
constexpr int MISC_OFF = STAGE_BYTES;
#define LB2 , 2
#endif
constexpr int LDS_BYTES = MISC_OFF + 512 + 1024;

#if ENGINE == 0
template <class FA, class FB>
__device__ __forceinline__ void engine(char* lds, int K, FA fa, FB fb) {
  float* stage = (float*)lds;
  float* As = (float*)(lds + OPS_OFF);
  float* Bs = As + 32 * ST_LD;
  const int tid = tidx(), ty = tid >> 4, tx = tid & 15;
  float acc[8][8];
#pragma unroll
  for (int i = 0; i < 8; ++i)
#pragma unroll
    for (int j = 0; j < 8; ++j) acc[i][j] = 0.f;
  __syncthreads();
  for (int k0 = 0; k0 < K; k0 += 32) {
    for (int e = tid; e < 4096; e += 256) { int r = e >> 5, kk = e & 31; As[kk * ST_LD + r] = fa(r, k0 + kk); }
    for (int e = tid; e < 4096; e += 256) { int kk = e >> 7, c = e & 127; Bs[kk * ST_LD + c] = fb(k0 + kk, c); }
    __syncthreads();
#pragma unroll 4
    for (int kk = 0; kk < 32; ++kk) {
      float4 a0 = *(const float4*)(As + kk * ST_LD + ty * 4), a1 = *(const float4*)(As + kk * ST_LD + 64 + ty * 4);
      float4 b0 = *(const float4*)(Bs + kk * ST_LD + tx * 4), b1 = *(const float4*)(Bs + kk * ST_LD + 64 + tx * 4);
      float a[8] = {a0.x, a0.y, a0.z, a0.w, a1.x, a1.y, a1.z, a1.w};
      float b[8] = {b0.x, b0.y, b0.z, b0.w, b1.x, b1.y, b1.z, b1.w};
#pragma unroll
      for (int i = 0; i < 8; ++i)
#pragma unroll
        for (int j = 0; j < 8; ++j) acc[i][j] = fmaf(a[i], b[j], acc[i][j]);
    }
    __syncthreads();
  }
#pragma unroll
  for (int i = 0; i < 8; ++i) {
    int row = (i < 4) ? ty * 4 + i : 64 + ty * 4 + (i - 4);
    *(float4*)(stage + row * ST_LD + tx * 4) = make_float4(acc[i][0], acc[i][1], acc[i][2], acc[i][3]);
    *(float4*)(stage + row * ST_LD + 64 + tx * 4) = make_float4(acc[i][4], acc[i][5], acc[i][6], acc[i][7]);
  }
  __syncthreads();
}
#else
using bf16x8 = __attribute__((ext_vector_type(8))) short;
using f32x4 = __attribute__((ext_vector_type(4))) float;
__device__ __forceinline__ int lrow_off(int row, int k) {
  return row * 32 + ((((k >> 3) ^ ((-(row >> 2)) & 3))) << 3) + (k & 7);
}
template <class FA, class FB>
__device__ __forceinline__ void engine(char* lds, int K, FA fa, FB fb) {
  float* stage = (float*)lds;
  __hip_bfloat16* Ab = (__hip_bfloat16*)(lds + OPS_OFF);
  __hip_bfloat16* Bb = Ab + 128 * 32;
  const int tid = tidx(), lane = tid & 63, wid = tid >> 6, wr = wid >> 1, wc = wid & 1, fr = lane & 15, fq = lane >> 4;
  f32x4 acc[4][4];
#pragma unroll
  for (int m = 0; m < 4; ++m)
#pragma unroll
    for (int n = 0; n < 4; ++n) acc[m][n] = (f32x4){0.f, 0.f, 0.f, 0.f};
  __syncthreads();
  for (int k0 = 0; k0 < K; k0 += 32) {
    for (int e = tid; e < 4096; e += 256) { int r = e >> 5, kk = e & 31; Ab[lrow_off(r, kk)] = __float2bfloat16(fa(r, k0 + kk)); }
    for (int e = tid; e < 4096; e += 256) { int kk = e >> 7, c = e & 127; Bb[lrow_off(c, kk)] = __float2bfloat16(fb(k0 + kk, c)); }
    __syncthreads();
    bf16x8 af[4], bfr[4];
#pragma unroll
    for (int m = 0; m < 4; ++m) af[m] = *(const bf16x8*)(Ab + lrow_off(wr * 64 + m * 16 + fr, fq * 8));
#pragma unroll
    for (int n = 0; n < 4; ++n) bfr[n] = *(const bf16x8*)(Bb + lrow_off(wc * 64 + n * 16 + fr, fq * 8));
#pragma unroll
    for (int m = 0; m < 4; ++m)
#pragma unroll
      for (int n = 0; n < 4; ++n) acc[m][n] = __builtin_amdgcn_mfma_f32_16x16x32_bf16(af[m], bfr[n], acc[m][n], 0, 0, 0);
    __syncthreads();
  }
#pragma unroll
  for (int m = 0; m < 4; ++m)
#pragma unroll
    for (int n = 0; n < 4; ++n)
#pragma unroll
      for (int j = 0; j < 4; ++j) stage[(wr * 64 + m * 16 + fq * 4 + j) * ST_LD + wc * 64 + n * 16 + fr] = acc[m][n][j];
  __syncthreads();
}
#endif


#if !EXACT
typedef __attribute__((ext_vector_type(2))) __bf16 bf2_t;
typedef __attribute__((ext_vector_type(2))) float f2_t;
__device__ __forceinline__ unsigned pk2(float a, float b) { f2_t f = {a, b}; bf2_t r = __builtin_convertvector(f, bf2_t); return *(unsigned*)&r; }
__device__ __forceinline__ float bf_lo(unsigned u) { return __uint_as_float(u << 16); }
__device__ __forceinline__ float bf_hi(unsigned u) { return __uint_as_float(u & 0xffff0000u); }
__device__ __forceinline__ int row_off(int r, int c) { return r * 64 + ((c ^ ((-(r >> 2)) & 3)) << 4); }
__device__ __forceinline__ int col_perm(int n) { return (n & ~31) | ((n >> 2) & 3) | ((((n >> 4) ^ n) & 1) << 2) | (((n >> 1) & 1) << 3) | ((n & 1) << 4); }
__device__ __forceinline__ int col_off(int n, int c) { return (c * 128 + col_perm(n)) * 16; }

typedef unsigned u32x4 __attribute__((ext_vector_type(4)));
typedef unsigned u32x2 __attribute__((ext_vector_type(2)));
typedef float fx4 __attribute__((ext_vector_type(4)));
template <bool CHK>
struct LdRow {
  static constexpr bool COL = false;
  const __hip_bfloat16 *p0, *p1; u32x4 v0[2], v1[2]; int o0;
  template <class RP> __device__ __forceinline__ void init(RP rp) {
    int ch = tidx() & 3, r0 = tidx() >> 2;
    const __hip_bfloat16* a = rp(r0); const __hip_bfloat16* b = rp(r0 + 64);
    p0 = a ? a + ch * 8 : nullptr; p1 = b ? b + ch * 8 : nullptr;
    o0 = row_off(r0, ch);
  }
  template <int S> __device__ __forceinline__ void fetch(int kt) {
    const u32x4 z = {0u, 0u, 0u, 0u};
    if (CHK) {
      v0[S] = z; v1[S] = z;
      if (p0) v0[S] = *(const u32x4*)(p0 + kt * 32);
      if (p1) v1[S] = *(const u32x4*)(p1 + kt * 32);
    } else { v0[S] = *(const u32x4*)(p0 + kt * 32); v1[S] = *(const u32x4*)(p1 + kt * 32); }
  }
  template <int S> __device__ __forceinline__ void commit(char* buf, int) { *(u32x4*)(buf + o0) = v0[S]; *(u32x4*)(buf + o0 + 4096) = v1[S]; }
};
__device__ __forceinline__ u32x4 scale8(u32x4 v, float s) {
  u32x4 r;
  r.x = pk2(bf_lo(v.x) * s, bf_hi(v.x) * s); r.y = pk2(bf_lo(v.y) * s, bf_hi(v.y) * s);
  r.z = pk2(bf_lo(v.z) * s, bf_hi(v.z) * s); r.w = pk2(bf_lo(v.w) * s, bf_hi(v.w) * s);
  return r;
}
struct LdRowS {
  static constexpr bool COL = false;
  const __hip_bfloat16 *p0, *p1; u32x4 v0[2], v1[2]; int o0; float s0, s1;
  template <class RP, class SC> __device__ __forceinline__ void init(RP rp, SC sc) {
    int ch = tidx() & 3, r0 = tidx() >> 2;
    p0 = rp(r0) + ch * 8; p1 = rp(r0 + 64) + ch * 8; s0 = sc(r0); s1 = sc(r0 + 64);
    o0 = row_off(r0, ch);
  }
  template <int S> __device__ __forceinline__ void fetch(int kt) { v0[S] = *(const u32x4*)(p0 + kt * 32); v1[S] = *(const u32x4*)(p1 + kt * 32); }
  template <int S> __device__ __forceinline__ void commit(char* buf, int) { *(u32x4*)(buf + o0) = scale8(v0[S], s0); *(u32x4*)(buf + o0 + 4096) = scale8(v1[S], s1); }
};
__device__ __forceinline__ unsigned silu_mul2(unsigned g, unsigned u) {
  float g0 = bf_lo(g), g1 = bf_hi(g), u0 = bf_lo(u), u1 = bf_hi(u);
  return pk2(g0 / (1.f + __expf(-g0)) * u0, g1 / (1.f + __expf(-g1)) * u1);
}
struct LdRowGU {
  static constexpr bool COL = false;
  const __hip_bfloat16 *p0, *p1; u32x4 g0[2], g1[2], u0[2], u1[2]; int o0; ptrdiff_t du;
  template <class RP> __device__ __forceinline__ void init(RP rp, ptrdiff_t du_) {
    int ch = tidx() & 3, r0 = tidx() >> 2;
    const __hip_bfloat16* a = rp(r0); const __hip_bfloat16* b = rp(r0 + 64);
    p0 = a ? a + ch * 8 : nullptr; p1 = b ? b + ch * 8 : nullptr; du = du_;
    o0 = row_off(r0, ch);
  }
  template <int S> __device__ __forceinline__ void fetch(int kt) {
    const u32x4 z = {0u, 0u, 0u, 0u};
    g0[S] = z; g1[S] = z; u0[S] = z; u1[S] = z;
    if (p0) { g0[S] = *(const u32x4*)(p0 + kt * 32); u0[S] = *(const u32x4*)(p0 + du + kt * 32); }
    if (p1) { g1[S] = *(const u32x4*)(p1 + kt * 32); u1[S] = *(const u32x4*)(p1 + du + kt * 32); }
  }
  template <int S> __device__ __forceinline__ void commit(char* buf, int) {
    u32x4 a, b;
    a.x = silu_mul2(g0[S].x, u0[S].x); a.y = silu_mul2(g0[S].y, u0[S].y); a.z = silu_mul2(g0[S].z, u0[S].z); a.w = silu_mul2(g0[S].w, u0[S].w);
    b.x = silu_mul2(g1[S].x, u1[S].x); b.y = silu_mul2(g1[S].y, u1[S].y); b.z = silu_mul2(g1[S].z, u1[S].z); b.w = silu_mul2(g1[S].w, u1[S].w);
    *(u32x4*)(buf + o0) = a; *(u32x4*)(buf + o0 + 4096) = b;
  }
};
struct LdColF {
  static constexpr bool COL = true;
  const float* p; size_t ld; fx4 w0[2], w1[2], w2[2], w3[2]; int ob; bool ok;
  __device__ __forceinline__ void init(const float* W, size_t ld_, int nvalid) {
    int half = tidx() & 1, n4 = (tidx() >> 1) & 31, ch = tidx() >> 6;
    ld = ld_; ok = 4 * n4 < nvalid;
    p = W + (size_t)(ch * 8 + half * 4) * ld + 4 * n4;
    ob = col_off(4 * n4, ch) + half * 8;
  }
  template <int S> __device__ __forceinline__ void fetch(int kt) {
    const fx4 z = {0.f, 0.f, 0.f, 0.f};
    w0[S] = z; w1[S] = z; w2[S] = z; w3[S] = z;
    if (ok) {
      const float* q = p + (size_t)(kt * 32) * ld;
      w0[S] = *(const fx4*)q; w1[S] = *(const fx4*)(q + ld); w2[S] = *(const fx4*)(q + 2 * ld); w3[S] = *(const fx4*)(q + 3 * ld);
    }
  }
  template <int S> __device__ __forceinline__ void commit(char* buf, int) {
    const int x1 = ob ^ 64;
    u32x2 t;
    t.x = pk2(w0[S].x, w1[S].x); t.y = pk2(w2[S].x, w3[S].x); *(u32x2*)(buf + ob) = t;
    t.x = pk2(w0[S].y, w1[S].y); t.y = pk2(w2[S].y, w3[S].y); *(u32x2*)(buf + x1 + 256) = t;
    t.x = pk2(w0[S].z, w1[S].z); t.y = pk2(w2[S].z, w3[S].z); *(u32x2*)(buf + ob + 128) = t;
    t.x = pk2(w0[S].w, w1[S].w); t.y = pk2(w2[S].w, w3[S].w); *(u32x2*)(buf + x1 + 384) = t;
  }
};
template <int SMODE>
struct LdColH {
  static constexpr bool COL = true;
  const __hip_bfloat16* p; size_t ld; u32x2 h0[2], h1[2], h2[2], h3[2]; int ob; float sl; int kb; bool ok;
  __device__ __forceinline__ void init(const __hip_bfloat16* W, size_t ld_, float sl_, int nvalid = 128) {
    int half = tidx() & 1, n4 = (tidx() >> 1) & 31, ch = tidx() >> 6;
    ld = ld_; sl = sl_; kb = ch * 8 + half * 4; ok = 4 * n4 < nvalid;
    p = W + (size_t)kb * ld + 4 * n4;
    ob = col_off(4 * n4, ch) + half * 8;
  }
  template <int S> __device__ __forceinline__ void fetch(int kt) {
    const __hip_bfloat16* q = p + (size_t)(kt * 32) * ld;
    const u32x2 z = {0u, 0u};
    h0[S] = z; h1[S] = z; h2[S] = z; h3[S] = z;
    if (ok) { h0[S] = *(const u32x2*)q; h1[S] = *(const u32x2*)(q + ld); h2[S] = *(const u32x2*)(q + 2 * ld); h3[S] = *(const u32x2*)(q + 3 * ld); }
  }
  template <int S> __device__ __forceinline__ void commit(char* buf, int kt) {
    const int x1 = ob ^ 64;
    const u32x2 a0 = h0[S], a1 = h1[S], a2 = h2[S], a3 = h3[S];
    u32x2 t;
    if (SMODE == 0) {
      t.x = (a0.x & 0xffffu) | (a1.x << 16); t.y = (a2.x & 0xffffu) | (a3.x << 16); *(u32x2*)(buf + ob) = t;
      t.x = (a0.x >> 16) | (a1.x & 0xffff0000u); t.y = (a2.x >> 16) | (a3.x & 0xffff0000u); *(u32x2*)(buf + x1 + 256) = t;
      t.x = (a0.y & 0xffffu) | (a1.y << 16); t.y = (a2.y & 0xffffu) | (a3.y << 16); *(u32x2*)(buf + ob + 128) = t;
      t.x = (a0.y >> 16) | (a1.y & 0xffff0000u); t.y = (a2.y >> 16) | (a3.y & 0xffff0000u); *(u32x2*)(buf + x1 + 384) = t;
    } else {
      const int k = kt * 32 + kb;
      const float z0 = __builtin_amdgcn_exp2f(sl * (float)(SMODE == 1 ? 127 - k : k)), z1 = __builtin_amdgcn_exp2f(sl * (float)(SMODE == 1 ? 126 - k : k + 1)),
                  z2 = __builtin_amdgcn_exp2f(sl * (float)(SMODE == 1 ? 125 - k : k + 2)), z3 = __builtin_amdgcn_exp2f(sl * (float)(SMODE == 1 ? 124 - k : k + 3));
      t.x = pk2(bf_lo(a0.x) * z0, bf_lo(a1.x) * z1); t.y = pk2(bf_lo(a2.x) * z2, bf_lo(a3.x) * z3); *(u32x2*)(buf + ob) = t;
      t.x = pk2(bf_hi(a0.x) * z0, bf_hi(a1.x) * z1); t.y = pk2(bf_hi(a2.x) * z2, bf_hi(a3.x) * z3); *(u32x2*)(buf + x1 + 256) = t;
      t.x = pk2(bf_lo(a0.y) * z0, bf_lo(a1.y) * z1); t.y = pk2(bf_lo(a2.y) * z2, bf_lo(a3.y) * z3); *(u32x2*)(buf + ob + 128) = t;
      t.x = pk2(bf_hi(a0.y) * z0, bf_hi(a1.y) * z1); t.y = pk2(bf_hi(a2.y) * z2, bf_hi(a3.y) * z3); *(u32x2*)(buf + x1 + 384) = t;
    }
  }
};
template <bool COL> __device__ __forceinline__ int frag_off(int base, int t, int fr, int fq) {
  return COL ? col_off(base + t * 16 + fr, fq) : row_off(base + t * 16 + fr, fq);
}
constexpr int FBUF_A0 = 0, FBUF_B0 = 32768;

__device__ __forceinline__ void mma_step(const char* bA, const char* bB, const int (&ao)[4], const int (&bo)[4], f32x4 (&acc)[4][4]) {
  bf16x8 af[4], bfr[4];
#pragma unroll
  for (int t = 0; t < 4; ++t) { af[t] = *(const bf16x8*)(bA + ao[t]); bfr[t] = *(const bf16x8*)(bB + bo[t]); }
#pragma unroll
  for (int m = 0; m < 4; ++m)
#pragma unroll
    for (int n = 0; n < 4; ++n) acc[m][n] = __builtin_amdgcn_mfma_f32_16x16x32_bf16(af[m], bfr[n], acc[m][n], 0, 0, 0);
}
template <class LA, class LB, int VAR = 0, bool PIN = true>
__device__ __forceinline__ void gemm_core(char* lds, int nk, LA& la, LB& lb, f32x4 (&acc)[4][4]) {
  const int lane = tidx() & 63, wid = tidx() >> 6, wr = wid >> 1, wc = wid & 1, fr = lane & 15, fq = lane >> 4;
  int ao[4], bo[4];
#pragma unroll
  for (int t = 0; t < 4; ++t) { ao[t] = frag_off<LA::COL>(wr * 64, t, fr, fq); bo[t] = frag_off<LB::COL>(wc * 64, t, fr, fq); }
  la.template fetch<0>(0); lb.template fetch<0>(0);
  la.template fetch<1>(1); lb.template fetch<1>(1);
  __syncthreads();
  la.template commit<0>(lds + FBUF_A0, 0); lb.template commit<0>(lds + FBUF_B0, 0);
  la.template commit<1>(lds + FBUF_A0 + 8192, 1); lb.template commit<1>(lds + FBUF_B0 + 8192, 1);
  __syncthreads();
  for (int kt = 0; kt < nk; kt += 2) {
    const int cur = (kt & 2) << 13;
    const bool more = kt + 2 < nk;
    if (VAR != 1 && more) {
      const int k0 = kt + 2;
      la.template fetch<0>(k0); lb.template fetch<0>(k0);
      la.template fetch<1>(k0 + 1); lb.template fetch<1>(k0 + 1);
    }
    if (PIN) __builtin_amdgcn_sched_barrier(0);
    if (VAR != 2) {
      mma_step(lds + FBUF_A0 + cur, lds + FBUF_B0 + cur, ao, bo, acc);
      mma_step(lds + FBUF_A0 + cur + 8192, lds + FBUF_B0 + cur + 8192, ao, bo, acc);
    }
    if (PIN) __builtin_amdgcn_sched_barrier(0);
    if (VAR != 3 && more) {
      const int nxt = cur ^ 16384;
      la.template commit<0>(lds + FBUF_A0 + nxt, kt + 2); lb.template commit<0>(lds + FBUF_B0 + nxt, kt + 2);
      la.template commit<1>(lds + FBUF_A0 + nxt + 8192, kt + 3); lb.template commit<1>(lds + FBUF_B0 + nxt + 8192, kt + 3);
    }
    __syncthreads();
  }
}
__device__ __forceinline__ void glds16(const void* g, char* l) {
  __builtin_amdgcn_global_load_lds((const void*)g, (LAS void*)l, 16, 0, 0);
}
__device__ __forceinline__ int glds_chunk_off() {
  const int r0 = tidx() >> 2, cp = tidx() & 3;
  return ((cp ^ ((-(r0 >> 2)) & 3)) << 3);
}
__device__ __forceinline__ void gemm_core_g(char* lds, int nk, const __hip_bfloat16* a0, const __hip_bfloat16* a1,
                                            const __hip_bfloat16* b0, const __hip_bfloat16* b1, f32x4 (&acc)[4][4]) {
  const int tid = tidx(), lane = tid & 63, wid = tid >> 6, wr = wid >> 1, wc = wid & 1, fr = lane & 15, fq = lane >> 4;
  int ao[4], bo[4];
#pragma unroll
  for (int t = 0; t < 4; ++t) { ao[t] = row_off(wr * 64 + t * 16 + fr, fq); bo[t] = row_off(wc * 64 + t * 16 + fr, fq); }
  char* my = lds + tid * 16;
  __syncthreads();
  glds16(a0, my); glds16(a1, my + 4096); glds16(b0, my + 8192); glds16(b1, my + 12288);
  glds16(a0 + 32, my + 16384); glds16(a1 + 32, my + 16384 + 4096); glds16(b0 + 32, my + 16384 + 8192); glds16(b1 + 32, my + 16384 + 12288);
  for (int kt = 0; kt < nk - 2; ++kt) {
    { const int kf = (kt + 2) * 32; char* d = my + ((kt + 2) & 3) * 16384;
      glds16(a0 + kf, d); glds16(a1 + kf, d + 4096); glds16(b0 + kf, d + 8192); glds16(b1 + kf, d + 12288); }
    asm volatile("s_waitcnt vmcnt(8)" ::: "memory");
    __builtin_amdgcn_s_barrier();
    asm volatile("" ::: "memory");
    const char* st = lds + (kt & 3) * 16384;
    mma_step(st, st + 8192, ao, bo, acc);
  }
  {
    asm volatile("s_waitcnt vmcnt(4)" ::: "memory");
    __builtin_amdgcn_s_barrier();
    asm volatile("" ::: "memory");
    const char* st = lds + ((nk - 2) & 3) * 16384;
    mma_step(st, st + 8192, ao, bo, acc);
    asm volatile("s_waitcnt vmcnt(0)" ::: "memory");
    __builtin_amdgcn_s_barrier();
    asm volatile("" ::: "memory");
    st = lds + ((nk - 1) & 3) * 16384;
    mma_step(st, st + 8192, ao, bo, acc);
  }
  __syncthreads();
}
__device__ __forceinline__ void acc_zero(f32x4 (&acc)[4][4]) {
#pragma unroll
  for (int m = 0; m < 4; ++m)
#pragma unroll
    for (int n = 0; n < 4; ++n) acc[m][n] = (f32x4){0.f, 0.f, 0.f, 0.f};
}
__device__ __forceinline__ void acc_to_stage(char* lds, f32x4 (&acc)[4][4]) {
  float* stage = (float*)lds;
  const int lane = tidx() & 63, wid = tidx() >> 6, wr = wid >> 1, wc = wid & 1, fr = lane & 15, fq = lane >> 4;
#pragma unroll
  for (int m = 0; m < 4; ++m)
#pragma unroll
    for (int n = 0; n < 4; ++n)
#pragma unroll
      for (int j = 0; j < 4; ++j) stage[(wr * 64 + m * 16 + fq * 4 + j) * ST_LD + wc * 64 + n * 16 + fr] = acc[m][n][j];
  __syncthreads();
}
__device__ __forceinline__ void st4bf(__hip_bfloat16* p, float4 v) { *(uint2*)p = make_uint2(pk2(v.x, v.y), pk2(v.z, v.w)); }
#endif

__device__ __forceinline__ void stA4(AT* p, float4 v) { stA(p, v.x); stA(p + 1, v.y); stA(p + 2, v.z); stA(p + 3, v.w); }

__device__ __forceinline__ void ph_ada1(const Params& p, int bid, int nb, char* lds) {
  float* s = (float*)lds;
  for (int item = bid; item < 4 * 24 * 8; item += nb) {
    int ks = item & 7, cb = (item >> 3) % 24, l = item / 192;
    __syncthreads();
    for (int e = tidx(); e < 5 * 128; e += 256) {
      int r = e >> 7, k = (e & 127) + ks * 128;
      float cv = r < 4 ? p.c[r * 1024 + k] : p.c_ctx[k];
      s[e] = silu_f(cv);
    }
    __syncthreads();
    int col = cb * 256 + tidx();
    float a0 = 0.f, a1 = 0.f, a2 = 0.f, a3 = 0.f, a4 = 0.f;
    const float* w = p.ada_w + ((size_t)l * 1024 + ks * 128) * 6144 + col;
    for (int k = 0; k < 128; ++k) {
      float wv = w[(size_t)k * 6144];
      a0 = fmaf(s[k], wv, a0); a1 = fmaf(s[128 + k], wv, a1); a2 = fmaf(s[256 + k], wv, a2); a3 = fmaf(s[384 + k], wv, a3); a4 = fmaf(s[512 + k], wv, a4);
    }
    float* mp = p.modp + ((size_t)(l * 8 + ks) * 5) * 6144 + col;
    mp[0] = a0; mp[6144] = a1; mp[2 * 6144] = a2; mp[3 * 6144] = a3; mp[4 * 6144] = a4;
  }
}
#if !EXACT
__device__ __forceinline__ void conv_dense_weights(const Params& p, int bid, int nb, char* lds) {
  float* tile = (float*)lds;
  const int tid = tidx(), tx = tid & 31, ty = tid >> 5;
  const int tiles_abin = 16 * 96, tiles_about = 16 * 32, tiles_min = 16 * 21, tiles_uq = 6 * 48, tiles_ukv = 4 * 64, tiles_mout = 16 * 32;
  const int per_layer = tiles_abin + tiles_about + tiles_min + tiles_uq + tiles_ukv + tiles_mout;
  for (int item = bid; item < 2 * per_layer; item += nb) {
    const int li = item / per_layer; int t = item % per_layer;
    const float* src; AT* dst; int K, N;
    if (t < tiles_abin) { src = p.ab_w_in + (size_t)li * 1024 * 3072; dst = p.WB + WB_ABIN + (size_t)li * 1024 * 3072; K = 1024; N = 3072; }
    else if ((t -= tiles_abin) < tiles_about) { src = p.ab_w_out + (size_t)li * 1024 * 1024; dst = p.WB + WB_ABOUT + (size_t)li * 1024 * 1024; K = 1024; N = 1024; }
    else if ((t -= tiles_about) < tiles_min) { src = p.mla_w_in + (size_t)li * 1024 * 672; dst = p.WB + WB_MIN + (size_t)li * 1024 * 672; K = 1024; N = 672; }
    else if ((t -= tiles_min) < tiles_uq) { src = p.w_uq + (size_t)li * 384 * 1536; dst = p.WB + WB_UQ + (size_t)li * 384 * 1536; K = 384; N = 1536; }
    else if ((t -= tiles_uq) < tiles_ukv) { src = p.w_ukv + (size_t)li * 256 * 2048; dst = p.WB + WB_UKV + (size_t)li * 256 * 2048; K = 256; N = 2048; }
    else { t -= tiles_ukv; src = p.mla_w_out + (size_t)li * 1024 * 1024; dst = p.WB + WB_MOUT + (size_t)li * 1024 * 1024; K = 1024; N = 1024; }
    const int ntn = N / 32, kt = t / ntn, nt = t % ntn;
    __syncthreads();
#pragma unroll
    for (int i = 0; i < 8; ++i) tile[(ty + 8 * i) * 33 + tx] = src[(size_t)(kt * 64 + ty + 8 * i) * N + nt * 32 + tx];
    __syncthreads();
    {
      const int n = tid >> 3, k8 = (tid & 7) * 8;
      const float* c = tile + k8 * 33 + n;
      u32x4 o;
      o.x = pk2(c[0], c[33]); o.y = pk2(c[2 * 33], c[3 * 33]); o.z = pk2(c[4 * 33], c[5 * 33]); o.w = pk2(c[6 * 33], c[7 * 33]);
      *(u32x4*)(dst + (size_t)(nt * 32 + n) * K + kt * 64 + k8) = o;
    }
  }
}
#endif

#if !EXACT
constexpr size_t WM_GATE = 0, WM_UP = (size_t)128 * 1024 * 512, WM_DOWN = (size_t)2 * 128 * 1024 * 512;
__device__ __forceinline__ void conv_moe_weights(const Params& p, int bid, int nb, char* lds) {
  float* tile = (float*)lds;
  const int tid = tidx();
  const int rk = tid >> 5, rn4 = (tid & 31) * 4;
  const int wn = tid >> 1, wk = (tid & 1) * 64;
  const int NT = 3 * 128 * 32;
  for (int item = bid; item < NT; item += nb) {
    const int tns = item / (128 * 32), rem = item % (128 * 32), mat = rem >> 5, t = rem & 31;
    const float* src; AT* dst; int K, N;
    if (tns == 0) { src = p.w_gate + (size_t)mat * 1024 * 512; dst = p.WM + WM_GATE + (size_t)mat * 1024 * 512; K = 1024; N = 512; }
    else if (tns == 1) { src = p.w_up + (size_t)mat * 1024 * 512; dst = p.WM + WM_UP + (size_t)mat * 1024 * 512; K = 1024; N = 512; }
    else { src = p.w_down + (size_t)mat * 512 * 1024; dst = p.WM + WM_DOWN + (size_t)mat * 512 * 1024; K = 512; N = 1024; }
    const int ntn = N >> 7, kt = t / ntn, nt = t % ntn;
    fx4 v[16];
    const float* q = src + (size_t)(kt * 128 + rk) * N + nt * 128 + rn4;
#pragma unroll
    for (int i = 0; i < 16; ++i) v[i] = *(const fx4*)(q + (size_t)(8 * i) * N);
    __syncthreads();
#pragma unroll
    for (int i = 0; i < 16; ++i) {
      float* t0 = tile + (rk + 8 * i) * 129 + rn4;
      t0[0] = v[i].x; t0[1] = v[i].y; t0[2] = v[i].z; t0[3] = v[i].w;
    }
    __syncthreads();
    AT* d = dst + (size_t)(nt * 128 + wn) * K + kt * 128 + wk;
    const float* c = tile + wk * 129 + wn;
#pragma unroll
    for (int g = 0; g < 8; ++g) {
      u32x4 o;
      o.x = pk2(c[(8 * g + 0) * 129], c[(8 * g + 1) * 129]); o.y = pk2(c[(8 * g + 2) * 129], c[(8 * g + 3) * 129]);
      o.z = pk2(c[(8 * g + 4) * 129], c[(8 * g + 5) * 129]); o.w = pk2(c[(8 * g + 6) * 129], c[(8 * g + 7) * 129]);
      *(u32x4*)(d + 8 * g) = o;
    }
  }
}
#endif
__device__ __forceinline__ void ph_ada2(const Params& p, int bid, int nb) {
  int gtid = bid * 256 + tidx(), gsz = nb * 256;
  for (int i = gtid; i < 4 * 5 * 6144; i += gsz) {
    int l = i / 30720, rem = i % 30720, r = rem / 6144, col = rem % 6144;
    float v = p.ada_b[l * 6144 + col];
    for (int ks = 0; ks < 8; ++ks) v += p.modp[((size_t)(l * 8 + ks) * 5 + r) * 6144 + col];
    p.mod[i] = v;
  }
  for (int i = gtid; i < 4096 * 64; i += gsz) {
    int t = i >> 6, k = i & 63;
    float inv = (float)exp(-(double)(2 * k) / 128.0 * 9.210340371976184);
    float ang = (float)t * inv, sn, cs;
    sincos_acc(ang, sn, cs);
    p.cs1c[i] = cs; p.cs1s[i] = sn;
  }
#if !EXACT
  for (int i = gtid; i < 4 * 128 * 48 * 8; i += gsz) {
    int j = i & 7, n = (i >> 3) % 48, c = (i / 384) & 127, l = i / (384 * 128), k = c * 8 + j;
    float w = n < 4 ? p.grp_w[((size_t)l * 1024 + k) * 4 + n] : (n < 36 ? p.exp_w[((size_t)l * 1024 + k) * 32 + n - 4] : 0.f);
    __hip_bfloat16 hi = __float2bfloat16(w);
    __hip_bfloat16 lo = __float2bfloat16(w - __bfloat162float(hi));
    size_t o = (((size_t)(l * 2 + 0) * 128 + c) * 48 + n) * 8 + j;
    p.WR[o] = *(unsigned short*)&hi;
    p.WR[o + (size_t)128 * 48 * 8] = *(unsigned short*)&lo;
  }
#endif
  for (int i = gtid; i < 4096 * 16; i += gsz) {
    int t = i >> 4, a = i & 15, j = a & 7;
    float inv = (float)exp(-(double)(2 * j) / 16.0 * 9.210340371976184);
    float pos = a < 8 ? (float)(t >> 6) : (float)(t & 63);
    float ang = pos * inv, sn, cs;
    sincos_acc(ang, sn, cs);
    p.cs2c[i] = cs; p.cs2s[i] = sn;
  }
}

__device__ __forceinline__ void ph_T1(const Params& p, int l, int bid, int nb) {
  int wave = tidx() >> 6, lane = tidx() & 63;
  const float* g = p.norm_g + (l * 2 + 0) * 1024;
  for (int tok = bid * 4 + wave; tok < NTOK; tok += nb * 4) {
    int mr = tok_modrow(tok);
    const float* src = (l == 0) ? (tok < NCTX ? p.ctx + (size_t)tok * 1024 : p.x + (size_t)(tok - NCTX) * 1024) : p.X + (size_t)tok * 1024;
    float v[16];
#pragma unroll
    for (int i = 0; i < 4; ++i) { float4 t4 = *(const float4*)(src + i * 256 + lane * 4); v[i * 4] = t4.x; v[i * 4 + 1] = t4.y; v[i * 4 + 2] = t4.z; v[i * 4 + 3] = t4.w; }
    if (l > 0) {
      const float* gm = p.mod + ((size_t)(l - 1) * 5 + mr) * 6144 + 5 * 1024;
      const AT* y0 = p.Y + (size_t)(tok * 2) * 1024; const AT* y1 = y0 + 1024;
#pragma unroll
      for (int i = 0; i < 4; ++i)
#pragma unroll
        for (int cc = 0; cc < 4; ++cc) { int col = i * 256 + lane * 4 + cc; v[i * 4 + cc] += gm[col] * (ldA(y0 + col) + ldA(y1 + col)); }
    }
    float ss = 0.f;
#pragma unroll
    for (int i = 0; i < 16; ++i) ss += v[i] * v[i];
    ss = wave_sum(ss);
    float rstd = rsqrtf(ss * (1.f / 1024.f) + EPSF);
    const float* md = p.mod + ((size_t)l * 5 + mr) * 6144;
#pragma unroll
    for (int i = 0; i < 4; ++i) {
      int col = i * 256 + lane * 4;
      *(float4*)(p.X + (size_t)tok * 1024 + col) = make_float4(v[i * 4], v[i * 4 + 1], v[i * 4 + 2], v[i * 4 + 3]);
#pragma unroll
      for (int cc = 0; cc < 4; ++cc) {
        float h = v[i * 4 + cc] * rstd * g[col + cc] * (1.f + md[1024 + col + cc]) + md[col + cc];
        stA(p.H + (size_t)tok * 1024 + col + cc, h);
      }
    }
  }
}
__device__ __forceinline__ void ph_final(const Params& p, int bid, int nb) {
  int wave = tidx() >> 6, lane = tidx() & 63;
  for (int tok = NCTX + bid * 4 + wave; tok < NTOK; tok += nb * 4) {
    int mr = tok_modrow(tok);
    const float* src = p.X + (size_t)tok * 1024;
    const float* gm = p.mod + ((size_t)3 * 5 + mr) * 6144 + 5 * 1024;
    const AT* y0 = p.Y + (size_t)(tok * 2) * 1024; const AT* y1 = y0 + 1024;
    float v[16];
    float ss = 0.f;
#pragma unroll
    for (int i = 0; i < 4; ++i)
#pragma unroll
      for (int cc = 0; cc < 4; ++cc) { int col = i * 256 + lane * 4 + cc; float t = src[col] + gm[col] * (ldA(y0 + col) + ldA(y1 + col)); v[i * 4 + cc] = t; ss += t * t; }
    ss = wave_sum(ss);
    float rstd = rsqrtf(ss * (1.f / 1024.f) + EPSF);
#pragma unroll
    for (int i = 0; i < 4; ++i) {
      int col = i * 256 + lane * 4;
      *(float4*)(p.out + (size_t)(tok - NCTX) * 1024 + col) = make_float4(v[i * 4] * rstd * p.final_g[col], v[i * 4 + 1] * rstd * p.final_g[col + 1],
                                                                           v[i * 4 + 2] * rstd * p.final_g[col + 2], v[i * 4 + 3] * rstd * p.final_g[col + 3]);
    }
  }
}

#define EPI_BEGIN for (int e_ = tidx(); e_ < 128 * 32; e_ += 256) { const int row = e_ >> 5, c4 = (e_ & 31) << 2; float4 v = *(const float4*)(stage + row * ST_LD + c4);
#define EPI_END }

__device__ __forceinline__ void ph_gemm_store(const Params& p, const AT* A, int lda, const float* W, int K, int N, AT* O, int ldo, int rt0, int bid, int nb, char* lds) {
  float* stage = (float*)lds;
  const int nct = (N + 127) / 128;
  const int nitems = (NRT - rt0) * nct;
  for (int item = bid; item < nitems; item += nb) {
    int ct = item % nct, rt = rt0 + item / nct;
    engine(lds, K,
           [&](int r, int k) { return ldA(A + (size_t)(rt * 128 + r) * lda + k); },
           [&](int k, int c) { int col = ct * 128 + c; return col < N ? W[(size_t)k * N + col] : 0.f; });
    EPI_BEGIN
      int col = ct * 128 + c4;
      if (col < N) stA4(O + (size_t)(rt * 128 + row) * ldo + col, v);
    EPI_END
  }
}
__device__ __forceinline__ void ph_gemm_resid(const Params& p, int l, const AT* A, const float* W, int rt0, int bid, int nb, char* lds) {
  float* stage = (float*)lds;
  const int nitems = (NRT - rt0) * 8;
  for (int item = bid; item < nitems; item += nb) {
    int ct = item & 7, rt = rt0 + (item >> 3);
    engine(lds, 1024,
           [&](int r, int k) { return ldA(A + (size_t)(rt * 128 + r) * 1024 + k); },
           [&](int k, int c) { return W[(size_t)k * 1024 + ct * 128 + c]; });
    int mr = tok_modrow(rt * 128);
    const float* gm = p.mod + ((size_t)l * 5 + mr) * 6144 + 2 * 1024 + ct * 128;
    EPI_BEGIN
      float* xp = p.X + (size_t)(rt * 128 + row) * 1024 + ct * 128 + c4;
      float4 xv = *(float4*)xp;
      xv.x += gm[c4] * v.x; xv.y += gm[c4 + 1] * v.y; xv.z += gm[c4 + 2] * v.z; xv.w += gm[c4 + 3] * v.w;
      *(float4*)xp = xv;
    EPI_END
  }
}

struct RetCtx { const AT* proj; const float* cc; const float* ss; int tok0; int t0; bool lat; int h; };
__device__ __forceinline__ float ret_rot(const RetCtx& r, int off, int j, int d) {
  const AT* base = r.proj + (size_t)(r.tok0 + j) * 3072 + off + r.h * 128;
#if !EXACT
  return ldA(base + d);
#endif
  if (!r.lat) return ldA(base + d);
  int i = d & 63;
  float x1 = ldA(base + i), x2 = ldA(base + 64 + i);
  float cs = r.cc[(r.t0 + j) * 64 + i], sn = r.ss[(r.t0 + j) * 64 + i];
  return d < 64 ? x1 * cs - x2 * sn : x1 * sn + x2 * cs;
}
__device__ __forceinline__ float ret_v(const RetCtx& r, int m, int e) { return ldA(r.proj + (size_t)(r.tok0 + m) * 3072 + 1024 + r.h * 128 + e); }

__device__ __forceinline__ void ph_R1(const Params& p, int l, int bid, int nb, char* lds) {
  const int li = l >> 1;
  float* stage = (float*)lds;
  const int NRET = NBAT * 4 * NCH;
  const int NLRU = NBAT * NCH * 8;
  for (int item = bid; item < NRET + NLRU; item += nb) {
    if (item < NRET) {
      int c = item % NCH, bh = item / NCH, h = bh & 3, b = bh >> 2;
      RetCtx rc{p.PROJ, p.cs1c, p.cs1s, chunk_tok0(b, c), (c - 2) * 128, c >= 2, h};
      for (int d = 0; d < 2; ++d) {
        float lg = -softplus_f(-p.ret_decay[(li * 2 + d) * 4 + h]);
        engine(lds, 128,
               [&](int r, int k) { float z = d == 0 ? expf(lg * (float)(127 - k)) : expf(lg * (float)k); return ret_rot(rc, 512, k, r) * KSCALE * z; },
               [&](int k, int cc) { return ret_v(rc, k, cc); });
        float* U = p.U + ((size_t)((b * 4 + h) * 2 + d) * NCH + c) * 16384;
        EPI_BEGIN
          *(float4*)(U + row * 128 + c4) = v;
        EPI_END
      }
    } else {
      int it = item - NRET;
      int kb = it & 7, c = (it >> 3) % NCH, b = it / (8 * NCH);
      float* us = (float*)lds;
      float* Wl = us + 128 * 64;
      int tok0 = chunk_tok0(b, c);
      int seqbase = c < 2 ? b * CTXL : NCTX + b * SEQ;
      int n = c < 2 ? CTXL : SEQ;
      int t0 = tok0 - seqbase;
      __syncthreads();
      for (int e = tidx(); e < 128 * 64; e += 256) {
        int pos = e >> 6, i = e & 63, ch = kb * 64 + i, t = t0 + pos;
        float acc = p.conv_b[li * 512 + ch];
#pragma unroll
        for (int tap = 0; tap < 4; ++tap) {
          int tt = t + tap - 2;
          if (tt >= 0 && tt < n) acc += p.conv_w[(li * 4 + tap) * 512 + ch] * ldA(p.PROJ + (size_t)(seqbase + tt) * 3072 + 2048 + ch);
        }
        us[e] = acc;
      }
      for (int e = tidx(); e < 4 * 4096; e += 256) {
        int dg = e >> 12, i = (e >> 6) & 63, j = e & 63, d = dg >> 1, g = dg & 1;
        Wl[e] = p.gate_w[((size_t)(((li * 2 + d) * 2 + g) * 8 + kb) * 64 + i) * 64 + j];
      }
      __syncthreads();
      if (tidx() < 128) {
        int d = tidx() >> 6, j = tidx() & 63, ch = kb * 64 + j;
        float sp = softplus_f(-p.lam[(li * 2 + d) * 512 + ch]);
        float br = p.gate_b[((li * 2 + d) * 2 + 0) * 512 + ch], bi = p.gate_b[((li * 2 + d) * 2 + 1) * 512 + ch];
        float h = 0.f, A = 1.f;
        const float* Wr = Wl + (d * 2 + 0) * 4096 + j;
        const float* Wi = Wl + (d * 2 + 1) * 4096 + j;
        for (int s = 0; s < 128; ++s) {
          int pos = d ? 127 - s : s;
          float r = br, ig = bi;
          const float* up = us + pos * 64;
#pragma unroll 8
          for (int i = 0; i < 64; ++i) { float uv = up[i]; r = fmaf(uv, Wr[i * 64], r); ig = fmaf(uv, Wi[i * 64], ig); }
          r = sigmoid_f(r); ig = sigmoid_f(ig);
          float la = -8.f * r * sp;
          float a = expf(la);
          float bt = sqrtf(-expm1f(2.f * la)) * (ig * up[j]);
          h = fmaf(a, h, bt); A *= a;
          size_t o = ((size_t)d * NTOK + tok0 + pos) * 512 + ch;
          p.HL[o] = h; p.AC[o] = A;
        }
        p.CHA[((d * 4 + b) * NCH + c) * 512 + ch] = A;
        p.CHH[((d * 4 + b) * NCH + c) * 512 + ch] = h;
      }
      __syncthreads();
    }
  }
}
__device__ __forceinline__ void ph_R2(const Params& p, int l, int bid, int nb) {
  const int li = l >> 1;
  int gtid = bid * 256 + tidx(), gsz = nb * 256;
  for (int i = gtid; i < 32 * 16384; i += gsz) {
    int el = i & 16383, bhd = i >> 14, d = bhd & 1, h = (bhd >> 1) & 3;
    float lg = -softplus_f(-p.ret_decay[(li * 2 + d) * 4 + h]);
    float dec = expf(lg * 128.f);
    float* base = p.U + (size_t)bhd * NCH * 16384 + el;
    float S = 0.f;
    for (int idx = 0; idx < NCH; ++idx) {
      int c = d == 0 ? idx : (idx < 2 ? 1 - idx : 35 - idx);
      float u = base[(size_t)c * 16384];
      base[(size_t)c * 16384] = S;
      S = fmaf(dec, S, u);
    }
  }
  for (int i = gtid; i < 2 * 4 * 512; i += gsz) {
    int ch = i & 511, db = i >> 9, d = db >> 2;
    float carry = 0.f;
    for (int idx = 0; idx < NCH; ++idx) {
      int c = d == 0 ? idx : (idx < 2 ? 1 - idx : 35 - idx);
      size_t o = ((size_t)db * NCH + c) * 512 + ch;
      p.CAR[o] = carry;
      carry = fmaf(p.CHA[o], carry, p.CHH[o]);
    }
  }
}
__device__ __forceinline__ void ph_R3(const Params& p, int l, int bid, int nb, char* lds) {
  const int li = l >> 1;
  float* stage = (float*)lds;
  const int NRET = NBAT * 4 * NCH;
  float* scr = p.SCR + (size_t)bid * 16384;
  for (int item = bid; item < NRET + NRT; item += nb) {
    if (item < NRET) {
      int c = item % NCH, bh = item / NCH, h = bh & 3, b = bh >> 2;
      RetCtx rc{p.PROJ, p.cs1c, p.cs1s, chunk_tok0(b, c), (c - 2) * 128, c >= 2, h};
      float lg0 = -softplus_f(-p.ret_decay[(li * 2 + 0) * 4 + h]);
      float lg1 = -softplus_f(-p.ret_decay[(li * 2 + 1) * 4 + h]);
      engine(lds, 128,
             [&](int r, int k) { return ret_rot(rc, 0, r, k); },
             [&](int k, int cc) { return ret_rot(rc, 512, cc, k) * KSCALE; });
      EPI_BEGIN
        float o4[4] = {v.x, v.y, v.z, v.w};
#pragma unroll
        for (int q = 0; q < 4; ++q) {
          int m = c4 + q;
          float M = row > m ? expf(lg0 * (float)(row - m)) : (row < m ? expf(lg1 * (float)(m - row)) : 2.f);
          scr[row * 128 + m] = o4[q] * M;
        }
      EPI_END
      __syncthreads();
      const float* S0 = p.U + ((size_t)((b * 4 + h) * 2 + 0) * NCH + c) * 16384;
      const float* S1 = p.U + ((size_t)((b * 4 + h) * 2 + 1) * NCH + c) * 16384;
      engine(lds, 384,
             [&](int r, int k) {
               if (k < 128) return scr[r * 128 + k];
               if (k < 256) return ret_rot(rc, 0, r, k - 128) * expf(lg0 * (float)(r + 1));
               return ret_rot(rc, 0, r, k - 256) * expf(lg1 * (float)(128 - r));
             },
             [&](int k, int cc) {
               if (k < 128) return ret_v(rc, k, cc);
               if (k < 256) return S0[(k - 128) * 128 + cc];
               return S1[(k - 256) * 128 + cc];
             });
      EPI_BEGIN
        float ss = v.x * v.x + v.y * v.y + v.z * v.z + v.w * v.w;
        ss = half_sum(ss);
        float rs = rsqrtf(ss * (1.f / 128.f) + EPSF);
        int tok = rc.tok0 + row;
        const AT* gp = p.PROJ + (size_t)tok * 3072 + 1536 + h * 128 + c4;
        float4 o = make_float4(v.x * rs * silu_f(ldA(gp)), v.y * rs * silu_f(ldA(gp + 1)), v.z * rs * silu_f(ldA(gp + 2)), v.w * rs * silu_f(ldA(gp + 3)));
        stA4(p.MIX + (size_t)tok * 1024 + h * 128 + c4, o);
      EPI_END
      __syncthreads();
    } else {
      int rt = item - NRET, b, c;
      rt_to_bc(rt, b, c);
      for (int e = tidx(); e < 128 * 512; e += 256) {
        int pos = e >> 9, ch = e & 511, tok = rt * 128 + pos;
        size_t o0 = ((size_t)0 * NTOK + tok) * 512 + ch, o1 = ((size_t)1 * NTOK + tok) * 512 + ch;
        float hf = p.HL[o0] + p.AC[o0] * p.CAR[((0 * 4 + b) * NCH + c) * 512 + ch];
        float hb = p.HL[o1] + p.AC[o1] * p.CAR[((1 * 4 + b) * NCH + c) * 512 + ch];
        float y = ldA(p.PROJ + (size_t)tok * 3072 + 2560 + ch);
        stA(p.MIX + (size_t)tok * 1024 + 512 + ch, (hf + hb) * gelu_tanh(y));
      }
    }
  }
}

__device__ __forceinline__ void ph_T2(const Params& p, int l, int bid, int nb, char* lds) {
  int wave = tidx() >> 6, lane = tidx() & 63;
  float* lg = (float*)(lds) + wave * 64;
  const float* g = p.norm_g + (l * 2 + 1) * 1024;
  const float* gw = p.grp_w + (size_t)l * 1024 * 4;
  const float* ew = p.exp_w + (size_t)l * 1024 * 32;
  const int gbeg = (l == 3) ? NCTX / 16 : 0;
  for (int grp = gbeg + bid; grp < NTOK / 16; grp += nb)
  for (int k4 = 0; k4 < 4; ++k4) {
    const int tok = grp * 16 + wave * 4 + k4;
    int mr = tok_modrow(tok);
    const float* src = p.X + (size_t)tok * 1024;
    const float* md = p.mod + ((size_t)l * 5 + mr) * 6144;
    float ss = 0.f;
#pragma unroll
    for (int i = 0; i < 4; ++i) { float4 t4 = *(const float4*)(src + i * 256 + lane * 4); ss += t4.x * t4.x + t4.y * t4.y + t4.z * t4.z + t4.w * t4.w; }
    ss = wave_sum(ss);
    float rstd = rsqrtf(ss * (1.f / 1024.f) + EPSF);
    float part[36];
#pragma unroll
    for (int j = 0; j < 36; ++j) part[j] = 0.f;
#pragma unroll 1
    for (int q = 0; q < 16; ++q) {
      int col = (q >> 2) * 256 + lane * 4 + (q & 3);
      float h = src[col] * rstd * g[col] * (1.f + md[4 * 1024 + col]) + md[3 * 1024 + col];
      stA(p.H + (size_t)tok * 1024 + col, h);
      float4 gv = *(const float4*)(gw + col * 4);
      part[0] = fmaf(h, gv.x, part[0]); part[1] = fmaf(h, gv.y, part[1]); part[2] = fmaf(h, gv.z, part[2]); part[3] = fmaf(h, gv.w, part[3]);
      const float4* ep = (const float4*)(ew + col * 32);
#pragma unroll
      for (int qq = 0; qq < 8; ++qq) { float4 e4 = ep[qq]; part[4 + qq * 4] = fmaf(h, e4.x, part[4 + qq * 4]); part[5 + qq * 4] = fmaf(h, e4.y, part[5 + qq * 4]); part[6 + qq * 4] = fmaf(h, e4.z, part[6 + qq * 4]); part[7 + qq * 4] = fmaf(h, e4.w, part[7 + qq * 4]); }
    }
#pragma unroll
    for (int j = 0; j < 36; ++j) { float t = wave_sum(part[j]); if (lane == 0) lg[j] = t; }
    if (lane == 0) {
      const float* gb = p.grp_b + l * 4;
      int gs = 0; float gm = lg[0] + gb[0];
      for (int j = 1; j < 4; ++j) { float t = lg[j] + gb[j]; if (t > gm) { gm = t; gs = j; } }
      float gsum = 0.f;
      for (int j = 0; j < 4; ++j) gsum += expf(lg[j] + gb[j] - gm);
      float gtop = 1.f / gsum;
      const float* wlp = lg + 4 + gs * 8;
      const float* eb = p.exp_b + l * 32 + gs * 8;
      int i0 = 0; float m0 = wlp[0] + eb[0];
      for (int j = 1; j < 8; ++j) { float t = wlp[j] + eb[j]; if (t > m0) { m0 = t; i0 = j; } }
      int i1 = -1; float m1 = -3.4e38f;
      for (int j = 0; j < 8; ++j) { float t = wlp[j] + eb[j]; if (j != i0 && t > m1) { m1 = t; i1 = j; } }
      float e1 = expf(m1 - m0);
      float p0 = 1.f / (1.f + e1), p1 = e1 / (1.f + e1);
      int ex0 = gs * 8 + i0, ex1 = gs * 8 + i1;
      p.re[tok * 2] = ex0; p.re[tok * 2 + 1] = ex1;
      p.rw[tok * 2] = gtop * p0; p.rw[tok * 2 + 1] = gtop * p1;

    }
  }
}

__device__ __forceinline__ void ph_RB(const Params& p, int l, int bid, int nb, char* lds) {
  int* sc = (int*)lds;
  const int tid = tidx(), lane = tid & 63, wid = tid >> 6;
  const int abeg = (l == 3) ? 2 * NCTX : 0;
  constexpr int PER = 136;
  for (int e = bid; e < 32; e += nb) {
    const int a0 = tid * PER;
    const int4* src = (const int4*)(p.re + a0);
    int c = 0;
    if (a0 + PER > abeg) {
#pragma unroll 34
      for (int i = 0; i < PER / 4; ++i) {
        const int4 q = src[i]; const int a = a0 + 4 * i;
        c += (q.x == e && a >= abeg) + (q.y == e && a + 1 >= abeg) + (q.z == e && a + 2 >= abeg) + (q.w == e && a + 3 >= abeg);
      }
    }
    int inc = c;
#pragma unroll
    for (int o = 1; o < 64; o <<= 1) { int t = __shfl_up(inc, o); if (lane >= o) inc += t; }
    __syncthreads();
    if (lane == 63) sc[wid] = inc;
    __syncthreads();
    int woff = 0;
    for (int w = 0; w < wid; ++w) woff += sc[w];
    const int total = sc[0] + sc[1] + sc[2] + sc[3];
    int o = woff + inc - c;
    int* lst = p.list + (size_t)e * NTOK;
    if (c > 0) {
#pragma unroll 17
      for (int i = 0; i < PER / 4; ++i) {
        const int4 q = src[i]; const int a = a0 + 4 * i;
        if (q.x == e && a >= abeg) lst[o++] = a;
        if (q.y == e && a + 1 >= abeg) lst[o++] = a + 1;
        if (q.z == e && a + 2 >= abeg) lst[o++] = a + 2;
        if (q.w == e && a + 3 >= abeg) lst[o++] = a + 3;
      }
    }
    if (tid == 0) p.cnt[(l * 32 + e) * 32] = total;
  }
}
__device__ __forceinline__ void moe_setup(const Params& p, int l, int* si) {
  __syncthreads();
  if (tidx() < 32) si[tidx()] = p.cnt[(l * 32 + tidx()) * 32];
  __syncthreads();
  if (tidx() == 0) {
    int b = 0, k = 0;
    for (int e = 0; e < 32; ++e) { si[32 + e] = b; si[65 + e] = k; b += si[e]; k += (si[e] + 127) >> 7; }
    si[64] = b; si[97] = k;
  }
  __syncthreads();
}
__device__ __forceinline__ void ph_E1(const Params& p, int l, int bid, int nb, char* lds) {
  float* stage = (float*)lds;
  int* si = (int*)(lds + MISC_OFF);
  moe_setup(p, l, si);
  const int nblk = si[97];
  for (int item = bid; item < nblk * 8; item += nb) {
    int nt = item & 7, bi = item >> 3;
    int e = 0;
    while (e < 31 && si[65 + e + 1] <= bi) ++e;
    int rb = bi - si[65 + e], cnt = si[e], base = si[32 + e];
    const int* lst = p.list + (size_t)e * NTOK + rb * 128;
    int nrow = cnt - rb * 128; if (nrow > 128) nrow = 128;
    const float* wg = p.w_gate + ((size_t)(l * 32 + e) * 1024) * 512 + nt * 64;
    const float* wu = p.w_up + ((size_t)(l * 32 + e) * 1024) * 512 + nt * 64;
    engine(lds, 1024,
           [&](int r, int k) { return r < nrow ? ldA(p.H + (size_t)(lst[r] >> 1) * 1024 + k) : 0.f; },
           [&](int k, int c) { return c < 64 ? wg[(size_t)k * 512 + c] : wu[(size_t)k * 512 + c - 64]; });
    for (int e_ = tidx(); e_ < 128 * 16; e_ += 256) {
      int row = e_ >> 4, c4 = (e_ & 15) << 2;
      if (row < nrow) {
        float4 gv = *(const float4*)(stage + row * ST_LD + c4), uv = *(const float4*)(stage + row * ST_LD + 64 + c4);
        float4 o = make_float4(silu_f(gv.x) * uv.x, silu_f(gv.y) * uv.y, silu_f(gv.z) * uv.z, silu_f(gv.w) * uv.w);
        stA4(p.HB + (size_t)(base + rb * 128 + row) * 512 + nt * 64 + c4, o);
      }
    }
  }
}
__device__ __forceinline__ void ph_E2(const Params& p, int l, int bid, int nb, char* lds) {
  float* stage = (float*)lds;
  int* si = (int*)(lds + MISC_OFF);
  moe_setup(p, l, si);
  const int nblk = si[97];
  for (int item = bid; item < nblk * 8; item += nb) {
    int ct = item & 7, bi = item >> 3;
    int e = 0;
    while (e < 31 && si[65 + e + 1] <= bi) ++e;
    int rb = bi - si[65 + e], cnt = si[e], base = si[32 + e];
    const int* lst = p.list + (size_t)e * NTOK + rb * 128;
    int nrow = cnt - rb * 128; if (nrow > 128) nrow = 128;
    const float* wd = p.w_down + ((size_t)(l * 32 + e) * 512) * 1024 + ct * 128;
    const AT* hb = p.HB + (size_t)(base + rb * 128) * 512;
    engine(lds, 512,
           [&](int r, int k) { return r < nrow ? ldA(hb + (size_t)r * 512 + k) : 0.f; },
           [&](int k, int c) { return wd[(size_t)k * 1024 + c]; });
    EPI_BEGIN
      if (row < nrow) {
        int a = lst[row];
        float w = p.rw[a];
        stA4(p.Y + (size_t)a * 1024 + ct * 128 + c4, make_float4(v.x * w, v.y * w, v.z * w, v.w * w));
      }
    EPI_END
  }
}

__device__ __forceinline__ void ph_MN(const Params& p, int l, int bid, int nb) {
  int wave = tidx() >> 6, lane = tidx() & 63;
  for (int grp = bid; grp < NTOK / 32; grp += nb)
#pragma unroll 4
  for (int k8 = 0; k8 < 8; ++k8) {
    const int tok = grp * 32 + wave * 8 + k8;
    const AT* pr = p.PROJ + (size_t)tok * P1LD;
    float sq = 0.f, skv = 0.f;
#pragma unroll
    for (int i = 0; i < 6; ++i) { float t = ldA(pr + i * 64 + lane); sq += t * t; }
#pragma unroll
    for (int i = 0; i < 4; ++i) { float t = ldA(pr + 384 + i * 64 + lane); skv += t * t; }
    sq = wave_sum(sq); skv = wave_sum(skv);
#if EXACT
    if (lane == 0) { p.RQ[tok] = rsqrtf(sq * (1.f / 384.f) + EPSF); p.RKV[tok] = rsqrtf(skv * (1.f / 256.f) + EPSF); }
#else
    {
      const float rq = rsqrtf(sq * (1.f / 384.f) + EPSF), rkv = rsqrtf(skv * (1.f / 256.f) + EPSF);
      const float* qg = p.q_g + (l >> 1) * 384; const float* kvg = p.kv_g + (l >> 1) * 256;
      AT* pw = p.PROJ + (size_t)tok * P1LD;
#pragma unroll
      for (int i = 0; i < 6; ++i) { int k = i * 64 + lane; stA(pw + k, ldA(pr + k) * rq * qg[k]); }
#pragma unroll
      for (int i = 0; i < 4; ++i) { int k = i * 64 + lane; stA(pw + 384 + k, ldA(pr + 384 + k) * rkv * kvg[k]); }
    }
#endif
    float kr = lane < 32 ? ldA(pr + 640 + lane) : 0.f;
    float other = __shfl_xor(kr, 16);
    int b, kpos; float outv = kr;
    if (tok < NCTX) { b = tok >> 8; kpos = tok & 255; }
    else {
      int t = (tok - NCTX) & 4095; b = (tok - NCTX) >> 12; kpos = CTXL + t;
      int i = lane & 15;
      float cs = p.cs2c[t * 16 + i], sn = p.cs2s[t * 16 + i];
      outv = (lane & 16) ? (other * sn + kr * cs) : (kr * cs - other * sn);
    }
#if EXACT
    if (lane < 32) {
      for (int h = 0; h < 16; ++h) stA(p.Kb + ((size_t)(b * 16 + h) * KVL + kpos) * 96 + 64 + lane, outv);
    }
#else
    if (lane < 32) stA(p.KR + (size_t)tok * 32 + lane, outv);
#endif
    (void)b; (void)kpos;
  }
}
__device__ __forceinline__ void ph_M2(const Params& p, int l, int bid, int nb, char* lds) {
  const int li = l >> 1;
  float* stage = (float*)lds;
  const float* wq = p.w_uq + (size_t)li * 384 * 1536;
  const float* wkv = p.w_ukv + (size_t)li * 256 * 2048;
  const float* qg = p.q_g + li * 384;
  const float* kvg = p.kv_g + li * 256;
  const int NQ = NRT * 12, NKV = NRT * 16;
  for (int item = bid; item < NQ + NKV; item += nb) {
    if (item < NQ) {
      int ct = item % 12, rt = item / 12;
      engine(lds, 384,
             [&](int r, int k) { int tok = rt * 128 + r; return ldA(p.PROJ + (size_t)tok * P1LD + k) * p.RQ[tok] * qg[k]; },
             [&](int k, int c) { return wq[(size_t)k * 1536 + ct * 128 + c]; });
      EPI_BEGIN
        int tok = rt * 128 + row, col = ct * 128 + c4, head = col / 96, d = col % 96;
        AT* dst = p.Ql + (size_t)tok * QLD + head * 96 + d;
        stA4(dst, v);
      EPI_END
    } else {
      int it = item - NQ, h = it & 15, rt = it >> 4;
      engine(lds, 256,
             [&](int r, int k) { int tok = rt * 128 + r; return ldA(p.PROJ + (size_t)tok * P1LD + 384 + k) * p.RKV[tok] * kvg[k]; },
             [&](int k, int c) { return wkv[(size_t)k * 2048 + h * 128 + c]; });
      EPI_BEGIN
        int tok = rt * 128 + row, b, kpos;
        if (tok < NCTX) { b = tok >> 8; kpos = tok & 255; } else { int tt = tok - NCTX; b = tt >> 12; kpos = CTXL + (tt & 4095); }
        if (c4 < 64) stA4(p.Kb + ((size_t)(b * 16 + h) * KVL + kpos) * 96 + c4, v);
        else stA4(p.Vb + ((size_t)(b * 16 + h) * KVL + kpos) * 64 + c4 - 64, v);
      EPI_END
    }
  }
}
__device__ __forceinline__ void ph_ATT(const Params& p, int l, int bid, int nb, char* lds) {
  float* Ks = (float*)lds;
  float* Vs = Ks + 64 * 97;
  float* Qs = Vs + 64 * 64;
  const int wave = tidx() >> 6, lane = tidx() & 63;
  const int NLAT = NBAT * 16 * 64, NCT = (l == 1) ? NBAT * 16 * 4 : 0;
  const float scale = 0.10206207261596577f;
  for (int item = bid; item < NLAT + NCT; item += nb) {
    bool lat = item < NLAT;
    int qb, bh, nkeys;
    if (lat) { qb = item & 63; bh = item >> 6; nkeys = KVL; } else { int it = item - NLAT; qb = it & 3; bh = it >> 2; nkeys = CTXL; }
    int b = bh >> 4, h = bh & 15;
    const AT* Q = p.Ql + (size_t)(lat ? NCTX + b * SEQ + qb * 64 : b * CTXL + qb * 64) * QLD + h * 96;
    __syncthreads();
    for (int e = tidx(); e < 64 * 96; e += 256) {
      int r = e / 96, d = e % 96;
      float val;
      if (lat && d >= 64) {
        int t = qb * 64 + r, i = (d - 64) & 15;
        float x1 = ldA(Q + (size_t)r * QLD + 64 + i), x2 = ldA(Q + (size_t)r * QLD + 80 + i);
        float cs = p.cs2c[t * 16 + i], sn = p.cs2s[t * 16 + i];
        val = d < 80 ? x1 * cs - x2 * sn : x1 * sn + x2 * cs;
      } else val = ldA(Q + (size_t)r * QLD + d);
      Qs[e] = val * scale;
    }
    float* Os = Qs + 64 * 96;
    float* Ms = Os + 64 * 64;
    float* Ls = Ms + 64;
    for (int e = tidx(); e < 64 * 64; e += 256) Os[e] = 0.f;
    if (tidx() < 64) { Ms[tidx()] = -3.0e38f; Ls[tidx()] = 0.f; }
    const AT* Kg = p.Kb + (size_t)bh * KVL * 96;
    const AT* Vg = p.Vb + (size_t)bh * KVL * 64;
    for (int kt = 0; kt < nkeys; kt += 64) {
      __syncthreads();
      for (int e = tidx(); e < 64 * 96; e += 256) { int r = e / 96, d = e % 96; Ks[r * 97 + d] = ldA(Kg + (size_t)(kt + r) * 96 + d); }
      for (int e = tidx(); e < 64 * 64; e += 256) Vs[e] = ldA(Vg + (size_t)kt * 64 + e);
      __syncthreads();
#pragma unroll 1
      for (int g = 0; g < 4; ++g) {
        float s0 = 0.f, s1 = 0.f, s2 = 0.f, s3 = 0.f;
        const int q0 = wave * 16 + g * 4;
        const float* qp = Qs + q0 * 96;
        for (int d = 0; d < 96; ++d) {
          float kv = Ks[lane * 97 + d];
          s0 = fmaf(qp[d], kv, s0); s1 = fmaf(qp[96 + d], kv, s1); s2 = fmaf(qp[192 + d], kv, s2); s3 = fmaf(qp[288 + d], kv, s3);
        }
        float p0, p1, p2, p3, o0, o1, o2, o3;
#define ATT_ROW(SI, PI, OI, I) { float mold = Ms[q0 + I]; float mx = wave_max(SI); float mn = fmaxf(mold, mx); float alpha = expf(mold - mn); \
          PI = expf(SI - mn); float sm = wave_sum(PI); OI = Os[(q0 + I) * 64 + lane] * alpha; if (lane == 0) { Ls[q0 + I] = Ls[q0 + I] * alpha + sm; Ms[q0 + I] = mn; } }
        ATT_ROW(s0, p0, o0, 0) ATT_ROW(s1, p1, o1, 1) ATT_ROW(s2, p2, o2, 2) ATT_ROW(s3, p3, o3, 3)
        for (int j = 0; j < 64; ++j) {
          float vv = Vs[j * 64 + lane];
          o0 = fmaf(__int_as_float(__builtin_amdgcn_readlane(__float_as_int(p0), j)), vv, o0);
          o1 = fmaf(__int_as_float(__builtin_amdgcn_readlane(__float_as_int(p1), j)), vv, o1);
          o2 = fmaf(__int_as_float(__builtin_amdgcn_readlane(__float_as_int(p2), j)), vv, o2);
          o3 = fmaf(__int_as_float(__builtin_amdgcn_readlane(__float_as_int(p3), j)), vv, o3);
        }
        Os[(q0 + 0) * 64 + lane] = o0; Os[(q0 + 1) * 64 + lane] = o1; Os[(q0 + 2) * 64 + lane] = o2; Os[(q0 + 3) * 64 + lane] = o3;
      }
    }
    __syncthreads();
    for (int qi = 0; qi < 16; ++qi) {
      int r = qb * 64 + wave * 16 + qi;
      int tok = lat ? NCTX + b * SEQ + r : b * CTXL + r;
      stA(p.MIX + (size_t)tok * 1024 + h * 64 + lane, Os[(wave * 16 + qi) * 64 + lane] / Ls[wave * 16 + qi]);
    }
  }
}


#if !EXACT
__device__ __forceinline__ void ph_T1_f(const Params& p, int l, int bid, int nb) {
  const int wave = tidx() >> 6, lane = tidx() & 63;
  const float* g = p.norm_g + (l * 2 + 0) * 1024;
  for (int pair = bid * 4 + wave; pair < NTOK / 2; pair += nb * 4) {
    float v[2][16];
    int mrs[2];
#pragma unroll
    for (int u = 0; u < 2; ++u) {
      const int tok = pair * 2 + u;
      const int mr = tok_modrow(tok); mrs[u] = mr;
      const float* src = (l == 0) ? (tok < NCTX ? p.ctx + (size_t)tok * 1024 : p.x + (size_t)(tok - NCTX) * 1024) : p.X + (size_t)tok * 1024;
#pragma unroll
      for (int i = 0; i < 4; ++i) { const fx4 t4 = *(const fx4*)(src + i * 256 + lane * 4); v[u][i * 4] = t4.x; v[u][i * 4 + 1] = t4.y; v[u][i * 4 + 2] = t4.z; v[u][i * 4 + 3] = t4.w; }
      if (l > 0) {
        const float* gm = p.mod + ((size_t)(l - 1) * 5 + mr) * 6144 + 5 * 1024;
        const AT* y0 = p.Y + (size_t)(tok * 2) * 1024;
#pragma unroll
        for (int i = 0; i < 4; ++i) {
          const int col = i * 256 + lane * 4;
          const u32x2 a = *(const u32x2*)(y0 + col), b = *(const u32x2*)(y0 + 1024 + col);
          const fx4 gg = *(const fx4*)(gm + col);
          v[u][i * 4 + 0] += gg.x * (bf_lo(a.x) + bf_lo(b.x)); v[u][i * 4 + 1] += gg.y * (bf_hi(a.x) + bf_hi(b.x));
          v[u][i * 4 + 2] += gg.z * (bf_lo(a.y) + bf_lo(b.y)); v[u][i * 4 + 3] += gg.w * (bf_hi(a.y) + bf_hi(b.y));
        }
      }
    }
#pragma unroll
    for (int u = 0; u < 2; ++u) {
      const int tok = pair * 2 + u;
      float ss = 0.f;
#pragma unroll
      for (int i = 0; i < 16; ++i) ss += v[u][i] * v[u][i];
      ss = wave_sum(ss);
      const float rstd = rsqrtf(ss * (1.f / 1024.f) + EPSF);
      const float* md = p.mod + ((size_t)l * 5 + mrs[u]) * 6144;
#pragma unroll
      for (int i = 0; i < 4; ++i) {
        const int col = i * 256 + lane * 4;
        fx4 xo = {v[u][i * 4], v[u][i * 4 + 1], v[u][i * 4 + 2], v[u][i * 4 + 3]};
        *(fx4*)(p.X + (size_t)tok * 1024 + col) = xo;
        const fx4 gg = *(const fx4*)(g + col), sc = *(const fx4*)(md + 1024 + col), sh = *(const fx4*)(md + col);
        u32x2 o;
        o.x = pk2(xo.x * rstd * gg.x * (1.f + sc.x) + sh.x, xo.y * rstd * gg.y * (1.f + sc.y) + sh.y);
        o.y = pk2(xo.z * rstd * gg.z * (1.f + sc.z) + sh.z, xo.w * rstd * gg.w * (1.f + sc.w) + sh.w);
        *(u32x2*)(p.H + (size_t)tok * 1024 + col) = o;
      }
    }
  }
}
__device__ __forceinline__ void ph_final_f(const Params& p, int bid, int nb) {
  const int wave = tidx() >> 6, lane = tidx() & 63;
  for (int pair = NCTX / 2 + bid * 4 + wave; pair < NTOK / 2; pair += nb * 4) {
    float v[2][16];
#pragma unroll
    for (int u = 0; u < 2; ++u) {
      const int tok = pair * 2 + u;
      const int mr = tok_modrow(tok);
      const float* src = p.X + (size_t)tok * 1024;
      const float* gm = p.mod + ((size_t)3 * 5 + mr) * 6144 + 5 * 1024;
      const AT* y0 = p.Y + (size_t)(tok * 2) * 1024;
#pragma unroll
      for (int i = 0; i < 4; ++i) {
        const int col = i * 256 + lane * 4;
        const fx4 t4 = *(const fx4*)(src + col);
        const u32x2 a = *(const u32x2*)(y0 + col), b = *(const u32x2*)(y0 + 1024 + col);
        const fx4 gg = *(const fx4*)(gm + col);
        v[u][i * 4 + 0] = t4.x + gg.x * (bf_lo(a.x) + bf_lo(b.x)); v[u][i * 4 + 1] = t4.y + gg.y * (bf_hi(a.x) + bf_hi(b.x));
        v[u][i * 4 + 2] = t4.z + gg.z * (bf_lo(a.y) + bf_lo(b.y)); v[u][i * 4 + 3] = t4.w + gg.w * (bf_hi(a.y) + bf_hi(b.y));
      }
    }
#pragma unroll
    for (int u = 0; u < 2; ++u) {
      const int tok = pair * 2 + u;
      float ss = 0.f;
#pragma unroll
      for (int i = 0; i < 16; ++i) ss += v[u][i] * v[u][i];
      ss = wave_sum(ss);
      const float rstd = rsqrtf(ss * (1.f / 1024.f) + EPSF);
#pragma unroll
      for (int i = 0; i < 4; ++i) {
        const int col = i * 256 + lane * 4;
        const fx4 fg = *(const fx4*)(p.final_g + col);
        fx4 o = {v[u][i * 4] * rstd * fg.x, v[u][i * 4 + 1] * rstd * fg.y, v[u][i * 4 + 2] * rstd * fg.z, v[u][i * 4 + 3] * rstd * fg.w};
        *(fx4*)(p.out + (size_t)(tok - NCTX) * 1024 + col) = o;
      }
    }
  }
}
#endif
#if !EXACT
template <int EPI>
__device__ __forceinline__ void ph_gemm_store_f(const Params& p, const AT* A, int lda, const AT* W, int K, int N, AT* O, int ldo, int bid, int nb, char* lds) {
  float* stage = (float*)lds;
  const int nct = (N + 127) / 128;
  const int nitems = NRT * nct;
  for (int item = bid; item < nitems; item += nb) {
    int ct = item % nct, rt = item / nct;
    f32x4 acc[4][4]; acc_zero(acc);
    {
      const int r0 = tidx() >> 2, co = glds_chunk_off();
      const AT* a0 = A + (size_t)(rt * 128 + r0) * lda + co;
      const int n0 = min(ct * 128 + r0, N - 1), n1 = min(ct * 128 + r0 + 64, N - 1);
      gemm_core_g(lds, K / 32, a0, a0 + (size_t)64 * lda, W + (size_t)n0 * K + co, W + (size_t)n1 * K + co, acc);
    }
    acc_to_stage(lds, acc);
    const float sc = (EPI == 1 && ct >= 4 && ct < 8) ? 0.08838834764831845f : 1.f;
    if (EPI == 1 && ct < 8 && rt >= 8) {
      EPI_BEGIN
        int tok = rt * 128 + row, t = (tok - NCTX) & 4095;
        float4 cs = *(const float4*)(p.cs1c + t * 64 + (c4 & 63)), sn = *(const float4*)(p.cs1s + t * 64 + (c4 & 63));
        float4 o = *(const float4*)(stage + row * ST_LD + (c4 ^ 64));
        float4 r;
        if (c4 < 64) { r.x = v.x * cs.x - o.x * sn.x; r.y = v.y * cs.y - o.y * sn.y; r.z = v.z * cs.z - o.z * sn.z; r.w = v.w * cs.w - o.w * sn.w; }
        else { r.x = o.x * sn.x + v.x * cs.x; r.y = o.y * sn.y + v.y * cs.y; r.z = o.z * sn.z + v.z * cs.z; r.w = o.w * sn.w + v.w * cs.w; }
        r.x *= sc; r.y *= sc; r.z *= sc; r.w *= sc;
        st4bf(O + (size_t)tok * ldo + ct * 128 + c4, r);
      EPI_END
    } else {
      EPI_BEGIN
        int col = ct * 128 + c4;
        if (col < N) st4bf(O + (size_t)(rt * 128 + row) * ldo + col, make_float4(v.x * sc, v.y * sc, v.z * sc, v.w * sc));
      EPI_END
    }
  }
}
__device__ __forceinline__ void ph_gemm_resid_f(const Params& p, int l, const AT* A, const AT* W, int rt0, int bid, int nb, char* lds) {
  float* stage = (float*)lds;
  const int nitems = (NRT - rt0) * 8;
  for (int item = bid; item < nitems; item += nb) {
    int ct = item & 7, rt = rt0 + (item >> 3);
    f32x4 acc[4][4]; acc_zero(acc);
    {
      const int r0 = tidx() >> 2, co = glds_chunk_off();
      const AT* a0 = A + (size_t)(rt * 128 + r0) * 1024 + co;
      const AT* b0 = W + (size_t)(ct * 128 + r0) * 1024 + co;
      gemm_core_g(lds, 32, a0, a0 + 64 * 1024, b0, b0 + 64 * 1024, acc);
    }
    acc_to_stage(lds, acc);
    int mr = tok_modrow(rt * 128);
    const float* gm = p.mod + ((size_t)l * 5 + mr) * 6144 + 2 * 1024 + ct * 128;
    EPI_BEGIN
      float* xp = p.X + (size_t)(rt * 128 + row) * 1024 + ct * 128 + c4;
      float4 xv = *(float4*)xp;
      float4 g4 = *(const float4*)(gm + c4);
      xv.x += g4.x * v.x; xv.y += g4.y * v.y; xv.z += g4.z * v.z; xv.w += g4.w * v.w;
      *(float4*)xp = xv;
      const float ssq = half_sum(xv.x * xv.x + xv.y * xv.y + xv.z * xv.z + xv.w * xv.w);
      if ((tidx() & 31) == 0) p.SSQ[(size_t)ct * NTOK + rt * 128 + row] = ssq;
    EPI_END
  }
}
__device__ __forceinline__ void ph_E1_f(const Params& p, int l, int bid, int nb, char* lds) {
  float* stage = (float*)lds;
  int* si = (int*)(lds + MISC_OFF);
  moe_setup(p, l, si);
  const int nblk = si[97];
  for (int item = bid; item < nblk * 8; item += nb) {
    int nt = item & 7, bi = item >> 3;
    int e = 0;
    while (e < 31 && si[65 + e + 1] <= bi) ++e;
    int rb = bi - si[65 + e], cnt = si[e], base = si[32 + e];
    const int* lst = p.list + (size_t)e * NTOK + rb * 128;
    int nrow = cnt - rb * 128; if (nrow > 128) nrow = 128;
    const float* wg = p.w_gate + ((size_t)(l * 32 + e) * 1024) * 512 + nt * 64;
    const float* wu = p.w_up + ((size_t)(l * 32 + e) * 1024) * 512 + nt * 64;
    LdRow<false> la; la.init([&](int r) { return p.H + (size_t)(r < nrow ? (__hip_atomic_load(&lst[r], __ATOMIC_RELAXED, __HIP_MEMORY_SCOPE_AGENT) >> 1) : 0) * 1024; });
    LdColF lb; lb.init(wg, 512, 128);
    { int half = tidx() & 1, n4 = (tidx() >> 1) & 31, ch = tidx() >> 6;
      lb.p = (n4 < 16 ? wg : wu) + (size_t)(ch * 8 + half * 4) * 512 + 4 * (n4 & 15); }
    f32x4 acc[4][4]; acc_zero(acc);
    gemm_core(lds, 32, la, lb, acc);
    acc_to_stage(lds, acc);
    for (int e_ = tidx(); e_ < 128 * 16; e_ += 256) {
      int row = e_ >> 4, c4 = (e_ & 15) << 2;
      if (row < nrow) {
        float4 gv = *(const float4*)(stage + row * ST_LD + c4), uv = *(const float4*)(stage + row * ST_LD + 64 + c4);
        float4 o = make_float4(silu_f(gv.x) * uv.x, silu_f(gv.y) * uv.y, silu_f(gv.z) * uv.z, silu_f(gv.w) * uv.w);
        st4bf(p.HB + (size_t)(base + rb * 128 + row) * 512 + nt * 64 + c4, o);
      }
    }
  }
}
__device__ __forceinline__ void ph_E1_g(const Params& p, int l, int bid, int nb, char* lds) {
  float* stage = (float*)lds;
  int* si = (int*)(lds + MISC_OFF);
  moe_setup(p, l, si);
  const int nblk = si[97];
  for (int item = bid; item < nblk * 8; item += nb) {
    int nt = item & 7, bi = item >> 3;
    int e = 0;
    while (e < 31 && si[65 + e + 1] <= bi) ++e;
    int rb = bi - si[65 + e], cnt = si[e], base = si[32 + e];
    const int* lst = p.list + (size_t)e * NTOK + rb * 128;
    int nrow = cnt - rb * 128; if (nrow > 128) nrow = 128;
    const AT* wgT = p.WM + WM_GATE + ((size_t)(l * 32 + e) * 512 + nt * 64) * 1024;
    const AT* wuT = p.WM + WM_UP + ((size_t)(l * 32 + e) * 512 + nt * 64) * 1024;
    AT* dst = p.HB + (size_t)(base + rb * 128) * 512 + nt * 64;
    const int r0 = tidx() >> 2, co = glds_chunk_off();
    const AT* a0 = p.H + (size_t)(r0 < nrow ? (lst[r0] >> 1) : 0) * 1024 + co;
    const AT* a1 = p.H + (size_t)(r0 + 64 < nrow ? (lst[r0 + 64] >> 1) : 0) * 1024 + co;
    f32x4 acc[4][4]; acc_zero(acc);
    gemm_core_g(lds, 32, a0, a1, wgT + (size_t)r0 * 1024 + co, wuT + (size_t)r0 * 1024 + co, acc);
    acc_to_stage(lds, acc);
    for (int e_ = tidx(); e_ < 128 * 16; e_ += 256) {
      const int row = e_ >> 4, c4 = (e_ & 15) << 2;
      if (row < nrow) {
        const float4 gv = *(const float4*)(stage + row * ST_LD + c4), uv = *(const float4*)(stage + row * ST_LD + 64 + c4);
        st4bf(dst + (size_t)row * 512 + c4, make_float4(silu_fast(gv.x) * uv.x, silu_fast(gv.y) * uv.y, silu_fast(gv.z) * uv.z, silu_fast(gv.w) * uv.w));
      }
    }
  }
}
__device__ __forceinline__ void ph_E2_f(const Params& p, int l, int bid, int nb, char* lds) {
  float* stage = (float*)lds;
  int* si = (int*)(lds + MISC_OFF);
  moe_setup(p, l, si);
  const int nblk = si[97];
  for (int item = bid; item < nblk * 8; item += nb) {
    int ct = item & 7, bi = item >> 3;
    int e = 0;
    while (e < 31 && si[65 + e + 1] <= bi) ++e;
    int rb = bi - si[65 + e], cnt = si[e], base = si[32 + e];
    const int* lst = p.list + (size_t)e * NTOK + rb * 128;
    int nrow = cnt - rb * 128; if (nrow > 128) nrow = 128;
    int* s_a = (int*)(lds + MISC_OFF + 512); float* s_w = (float*)(lds + MISC_OFF + 1024);
    __syncthreads();
    if (tidx() < 128) { const int r = tidx(); int a = r < nrow ? lst[r] : 0; s_a[r] = a; s_w[r] = r < nrow ? p.rw[a] : 0.f; }
    const AT* wdT = p.WM + WM_DOWN + ((size_t)(l * 32 + e) * 1024 + ct * 128) * 512;
    const AT* hb = p.HB + (size_t)(base + rb * 128) * 512;
    f32x4 acc[4][4]; acc_zero(acc);
    {
      const int r0 = tidx() >> 2, co = glds_chunk_off();
      const AT* a0 = hb + (size_t)(r0 < nrow ? r0 : 0) * 512 + co;
      const AT* a1 = hb + (size_t)(r0 + 64 < nrow ? r0 + 64 : 0) * 512 + co;
      gemm_core_g(lds, 16, a0, a1, wdT + (size_t)r0 * 512 + co, wdT + (size_t)(r0 + 64) * 512 + co, acc);
    }
    acc_to_stage(lds, acc);
    EPI_BEGIN
      if (row < nrow) {
        const int a = s_a[row];
        const float w = s_w[row];
        st4bf(p.Y + (size_t)a * 1024 + ct * 128 + c4, make_float4(v.x * w, v.y * w, v.z * w, v.w * w));
      }
    EPI_END
  }
}
__device__ __forceinline__ void ph_M2_f(const Params& p, int l, int bid, int nb, char* lds) {
  const int li = l >> 1;
  float* stage = (float*)lds;
  const AT* wq = p.WB + WB_UQ + (size_t)li * 384 * 1536;
  const AT* wkv = p.WB + WB_UKV + (size_t)li * 256 * 2048;
  const int NQ = NRT * 12, NKV = NRT * 16;
  for (int item = bid; item < NQ + NKV; item += nb) {
    if (item < NQ) {
      int ct = item % 12, rt = item / 12;
      f32x4 acc[4][4]; acc_zero(acc);
      {
        const int r0 = tidx() >> 2, co = glds_chunk_off();
        const AT* a0 = p.PROJ + (size_t)(rt * 128 + r0) * P1LD + co;
        const AT* b0 = wq + (size_t)(ct * 128 + r0) * 384 + co;
        gemm_core_g(lds, 12, a0, a0 + 64 * P1LD, b0, b0 + 64 * 384, acc);
      }
      acc_to_stage(lds, acc);
      EPI_BEGIN
        int tok = rt * 128 + row, col = ct * 128 + c4, head = col / 96, d = col % 96;
        const float rq = 1.f;
        AT* dst = p.Ql + (size_t)tok * QLD + head * 96 + d;
        st4bf(dst, make_float4(v.x * rq, v.y * rq, v.z * rq, v.w * rq));
      EPI_END
    } else {
      int it = item - NQ, h = it & 15, rt = it >> 4;
      f32x4 acc[4][4]; acc_zero(acc);
      {
        const int r0 = tidx() >> 2, co = glds_chunk_off();
        const AT* a0 = p.PROJ + (size_t)(rt * 128 + r0) * P1LD + 384 + co;
        const AT* b0 = wkv + (size_t)(h * 128 + r0) * 256 + co;
        gemm_core_g(lds, 8, a0, a0 + 64 * P1LD, b0, b0 + 64 * 256, acc);
      }
      acc_to_stage(lds, acc);
      EPI_BEGIN
        int tok = rt * 128 + row, b, kpos;
        const float rk = 1.f;
        if (tok < NCTX) { b = tok >> 8; kpos = tok & 255; } else { int tt = tok - NCTX; b = tt >> 12; kpos = CTXL + (tt & 4095); }
        float4 o = make_float4(v.x * rk, v.y * rk, v.z * rk, v.w * rk);
        if (c4 < 64) st4bf(p.Kb + ((size_t)(b * 16 + h) * KVL + kpos) * 96 + c4, o);
        else if (c4 < 96) *(u32x2*)(p.Kb + ((size_t)(b * 16 + h) * KVL + kpos) * 96 + c4) = *(const u32x2*)(p.KR + (size_t)tok * 32 + c4 - 64);
      EPI_END
      {
        int tok0 = rt * 128, b, kp0;
        if (tok0 < NCTX) { b = tok0 >> 8; kp0 = tok0 & 255; } else { int tt = tok0 - NCTX; b = tt >> 12; kp0 = CTXL + (tt & 4095); }
        for (int e_ = tidx(); e_ < 64 * 32; e_ += 256) {
          int dv = e_ >> 5, r4 = (e_ & 31) << 2;
          float x0 = stage[(r4 + 0) * ST_LD + 64 + dv];
          float x1 = stage[(r4 + 1) * ST_LD + 64 + dv];
          float x2 = stage[(r4 + 2) * ST_LD + 64 + dv];
          float x3 = stage[(r4 + 3) * ST_LD + 64 + dv];
          st4bf(p.Vt + ((size_t)(b * 16 + h) * 64 + dv) * KVL + kp0 + r4, make_float4(x0, x1, x2, x3));
        }
      }
    }
  }
}

__device__ __forceinline__ void ph_T2_f(const Params& p, int l, int bid, int nb, char* lds) {
  const int tid = tidx(), lane = tid & 63, wid = tid >> 6, fr = lane & 15, fq = lane >> 4;
  float* rs = (float*)lds + wid * 16;
  const float* g = p.norm_g + (l * 2 + 1) * 1024;
  const unsigned short* Whi = p.WR + (size_t)(l * 2 + 0) * 128 * 48 * 8;
  const unsigned short* Wlo = p.WR + (size_t)(l * 2 + 1) * 128 * 48 * 8;
  const int ibeg = (l == 3) ? NCTX / 16 : 0;
  const int nitem = NTOK / 16;
  for (int item0 = ibeg + bid * 2; item0 < nitem; item0 += nb * 2) {
    const int item = min(item0 + (wid >> 1), nitem - 1);
    const bool live = item0 + (wid >> 1) < nitem;
    const int kh = wid & 1;
    const int tok0 = item * 16;
    const int mr = tok_modrow(tok0);
    const float* md = p.mod + ((size_t)l * 5 + mr) * 6144;
    float rstd;
    {
      float ss = 0.f;
#pragma unroll
      for (int ct = 0; ct < 8; ++ct) ss += p.SSQ[(size_t)ct * NTOK + tok0 + fr];
      rstd = rsqrtf(ss * (1.f / 1024.f) + EPSF);
    }
    const float* xr = p.X + (size_t)(tok0 + fr) * 1024 + fq * 8 + kh * 512;
    AT* hr = p.H + (size_t)(tok0 + fr) * 1024 + fq * 8 + kh * 512;
    f32x4 acc[3];
    acc[0] = (f32x4){0.f, 0.f, 0.f, 0.f}; acc[1] = acc[0]; acc[2] = acc[0];
    fx4 xa = *(const fx4*)(xr), xb = *(const fx4*)(xr + 4);
    const size_t wo0 = ((size_t)(kh * 64 + fq) * 48 + fr) * 8;
    bf16x8 wh0 = *(const bf16x8*)(Whi + wo0), wh1 = *(const bf16x8*)(Whi + wo0 + 128), wh2 = *(const bf16x8*)(Whi + wo0 + 256);
    bf16x8 wl0 = *(const bf16x8*)(Wlo + wo0), wl1 = *(const bf16x8*)(Wlo + wo0 + 128), wl2 = *(const bf16x8*)(Wlo + wo0 + 256);
#pragma unroll 2
    for (int s = 0; s < 16; ++s) {
      const int k0 = kh * 512 + s * 32 + fq * 8;
      const int sn = min(s + 1, 15);
      const fx4 xan = *(const fx4*)(xr + sn * 32), xbn = *(const fx4*)(xr + sn * 32 + 4);
      const size_t won = wo0 + (size_t)sn * 4 * 48 * 8;
      const bf16x8 wh0n = *(const bf16x8*)(Whi + won), wh1n = *(const bf16x8*)(Whi + won + 128), wh2n = *(const bf16x8*)(Whi + won + 256);
      const bf16x8 wl0n = *(const bf16x8*)(Wlo + won), wl1n = *(const bf16x8*)(Wlo + won + 128), wl2n = *(const bf16x8*)(Wlo + won + 256);
      const fx4 g0 = *(const fx4*)(g + k0), g1 = *(const fx4*)(g + k0 + 4);
      const fx4 c0 = *(const fx4*)(md + 4 * 1024 + k0), c1 = *(const fx4*)(md + 4 * 1024 + k0 + 4);
      const fx4 s0 = *(const fx4*)(md + 3 * 1024 + k0), s1 = *(const fx4*)(md + 3 * 1024 + k0 + 4);
      float h[8];
      h[0] = xa.x * rstd * g0.x * (1.f + c0.x) + s0.x; h[1] = xa.y * rstd * g0.y * (1.f + c0.y) + s0.y;
      h[2] = xa.z * rstd * g0.z * (1.f + c0.z) + s0.z; h[3] = xa.w * rstd * g0.w * (1.f + c0.w) + s0.w;
      h[4] = xb.x * rstd * g1.x * (1.f + c1.x) + s1.x; h[5] = xb.y * rstd * g1.y * (1.f + c1.y) + s1.y;
      h[6] = xb.z * rstd * g1.z * (1.f + c1.z) + s1.z; h[7] = xb.w * rstd * g1.w * (1.f + c1.w) + s1.w;
      u32x4 hi;
      hi.x = pk2(h[0], h[1]); hi.y = pk2(h[2], h[3]); hi.z = pk2(h[4], h[5]); hi.w = pk2(h[6], h[7]);
      if (live) *(u32x4*)(hr + s * 32) = hi;
      u32x4 lo;
      lo.x = pk2(h[0] - bf_lo(hi.x), h[1] - bf_hi(hi.x)); lo.y = pk2(h[2] - bf_lo(hi.y), h[3] - bf_hi(hi.y));
      lo.z = pk2(h[4] - bf_lo(hi.z), h[5] - bf_hi(hi.z)); lo.w = pk2(h[6] - bf_lo(hi.w), h[7] - bf_hi(hi.w));
      const bf16x8 ahi = *(bf16x8*)&hi, alo = *(bf16x8*)&lo;
      acc[0] = __builtin_amdgcn_mfma_f32_16x16x32_bf16(ahi, wh0, acc[0], 0, 0, 0);
      acc[0] = __builtin_amdgcn_mfma_f32_16x16x32_bf16(alo, wh0, acc[0], 0, 0, 0);
      acc[0] = __builtin_amdgcn_mfma_f32_16x16x32_bf16(ahi, wl0, acc[0], 0, 0, 0);
      acc[1] = __builtin_amdgcn_mfma_f32_16x16x32_bf16(ahi, wh1, acc[1], 0, 0, 0);
      acc[1] = __builtin_amdgcn_mfma_f32_16x16x32_bf16(alo, wh1, acc[1], 0, 0, 0);
      acc[1] = __builtin_amdgcn_mfma_f32_16x16x32_bf16(ahi, wl1, acc[1], 0, 0, 0);
      acc[2] = __builtin_amdgcn_mfma_f32_16x16x32_bf16(ahi, wh2, acc[2], 0, 0, 0);
      acc[2] = __builtin_amdgcn_mfma_f32_16x16x32_bf16(alo, wh2, acc[2], 0, 0, 0);
      acc[2] = __builtin_amdgcn_mfma_f32_16x16x32_bf16(ahi, wl2, acc[2], 0, 0, 0);
      xa = xan; xb = xbn; wh0 = wh0n; wh1 = wh1n; wh2 = wh2n; wl0 = wl0n; wl1 = wl1n; wl2 = wl2n;
    }
    float* lgp = (float*)(lds + 256) + (wid >> 1) * 16 * 48;
    __syncthreads();
    if (kh == 1) {
#pragma unroll
      for (int t = 0; t < 3; ++t)
#pragma unroll
        for (int j = 0; j < 4; ++j) lgp[(4 * fq + j) * 48 + t * 16 + fr] = acc[t][j];
    }
    __syncthreads();
    if (kh == 0) {
#pragma unroll
      for (int t = 0; t < 3; ++t)
#pragma unroll
        for (int j = 0; j < 4; ++j) lgp[(4 * fq + j) * 48 + t * 16 + fr] += acc[t][j];
    }
    float* lg = lgp;
    if (kh == 0 && live && lane < 16) {
      const float* my = lg + lane * 48;
      const int tok = tok0 + lane;
      const float* gb = p.grp_b + l * 4;
      int gs = 0; float gm = my[0] + gb[0];
      for (int j = 1; j < 4; ++j) { float t = my[j] + gb[j]; if (t > gm) { gm = t; gs = j; } }
      float gsum = 0.f;
      for (int j = 0; j < 4; ++j) gsum += expf(my[j] + gb[j] - gm);
      float gtop = 1.f / gsum;
      const float* wlp = my + 4 + gs * 8;
      const float* eb = p.exp_b + l * 32 + gs * 8;
      int i0 = 0; float m0 = wlp[0] + eb[0];
      for (int j = 1; j < 8; ++j) { float t = wlp[j] + eb[j]; if (t > m0) { m0 = t; i0 = j; } }
      int i1 = -1; float m1 = -3.4e38f;
      for (int j = 0; j < 8; ++j) { float t = wlp[j] + eb[j]; if (j != i0 && t > m1) { m1 = t; i1 = j; } }
      float e1 = expf(m1 - m0);
      float p0 = 1.f / (1.f + e1), p1 = e1 / (1.f + e1);
      p.re[tok * 2] = gs * 8 + i0; p.re[tok * 2 + 1] = gs * 8 + i1;
      p.rw[tok * 2] = gtop * p0; p.rw[tok * 2 + 1] = gtop * p1;
    }
  }
}

constexpr int NSEG = 272;
template <class LB>
__device__ __forceinline__ void gemm_core_Alds(char* lds, const char* abuf, int nk, LB& lb, f32x4 (&acc)[4][4]) {
  const int lane = tidx() & 63, wid = tidx() >> 6, wr = wid >> 1, wc = wid & 1, fr = lane & 15, fq = lane >> 4;
  int ao[4], bo[4];
#pragma unroll
  for (int t = 0; t < 4; ++t) { ao[t] = frag_off<false>(wr * 64, t, fr, fq); bo[t] = frag_off<LB::COL>(wc * 64, t, fr, fq); }
  lb.template fetch<0>(0); lb.template fetch<1>(1);
  __syncthreads();
  lb.template commit<0>(lds + FBUF_B0, 0); lb.template commit<1>(lds + FBUF_B0 + 8192, 1);
  __syncthreads();
  for (int kt = 0; kt < nk; kt += 2) {
    const int cur = (kt & 2) << 13;
    const bool more = kt + 2 < nk;
    if (more) { const int k0 = kt + 2; lb.template fetch<0>(k0); lb.template fetch<1>(k0 + 1); }
    mma_step(abuf + kt * 8192, lds + FBUF_B0 + cur, ao, bo, acc);
    mma_step(abuf + (kt + 1) * 8192, lds + FBUF_B0 + cur + 8192, ao, bo, acc);
    if (more) { const int nxt = cur ^ 16384; lb.template commit<0>(lds + FBUF_B0 + nxt, kt + 2); lb.template commit<1>(lds + FBUF_B0 + nxt + 8192, kt + 3); }
    __syncthreads();
  }
}
constexpr float LOG2E = 1.4426950408889634f;

template <bool FIN>
__device__ __forceinline__ void lru_local_f(const Params& p, int li, int b, int c, int kb, char* lds) {
  const int tid = tidx(), lane = tid & 63, wid = tid >> 6, fr = lane & 15, fq = lane >> 4;
  char* Ub = lds;
  char* Wb = lds + 16384;
  const int tok0 = chunk_tok0(b, c);
  const int seqbase = c < 2 ? b * CTXL : NCTX + b * SEQ;
  const int n = c < 2 ? CTXL : SEQ;
  const int t0 = tok0 - seqbase;
  __syncthreads();
#pragma unroll
  for (int i = 0; i < 4; ++i) {
    const int e = tid + 256 * i, pos = e >> 3, c8 = e & 7, ch0 = kb * 64 + c8 * 8, t = t0 + pos;
    float a[8];
    { fx4 b0 = *(const fx4*)(p.conv_b + li * 512 + ch0), b1 = *(const fx4*)(p.conv_b + li * 512 + ch0 + 4);
      a[0] = b0.x; a[1] = b0.y; a[2] = b0.z; a[3] = b0.w; a[4] = b1.x; a[5] = b1.y; a[6] = b1.z; a[7] = b1.w; }
#pragma unroll
    for (int tap = 0; tap < 4; ++tap) {
      const int tt = t + tap - 2;
      if (tt >= 0 && tt < n) {
        const u32x4 x = *(const u32x4*)(p.PROJ + (size_t)(seqbase + tt) * 3072 + 2048 + ch0);
        const float* w = p.conv_w + (li * 4 + tap) * 512 + ch0;
        const fx4 w0 = *(const fx4*)w, w1 = *(const fx4*)(w + 4);
        a[0] = fmaf(w0.x, bf_lo(x.x), a[0]); a[1] = fmaf(w0.y, bf_hi(x.x), a[1]); a[2] = fmaf(w0.z, bf_lo(x.y), a[2]); a[3] = fmaf(w0.w, bf_hi(x.y), a[3]);
        a[4] = fmaf(w1.x, bf_lo(x.z), a[4]); a[5] = fmaf(w1.y, bf_hi(x.z), a[5]); a[6] = fmaf(w1.z, bf_lo(x.w), a[6]); a[7] = fmaf(w1.w, bf_hi(x.w), a[7]);
      }
    }
    u32x4 o; o.x = pk2(a[0], a[1]); o.y = pk2(a[2], a[3]); o.z = pk2(a[4], a[5]); o.w = pk2(a[6], a[7]);
    *(u32x4*)(Ub + (c8 >> 2) * 8192 + row_off(pos, c8 & 3)) = o;
  }
  {
    const int half = tid & 1, n4 = (tid >> 1) & 31, ch = tid >> 6;
#pragma unroll
    for (int kt = 0; kt < 2; ++kt)
#pragma unroll
      for (int nh = 0; nh < 2; ++nh) {
        const int ncol = nh * 128 + 4 * n4, dg = ncol >> 6, j = ncol & 63, d = dg >> 1, g = dg & 1;
        const float* src = p.gate_w + ((size_t)(((li * 2 + d) * 2 + g) * 8 + kb) * 64 + (kt * 32 + ch * 8 + half * 4)) * 64 + j;
        const fx4 w0 = *(const fx4*)src, w1 = *(const fx4*)(src + 64), w2 = *(const fx4*)(src + 128), w3 = *(const fx4*)(src + 192);
        char* base = Wb + kt * 16384 + (ch * 256 + nh * 128) * 16 + half * 8;
        const int pe = col_perm(4 * n4) * 16;
        u32x2 tv;
        tv.x = pk2(w0.x, w1.x); tv.y = pk2(w2.x, w3.x); *(u32x2*)(base + pe) = tv;
        tv.x = pk2(w0.y, w1.y); tv.y = pk2(w2.y, w3.y); *(u32x2*)(base + (pe ^ 64) + 256) = tv;
        tv.x = pk2(w0.z, w1.z); tv.y = pk2(w2.z, w3.z); *(u32x2*)(base + pe + 128) = tv;
        tv.x = pk2(w0.w, w1.w); tv.y = pk2(w2.w, w3.w); *(u32x2*)(base + (pe ^ 64) + 384) = tv;
      }
  }
  __syncthreads();
  const int sbase = (c < 2 ? c * 8 : 16 + (c - 2) * 8) + wid * 2;
  __hip_bfloat16* ot = (__hip_bfloat16*)(lds + 49152);
#pragma unroll 1
  for (int d = 0; d < 2; ++d) {
    f32x4 acc[2][8];
#pragma unroll
    for (int m = 0; m < 2; ++m)
#pragma unroll
      for (int nn = 0; nn < 8; ++nn) acc[m][nn] = (f32x4){0.f, 0.f, 0.f, 0.f};
#pragma unroll
    for (int kt = 0; kt < 2; ++kt) {
      bf16x8 af0 = *(const bf16x8*)(Ub + kt * 8192 + row_off(wid * 32 + fr, fq));
      bf16x8 af1 = *(const bf16x8*)(Ub + kt * 8192 + row_off(wid * 32 + 16 + fr, fq));
#pragma unroll
      for (int nn = 0; nn < 8; ++nn) {
        bf16x8 bfv = *(const bf16x8*)(Wb + kt * 16384 + (fq * 256 + d * 128 + col_perm(nn * 16 + fr)) * 16);
        acc[0][nn] = __builtin_amdgcn_mfma_f32_16x16x32_bf16(af0, bfv, acc[0][nn], 0, 0, 0);
        acc[1][nn] = __builtin_amdgcn_mfma_f32_16x16x32_bf16(af1, bfv, acc[1][nn], 0, 0, 0);
      }
    }
#pragma unroll
    for (int q4 = 0; q4 < 4; ++q4) {
      const int chl = q4 * 16 + fr, ch = kb * 64 + chl;
      const float sp = softplus_f(-p.lam[(li * 2 + d) * 512 + ch]);
      const float br = p.gate_b[((li * 2 + d) * 2 + 0) * 512 + ch], bi = p.gate_b[((li * 2 + d) * 2 + 1) * 512 + ch];
#pragma unroll
      for (int mt = 0; mt < 2; ++mt) {
        float hv[4], Av[4], av[4], bv[4];
        float h = 0.f, A = 1.f;
#pragma unroll
        for (int s4 = 0; s4 < 4; ++s4) {
          const int jj = d ? 3 - s4 : s4;
          const int pos = wid * 32 + mt * 16 + fq * 4 + jj;
          const float r = __builtin_amdgcn_rcpf(1.f + __builtin_amdgcn_exp2f(-LOG2E * ((d ? acc[mt][q4][3 - s4] : acc[mt][q4][s4]) + br)));
          const float ig = __builtin_amdgcn_rcpf(1.f + __builtin_amdgcn_exp2f(-LOG2E * ((d ? acc[mt][4 + q4][3 - s4] : acc[mt][4 + q4][s4]) + bi)));
          const float uval = __bfloat162float(*(const __hip_bfloat16*)(Ub + (chl >> 5) * 8192 + row_off(pos, (chl & 31) >> 3) + (chl & 7) * 2));
          const float a = __builtin_amdgcn_exp2f(-8.f * LOG2E * r * sp);
          const float bt = __builtin_amdgcn_sqrtf(fmaxf(1.f - a * a, 0.f)) * (ig * uval);
          h = fmaf(a, h, bt); A *= a;
          if (d) { hv[3 - s4] = h; Av[3 - s4] = A; av[3 - s4] = a; bv[3 - s4] = bt; } else { hv[s4] = h; Av[s4] = A; av[s4] = a; bv[s4] = bt; }
        }
        float Ai = A, Hi = h;
#pragma unroll
        for (int st = 16; st <= 32; st <<= 1) {
          float Ao = d ? __shfl_down(Ai, st) : __shfl_up(Ai, st);
          float Ho = d ? __shfl_down(Hi, st) : __shfl_up(Hi, st);
          const bool has = d ? (fq + (st >> 4) <= 3) : (fq >= (st >> 4));
          if (has) { Hi = fmaf(Ai, Ho, Hi); Ai = Ai * Ao; }
        }
        float Ae = d ? __shfl_down(Ai, 16) : __shfl_up(Ai, 16);
        float He = d ? __shfl_down(Hi, 16) : __shfl_up(Hi, 16);
        const bool first = d ? (fq == 3) : (fq == 0);
        if (first) { Ae = 1.f; He = 0.f; }
        if (!FIN) {
          const bool last = d ? (fq == 0) : (fq == 3);
          if (last) {
            const size_t so = ((size_t)(d * 4 + b) * NSEG + sbase + mt) * 512 + ch;
            p.CHA[so] = Ai; p.CHH[so] = Hi;
          }
        } else {
          const float cin = p.CAR[((size_t)(d * 4 + b) * NSEG + sbase + mt) * 512 + ch];
          float hst = fmaf(Ae, cin, He);
#pragma unroll
          for (int s4 = 0; s4 < 4; ++s4) {
            hst = d ? fmaf(av[3 - s4], hst, bv[3 - s4]) : fmaf(av[s4], hst, bv[s4]);
            const int jj = d ? 3 - s4 : s4;
            const int pos = wid * 32 + mt * 16 + fq * 4 + jj;
            if (d == 0) ot[pos * 64 + chl] = __float2bfloat16(hst);
            else ot[pos * 64 + chl] = __float2bfloat16(__bfloat162float(ot[pos * 64 + chl]) + hst);
          }
        }
        (void)hv; (void)Av;
        __builtin_amdgcn_sched_barrier(0);
      }
    }
  }
  if (FIN) {
    __syncthreads();
    {
      const int row = tid >> 1, half = tid & 1;
      const u32x4* srcv = (const u32x4*)(ot + row * 64 + half * 32);
      const u32x4* yv = (const u32x4*)(p.PROJ + (size_t)(tok0 + row) * 3072 + 2560 + kb * 64 + half * 32);
      u32x4* dstv = (u32x4*)(p.MIX + (size_t)(tok0 + row) * 1024 + 512 + kb * 64 + half * 32);
#pragma unroll
      for (int q = 0; q < 4; ++q) {
        const u32x4 hh = srcv[q], yy = yv[q];
        u32x4 o;
        o.x = pk2(bf_lo(hh.x) * gelu_tanh_fast(bf_lo(yy.x)), bf_hi(hh.x) * gelu_tanh_fast(bf_hi(yy.x)));
        o.y = pk2(bf_lo(hh.y) * gelu_tanh_fast(bf_lo(yy.y)), bf_hi(hh.y) * gelu_tanh_fast(bf_hi(yy.y)));
        o.z = pk2(bf_lo(hh.z) * gelu_tanh_fast(bf_lo(yy.z)), bf_hi(hh.z) * gelu_tanh_fast(bf_hi(yy.z)));
        o.w = pk2(bf_lo(hh.w) * gelu_tanh_fast(bf_lo(yy.w)), bf_hi(hh.w) * gelu_tanh_fast(bf_hi(yy.w)));
        dstv[q] = o;
      }
    }
  }
}

__device__ __forceinline__ void ph_R1_f(const Params& p, int l, int bid, int nb, char* lds) {
  const int li = l >> 1;
  float* stage = (float*)lds;
  const int NRET = NBAT * 4 * NCH;
  const int NLRU = NBAT * NCH * 8;
  for (int item = bid; item < NRET + NLRU; item += nb) {
    if (item < NRET) {
      int c = item % NCH, bh = item / NCH, h = bh & 3, b = bh >> 2;
      const AT* base = p.PROJ + (size_t)chunk_tok0(b, c) * 3072 + h * 128;
#pragma unroll
      for (int d = 0; d < 2; ++d) {
        const float lg2 = -softplus_f(-p.ret_decay[(li * 2 + d) * 4 + h]) * LOG2E;
        f32x4 acc[4][4]; acc_zero(acc);
        LdColH<0> la; la.init(base + 1024, 3072, 0.f);
        if (d == 0) { LdColH<1> lb; lb.init(base + 512, 3072, lg2); gemm_core<LdColH<0>, LdColH<1>, 0, false>(lds, 4, la, lb, acc); }
        else        { LdColH<2> lb; lb.init(base + 512, 3072, lg2); gemm_core<LdColH<0>, LdColH<2>, 0, false>(lds, 4, la, lb, acc); }
        acc_to_stage(lds, acc);
        float* U = p.U + ((size_t)((b * 4 + h) * 2 + d) * NCH + c) * 16384;
        EPI_BEGIN
          *(float4*)(U + row * 128 + c4) = v;
        EPI_END
      }
    } else {
      int it = item - NRET;
      int kb = it & 7, c = (it >> 3) % NCH, b = it / (8 * NCH);
      lru_local_f<false>(p, li, b, c, kb, lds);
    }
  }
}
__device__ __forceinline__ void ph_R2_f(const Params& p, int l, int bid, int nb) {
  const int li = l >> 1;
  const bool lru_blk = bid >= nb - 16;
  int gtid = (lru_blk ? bid - (nb - 16) : bid) * 256 + tidx(), gsz = (lru_blk ? 16 : nb - 16) * 256;
  if (lru_blk)
  for (int i = gtid; i < 2 * 4 * 512; i += gsz) {
    int ch = i & 511, db = i >> 9, d = db >> 2;
    float carry = 0.f;
    const size_t base = (size_t)db * NSEG * 512 + ch;
#pragma unroll 16
    for (int idx = 0; idx < NSEG; ++idx) {
      int sg = d == 0 ? idx : (idx < 16 ? 15 - idx : NSEG + 15 - idx);
      size_t o = base + (size_t)sg * 512;
      p.CAR[o] = carry;
      carry = fmaf(p.CHA[o], carry, p.CHH[o]);
    }
  }
  if (!lru_blk)
  for (int i = gtid; i < 32 * 16384; i += gsz) {
    int el = i & 16383, bhd = i >> 14, d = bhd & 1, h = (bhd >> 1) & 3;
    float lg = -softplus_f(-p.ret_decay[(li * 2 + d) * 4 + h]);
    float dec = expf(lg * 128.f);
    const float* base = p.U + (size_t)bhd * NCH * 16384 + el;
    AT* sb = p.SB + (size_t)bhd * NCH * 16384 + el;
    float S = 0.f;
#pragma unroll 17
    for (int idx = 0; idx < NCH; ++idx) {
      int c = d == 0 ? idx : (idx < 2 ? 1 - idx : 35 - idx);
      float u = base[(size_t)c * 16384];
      sb[(size_t)c * 16384] = __float2bfloat16(S);
      S = fmaf(dec, S, u);
    }
  }
}
__device__ __forceinline__ void ph_R3_f(const Params& p, int l, int bid, int nb, char* lds) {
  const int li = l >> 1;
  float* stage = (float*)lds;
  const int lane = tidx() & 63, wid = tidx() >> 6, wr = wid >> 1, wc = wid & 1, fr = lane & 15, fq = lane >> 4;
  const int NRET = NBAT * 4 * NCH;
  char* Pb = lds;
  for (int item = bid; item < NRET + NBAT * NCH * 8; item += nb) {
    if (item < NRET) {
      int c = item % NCH, bh = item / NCH, h = bh & 3, b = bh >> 2;
      const int tok0 = chunk_tok0(b, c);
      const AT* base = p.PROJ + (size_t)tok0 * 3072 + h * 128;
      const float l0 = -softplus_f(-p.ret_decay[(li * 2 + 0) * 4 + h]) * LOG2E;
      const float l1 = -softplus_f(-p.ret_decay[(li * 2 + 1) * 4 + h]) * LOG2E;
      f32x4 acc[4][4]; acc_zero(acc);
      const int r0 = tidx() >> 2, co = glds_chunk_off();
      {
        const AT* k0 = base + 512 + (size_t)r0 * 3072 + co;
        const AT* q0 = base + (size_t)r0 * 3072 + co;
        gemm_core_g(lds, 4, k0, k0 + (size_t)64 * 3072, q0, q0 + (size_t)64 * 3072, acc);
      }
      float l0o = l0, l1o = l1;
      asm volatile("" : "+v"(l0o), "+v"(l1o));
#pragma unroll
      for (int mt = 0; mt < 4; ++mt)
#pragma unroll
        for (int nt = 0; nt < 4; ++nt) {
          const int m0 = wr * 64 + mt * 16 + fq * 4, j = wc * 64 + nt * 16 + fr;
          float pv[4];
#pragma unroll
          for (int q = 0; q < 4; ++q) {
            const int m = m0 + q;
            const int dd = j - m; const float ee = __builtin_amdgcn_exp2f((dd > 0 ? l0o : l1o) * (float)(dd > 0 ? dd : -dd)); const float M = dd == 0 ? 2.f : ee;
            pv[q] = acc[mt][nt][q] * M;
          }
          u32x2 o; o.x = pk2(pv[0], pv[1]); o.y = pk2(pv[2], pv[3]);
          *(u32x2*)(Pb + (m0 >> 5) * 8192 + row_off(j, (m0 & 31) >> 3) + (m0 & 7) * 2) = o;
        }
      acc_zero(acc);
      { LdColH<0> lb; lb.init(base + 1024, 3072, 0.f); gemm_core_Alds(lds, Pb, 4, lb, acc); }
#pragma unroll 1
      for (int d = 0; d < 2; ++d) {
        const float lx = d ? l1 : l0;
#pragma unroll
        for (int i = 0; i < 8; ++i) {
          const int idx = tidx() + 256 * i, row = idx >> 4, c16 = idx & 15;
          const u32x4 qv = *(const u32x4*)(base + (size_t)row * 3072 + c16 * 8);
          const float xi = __builtin_amdgcn_exp2f(lx * (float)(d ? 128 - row : row + 1));
          *(u32x4*)(Pb + (c16 >> 2) * 8192 + row_off(row, c16 & 3)) = scale8(qv, xi);
        }
        const AT* sb = p.SB + ((size_t)((b * 4 + h) * 2 + d) * NCH + c) * 16384;
        LdRow<false> lb; lb.init([&](int r) { return sb + (size_t)r * 128; });
        gemm_core_Alds(lds, Pb, 4, lb, acc);
      }
      acc_to_stage(lds, acc);
      EPI_BEGIN
        float ss = v.x * v.x + v.y * v.y + v.z * v.z + v.w * v.w;
        ss = half_sum(ss);
        float rs = rsqrtf(ss * (1.f / 128.f) + EPSF);
        int tok = tok0 + row;
        const u32x2 gg = *(const u32x2*)(p.PROJ + (size_t)tok * 3072 + 1536 + h * 128 + c4);
        float4 o = make_float4(v.x * rs * silu_fast(bf_lo(gg.x)), v.y * rs * silu_fast(bf_hi(gg.x)), v.z * rs * silu_fast(bf_lo(gg.y)), v.w * rs * silu_fast(bf_hi(gg.y)));
        st4bf(p.MIX + (size_t)tok * 1024 + h * 128 + c4, o);
      EPI_END
    } else {
      int it = item - NRET;
      int kb = it & 7, c = (it >> 3) % NCH, b = it / (8 * NCH);
      lru_local_f<true>(p, li, b, c, kb, lds);
    }
  }
}

constexpr int KROW = 240;
constexpr int VROW = 144;
constexpr int KT_BYTES = 64 * KROW;
constexpr int VT_BYTES = 64 * VROW;
__device__ __forceinline__ void ph_ATT_f(const Params& p, int l, int bid, int nb, char* lds) {
  const int tid = tidx(), lane = tid & 63, wid = tid >> 6, fr = lane & 15, fq = lane >> 4;
  char* Kl = lds;
  char* Vl = lds + 2 * KT_BYTES;
  int ko0, ko1, ko2, vo0, vo1, vg0, vg1;
  { int e = tid;       ko0 = (e / 12) * KROW + (e % 12) * 16; vo0 = (e >> 3) * VROW + (e & 7) * 16; vg0 = (e >> 3) * KVL + (e & 7) * 8;
    e = tid + 256;     ko1 = (e / 12) * KROW + (e % 12) * 16; vo1 = (e >> 3) * VROW + (e & 7) * 16; vg1 = (e >> 3) * KVL + (e & 7) * 8;
    e = tid + 512;     ko2 = (e / 12) * KROW + (e % 12) * 16; }
  const float qscale = 0.10206207261596577f * 1.4426950408889634f;
  const int NLAT = NBAT * 16 * 32, NCT = (l == 1) ? NBAT * 16 * 2 : 0;
  for (int item = bid; item < NLAT + NCT; item += nb) {
    const bool lat = item < NLAT;
    int qb, bh, ntile;
    if (lat) { qb = item & 31; bh = item >> 5; ntile = KVL / 64; } else { int it = item - NLAT; qb = it & 1; bh = it >> 1; ntile = CTXL / 64; }
    const int b = bh >> 4, h = bh & 15;
    const int q0 = qb * 128 + wid * 32;
    const AT* Qbase = p.Ql + (size_t)(lat ? NCTX + b * SEQ + q0 : b * CTXL + q0) * QLD + h * 96;
    bf16x8 qf[2][3];
#pragma unroll
    for (int qt = 0; qt < 2; ++qt)
#pragma unroll
      for (int s = 0; s < 3; ++s) {
        u32x4 raw = *(const u32x4*)(Qbase + (size_t)(qt * 16 + fr) * QLD + s * 32 + fq * 8);
        float f[8] = {bf_lo(raw.x), bf_hi(raw.x), bf_lo(raw.y), bf_hi(raw.y), bf_lo(raw.z), bf_hi(raw.z), bf_lo(raw.w), bf_hi(raw.w)};
        if (s == 2) {
          u32x4 oth;
          oth.x = __shfl_xor(raw.x, 32); oth.y = __shfl_xor(raw.y, 32); oth.z = __shfl_xor(raw.z, 32); oth.w = __shfl_xor(raw.w, 32);
          if (lat) {
            float g[8] = {bf_lo(oth.x), bf_hi(oth.x), bf_lo(oth.y), bf_hi(oth.y), bf_lo(oth.z), bf_hi(oth.z), bf_lo(oth.w), bf_hi(oth.w)};
            int fro = lane;
            asm volatile("" : "+v"(fro));
            const int t = (q0 + qt * 16 + (fro & 15)) * 16 + 8 * ((fro >> 4) & 1);
            const float* cp = p.cs2c + t;
            const float* sp = p.cs2s + t;
#pragma unroll
            for (int j = 0; j < 8; ++j) {
              float cs = cp[j], sn = sp[j];
              f[j] = (fq < 2) ? (f[j] * cs - g[j] * sn) : (g[j] * sn + f[j] * cs);
            }
          }
        }
        u32x4 o;
        o.x = pk2(f[0] * qscale, f[1] * qscale); o.y = pk2(f[2] * qscale, f[3] * qscale);
        o.z = pk2(f[4] * qscale, f[5] * qscale); o.w = pk2(f[6] * qscale, f[7] * qscale);
        qf[qt][s] = *(bf16x8*)&o;
      }
    float mrun[2] = {0.f, 0.f};
    f32x4 al[2] = {(f32x4){0.f, 0.f, 0.f, 0.f}, (f32x4){0.f, 0.f, 0.f, 0.f}};
    f32x4 ao[4][2];
#pragma unroll
    for (int dt = 0; dt < 4; ++dt) { ao[dt][0] = (f32x4){0.f, 0.f, 0.f, 0.f}; ao[dt][1] = (f32x4){0.f, 0.f, 0.f, 0.f}; }
    const char* Kg = (const char*)(p.Kb + (size_t)bh * KVL * 96);
    const AT* Vg = p.Vt + (size_t)bh * 64 * KVL;
    u32x4 kr0, kr1, kr2, vr0, vr1;
    kr0 = *(const u32x4*)(Kg + tid * 16); kr1 = *(const u32x4*)(Kg + (tid + 256) * 16); kr2 = *(const u32x4*)(Kg + (tid + 512) * 16);
    vr0 = *(const u32x4*)(Vg + vg0); vr1 = *(const u32x4*)(Vg + vg1);
    __syncthreads();
    *(u32x4*)(Kl + ko0) = kr0; *(u32x4*)(Kl + ko1) = kr1; *(u32x4*)(Kl + ko2) = kr2;
    *(u32x4*)(Vl + vo0) = vr0; *(u32x4*)(Vl + vo1) = vr1;
    __syncthreads();
    {
      const int t1 = min(1, ntile - 1);
      const char* kg = Kg + (size_t)t1 * 12288;
      kr0 = *(const u32x4*)(kg + tid * 16); kr1 = *(const u32x4*)(kg + (tid + 256) * 16); kr2 = *(const u32x4*)(kg + (tid + 512) * 16);
      vr0 = *(const u32x4*)(Vg + vg0 + t1 * 64); vr1 = *(const u32x4*)(Vg + vg1 + t1 * 64);
    }
    bf16x8 kf[2][4];
    {
      const char* kb = Kl + fr * KROW + fq * 16;
#pragma unroll
      for (int s = 0; s < 2; ++s)
#pragma unroll
        for (int k4 = 0; k4 < 4; ++k4) kf[s][k4] = *(const bf16x8*)(kb + k4 * 16 * KROW + s * 64);
    }
    auto tile_iter = [&](const int t, u32x4& xk0, u32x4& xk1, u32x4& xk2, u32x4& xv0, u32x4& xv1) __attribute__((always_inline)) {
      const int cur = t & 1;
      f32x4 as[4][2];
      {
        const f32x4 n0 = {-mrun[0], -mrun[0], -mrun[0], -mrun[0]}, n1 = {-mrun[1], -mrun[1], -mrun[1], -mrun[1]};
        const char* kb2 = Kl + cur * KT_BYTES + fr * KROW + fq * 16 + 128;
#pragma unroll
        for (int k4 = 0; k4 < 4; ++k4) {
          as[k4][0] = __builtin_amdgcn_mfma_f32_16x16x32_bf16(kf[0][k4], qf[0][0], n0, 0, 0, 0);
          as[k4][1] = __builtin_amdgcn_mfma_f32_16x16x32_bf16(kf[0][k4], qf[1][0], n1, 0, 0, 0);
        }
        __builtin_amdgcn_sched_barrier(0);
#pragma unroll
        for (int k4 = 0; k4 < 4; ++k4) kf[0][k4] = *(const bf16x8*)(kb2 + k4 * 16 * KROW);
        __builtin_amdgcn_sched_barrier(0);
#pragma unroll
        for (int k4 = 0; k4 < 4; ++k4) {
          as[k4][0] = __builtin_amdgcn_mfma_f32_16x16x32_bf16(kf[1][k4], qf[0][1], as[k4][0], 0, 0, 0);
          as[k4][1] = __builtin_amdgcn_mfma_f32_16x16x32_bf16(kf[1][k4], qf[1][1], as[k4][1], 0, 0, 0);
        }
#pragma unroll
        for (int k4 = 0; k4 < 4; ++k4) {
          as[k4][0] = __builtin_amdgcn_mfma_f32_16x16x32_bf16(kf[0][k4], qf[0][2], as[k4][0], 0, 0, 0);
          as[k4][1] = __builtin_amdgcn_mfma_f32_16x16x32_bf16(kf[0][k4], qf[1][2], as[k4][1], 0, 0, 0);
        }
      }
      __builtin_amdgcn_sched_barrier(0);
      bf16x8 vf[2][4];
      {
        const char* vb = Vl + cur * VT_BYTES + fr * VROW + fq * 8;
#pragma unroll
        for (int ks = 0; ks < 2; ++ks)
#pragma unroll
          for (int dt = 0; dt < 4; ++dt) {
            if (ks == 1 && dt >= 2) continue;
            u32x2 lo = *(const u32x2*)(vb + dt * 16 * VROW + ks * 64);
            u32x2 hi = *(const u32x2*)(vb + dt * 16 * VROW + ks * 64 + 32);
            u32x4 a4 = {lo.x, lo.y, hi.x, hi.y};
            vf[ks][dt] = *(bf16x8*)&a4;
          }
      }
      __builtin_amdgcn_sched_barrier(0);
      bf16x8 pf[2][2];
#pragma unroll
      for (int qt = 0; qt < 2; ++qt) {
        float mx = as[0][qt][0];
#pragma unroll
        for (int k4 = 0; k4 < 4; ++k4)
#pragma unroll
          for (int j = 0; j < 4; ++j) mx = fmaxf(mx, as[k4][qt][j]);
        if (t == 0 || __builtin_amdgcn_ballot_w64(mx > 8.f) != 0ull) {
          mx = fmaxf(mx, __shfl_xor(mx, 16));
          mx = fmaxf(mx, __shfl_xor(mx, 32));
          const float dl = (t == 0) ? mx : fmaxf(mx, 0.f);
          const float alpha = (t == 0) ? 1.f : __builtin_amdgcn_exp2f(-dl);
          mrun[qt] += dl;
          al[qt][0] *= alpha; al[qt][1] *= alpha; al[qt][2] *= alpha; al[qt][3] *= alpha;
#pragma unroll
          for (int dt = 0; dt < 4; ++dt) { ao[dt][qt][0] *= alpha; ao[dt][qt][1] *= alpha; ao[dt][qt][2] *= alpha; ao[dt][qt][3] *= alpha; }
#pragma unroll
          for (int k4 = 0; k4 < 4; ++k4) { as[k4][qt][0] -= dl; as[k4][qt][1] -= dl; as[k4][qt][2] -= dl; as[k4][qt][3] -= dl; }
        }
        float pv[4][4];
#pragma unroll
        for (int k4 = 0; k4 < 4; ++k4)
#pragma unroll
          for (int j = 0; j < 4; ++j) pv[k4][j] = __builtin_amdgcn_exp2f(as[k4][qt][j]);
#pragma unroll
        for (int ks = 0; ks < 2; ++ks) {
          u32x4 o;
          o.x = pk2(pv[2 * ks][0], pv[2 * ks][1]); o.y = pk2(pv[2 * ks][2], pv[2 * ks][3]);
          o.z = pk2(pv[2 * ks + 1][0], pv[2 * ks + 1][1]); o.w = pk2(pv[2 * ks + 1][2], pv[2 * ks + 1][3]);
          pf[qt][ks] = *(bf16x8*)&o;
        }
      }
      __builtin_amdgcn_sched_barrier(0);
      {
        const char* vb = Vl + cur * VT_BYTES + fr * VROW + fq * 8;
#pragma unroll
        for (int dt = 2; dt < 4; ++dt) {
          u32x2 lo = *(const u32x2*)(vb + dt * 16 * VROW + 64);
          u32x2 hi = *(const u32x2*)(vb + dt * 16 * VROW + 64 + 32);
          u32x4 a4 = {lo.x, lo.y, hi.x, hi.y};
          vf[1][dt] = *(bf16x8*)&a4;
        }
      }
      {
        char* kd = Kl + (cur ^ 1) * KT_BYTES; char* vd = Vl + (cur ^ 1) * VT_BYTES;
        *(u32x4*)(kd + ko0) = xk0; *(u32x4*)(kd + ko1) = xk1; *(u32x4*)(kd + ko2) = xk2;
        *(u32x4*)(vd + vo0) = xv0; *(u32x4*)(vd + vo1) = xv1;
        const int t3 = min(t + 2, ntile - 1);
        const char* kg = Kg + (size_t)t3 * 12288;
        xk0 = *(const u32x4*)(kg + tid * 16); xk1 = *(const u32x4*)(kg + (tid + 256) * 16); xk2 = *(const u32x4*)(kg + (tid + 512) * 16);
        xv0 = *(const u32x4*)(Vg + vg0 + t3 * 64); xv1 = *(const u32x4*)(Vg + vg1 + t3 * 64);
      }
      const u32x4 o4 = {0x3f803f80u, 0x3f803f80u, 0x3f803f80u, 0x3f803f80u};
      const bf16x8 ones = *(const bf16x8*)&o4;
#pragma unroll
      for (int dt = 0; dt < 4; ++dt) {
        ao[dt][0] = __builtin_amdgcn_mfma_f32_16x16x32_bf16(vf[0][dt], pf[0][0], ao[dt][0], 0, 0, 0);
        ao[dt][1] = __builtin_amdgcn_mfma_f32_16x16x32_bf16(vf[0][dt], pf[1][0], ao[dt][1], 0, 0, 0);
      }
      al[0] = __builtin_amdgcn_mfma_f32_16x16x32_bf16(ones, pf[0][0], al[0], 0, 0, 0);
      al[1] = __builtin_amdgcn_mfma_f32_16x16x32_bf16(ones, pf[1][0], al[1], 0, 0, 0);
      __builtin_amdgcn_sched_barrier(0);
      __syncthreads();
      {
        const char* kb = Kl + (cur ^ 1) * KT_BYTES + fr * KROW + fq * 16;
#pragma unroll
        for (int s = 0; s < 2; ++s)
#pragma unroll
          for (int k4 = 0; k4 < 4; ++k4) kf[s][k4] = *(const bf16x8*)(kb + k4 * 16 * KROW + s * 64);
      }
      __builtin_amdgcn_sched_barrier(0);
#pragma unroll
      for (int dt = 0; dt < 4; ++dt) {
        ao[dt][0] = __builtin_amdgcn_mfma_f32_16x16x32_bf16(vf[1][dt], pf[0][1], ao[dt][0], 0, 0, 0);
        ao[dt][1] = __builtin_amdgcn_mfma_f32_16x16x32_bf16(vf[1][dt], pf[1][1], ao[dt][1], 0, 0, 0);
      }
      al[0] = __builtin_amdgcn_mfma_f32_16x16x32_bf16(ones, pf[0][1], al[0], 0, 0, 0);
      al[1] = __builtin_amdgcn_mfma_f32_16x16x32_bf16(ones, pf[1][1], al[1], 0, 0, 0);
    };
    for (int t = 0; t < ntile; t += 2) {
      tile_iter(t, kr0, kr1, kr2, vr0, vr1);
      tile_iter(t + 1, kr0, kr1, kr2, vr0, vr1);
    }
#pragma unroll
    for (int qt = 0; qt < 2; ++qt) {
      const float inv = 1.f / al[qt][0];
      const int r = q0 + qt * 16 + fr;
      const int tok = lat ? NCTX + b * SEQ + r : b * CTXL + r;
      AT* dst = p.MIX + (size_t)tok * 1024 + h * 64 + 4 * fq;
#pragma unroll
      for (int dt = 0; dt < 4; ++dt) {
        u32x2 o; o.x = pk2(ao[dt][qt][0] * inv, ao[dt][qt][1] * inv); o.y = pk2(ao[dt][qt][2] * inv, ao[dt][qt][3] * inv);
        *(u32x2*)(dst + dt * 16) = o;
      }
    }
  }
}
#endif

enum { PH_ADA1 = 0, PH_ADA2, PH_T1, PH_G1E, PH_R1, PH_R2, PH_R3, PH_G2E, PH_T2, PH_E1, PH_E2, PH_M1, PH_MN, PH_M2, PH_ATT, PH_M4, PH_FINAL, PH_RB };

#if EXACT
#define T1_CALL ph_T1(p, l, bid, nb);
#define FINAL_CALL ph_final(p, bid, nb);
#define T2_CALL ph_T2(p, l, bid, nb, lds);
#define R1_CALL ph_R1(p, l, bid, nb, lds);
#define R2_CALL ph_R2(p, l, bid, nb);
#define R3_CALL ph_R3(p, l, bid, nb, lds);
#define ATT_CALL ph_ATT(p, l, bid, nb, lds);
#define G1E_CALL ph_gemm_store(p, p.H, 1024, p.ab_w_in + (size_t)li * 1024 * 3072, 1024, 3072, p.PROJ, 3072, 0, bid, nb, lds);
#define G2E_CALL ph_gemm_resid(p, l, p.MIX, p.ab_w_out + (size_t)li * 1024 * 1024, 0, bid, nb, lds);
#define E1_CALL ph_E1(p, l, bid, nb, lds);
#define E2_CALL ph_E2(p, l, bid, nb, lds);
#define M1_CALL ph_gemm_store(p, p.H, 1024, p.mla_w_in + (size_t)li * 1024 * 672, 1024, 672, p.PROJ, P1LD, 0, bid, nb, lds);
#define M2_CALL ph_M2(p, l, bid, nb, lds);
#define M4_CALL ph_gemm_resid(p, l, p.MIX, p.mla_w_out + (size_t)li * 1024 * 1024, (l == 3) ? 8 : 0, bid, nb, lds);
#else
#define T1_CALL ph_T1_f(p, l, bid, nb);
#define FINAL_CALL ph_final_f(p, bid, nb);
#define T2_CALL ph_T2_f(p, l, bid, nb, lds);
#define R1_CALL ph_R1_f(p, l, bid, nb, lds);
#define R2_CALL ph_R2_f(p, l, bid, nb);
#define R3_CALL ph_R3_f(p, l, bid, nb, lds);
#define ATT_CALL ph_ATT_f(p, l, bid, nb, lds);
#define G1E_CALL ph_gemm_store_f<1>(p, p.H, 1024, p.WB + WB_ABIN + (size_t)li * 1024 * 3072, 1024, 3072, p.PROJ, 3072, bid, nb, lds);
#define G2E_CALL ph_gemm_resid_f(p, l, p.MIX, p.WB + WB_ABOUT + (size_t)li * 1024 * 1024, 0, bid, nb, lds);
#if E1_FAST == 2
#define E1_CALL ph_E1_g(p, l, bid, nb, lds);
#elif E1_FAST
#define E1_CALL ph_E1_f(p, l, bid, nb, lds);
#else
#define E1_CALL ph_E1(p, l, bid, nb, lds);
#endif
#define E2_CALL ph_E2_f(p, l, bid, nb, lds);
#define M1_CALL ph_gemm_store_f<0>(p, p.H, 1024, p.WB + WB_MIN + (size_t)li * 1024 * 672, 1024, 672, p.PROJ, P1LD, bid, nb, lds);
#define M2_CALL ph_M2_f(p, l, bid, nb, lds);
#define M4_CALL ph_gemm_resid_f(p, l, p.MIX, p.WB + WB_MOUT + (size_t)li * 1024 * 1024, (l == 3) ? 8 : 0, bid, nb, lds);
#endif
__device__ __forceinline__ void run_phase(const Params& p, int ph, int l, int bid, int nb, char* lds) {
  const int li = l >> 1;
  switch (ph) {
    case PH_ADA1: if constexpr (((PHMASK) >> PH_ADA1) & 1) { ph_ada1(p, bid, nb, lds);
#if !EXACT
      conv_dense_weights(p, bid, nb, lds);
      conv_moe_weights(p, bid, nb, lds);
#endif
    } break;
    case PH_ADA2: if constexpr (((PHMASK) >> PH_ADA2) & 1) { ph_ada2(p, bid, nb); } break;
    case PH_T1: if constexpr (((PHMASK) >> PH_T1) & 1) { T1_CALL } break;
    case PH_G1E: if constexpr (((PHMASK) >> PH_G1E) & 1) { G1E_CALL } break;
    case PH_R1: if constexpr (((PHMASK) >> PH_R1) & 1) { R1_CALL } break;
    case PH_R2: if constexpr (((PHMASK) >> PH_R2) & 1) { R2_CALL } break;
    case PH_R3: if constexpr (((PHMASK) >> PH_R3) & 1) { R3_CALL } break;
    case PH_G2E: if constexpr (((PHMASK) >> PH_G2E) & 1) { G2E_CALL } break;
    case PH_T2: if constexpr (((PHMASK) >> PH_T2) & 1) { T2_CALL } break;
    case PH_E1: if constexpr (((PHMASK) >> PH_E1) & 1) { E1_CALL } break;
    case PH_E2: if constexpr (((PHMASK) >> PH_E2) & 1) { E2_CALL } break;
    case PH_M1: if constexpr (((PHMASK) >> PH_M1) & 1) { M1_CALL } break;
    case PH_MN: if constexpr (((PHMASK) >> PH_MN) & 1) { ph_MN(p, l, bid, nb); } break;
    case PH_M2: if constexpr (((PHMASK) >> PH_M2) & 1) { M2_CALL } break;
    case PH_ATT: if constexpr (((PHMASK) >> PH_ATT) & 1) { ATT_CALL } break;
    case PH_M4: if constexpr (((PHMASK) >> PH_M4) & 1) { M4_CALL } break;
    case PH_FINAL: if constexpr (((PHMASK) >> PH_FINAL) & 1) { FINAL_CALL } break;
    case PH_RB: if constexpr (((PHMASK) >> PH_RB) & 1) { ph_RB(p, l, bid, nb, lds); } break;
  }
}

constexpr int NPHASE = 43;
__host__ __device__ __forceinline__ void decode_phase(int i, int& ph, int& l) {
  if (i == 0) { ph = PH_ADA1; l = 0; return; }
  if (i == 1) { ph = PH_ADA2; l = 0; return; }
  if (i == NPHASE - 1) { ph = PH_FINAL; l = 0; return; }
  int j = i - 2; l = j / 10; int s = j % 10;
  bool even = (l & 1) == 0;
  if (s == 0) ph = PH_T1;
  else if (s == 1) ph = even ? PH_G1E : PH_M1;
  else if (s == 2) ph = even ? PH_R1 : PH_MN;
  else if (s == 3) ph = even ? PH_R2 : PH_M2;
  else if (s == 4) ph = even ? PH_R3 : PH_ATT;
  else if (s == 5) ph = even ? PH_G2E : PH_M4;
  else if (s == 6) ph = PH_T2;
  else if (s == 7) ph = PH_RB;
  else if (s == 8) ph = PH_E1;
  else ph = PH_E2;
}

#if !MEGA
__global__ void __launch_bounds__(256 LB2) k_phase(Params p, int ph, int l) {
  __shared__ __attribute__((aligned(16))) char smem[LDS_BYTES];
  run_phase(p, ph, l, blockIdx.x, gridDim.x, smem);
}
#else
__global__ void __launch_bounds__(256 LB2) k_mega(Params p) {
  __shared__ __attribute__((aligned(16))) char smem[LDS_BYTES];
  volatile LAS unsigned* st = (volatile LAS unsigned*)(smem + MISC_OFF + 496);
  if (tidx() == 0) { st[0] = 0u; st[1] = 0u; st[2] = 0u; st[3] = 0u; }
  __syncthreads();
  XcdBarrier xb = xcd_barrier_post(p.bar, st);
  const int nb = gridDim.x;
  const int bid = blockIdx.x;
  const int vbid = (nb & 7) == 0 ? (int)(blockIdx.x & 7) * (nb >> 3) + (int)(blockIdx.x >> 3) : (int)blockIdx.x;
#ifndef XCDMASK
#define XCDMASK (1<<PH_ATT)
#endif
#ifndef HALFMASK
#define HALFMASK 0
#endif
#ifndef DUPMASK
#define DUPMASK 0
#endif
#define RUNP(PH, L) { run_phase(p, PH, L, (((XCDMASK) >> (PH)) & 1) ? vbid : bid, nb, smem); xcd_barrier(xb); if (((DUPMASK) >> (PH)) & 1) { run_phase(p, PH, L, bid, nb, smem); xcd_barrier(xb); } }
  RUNP(PH_ADA1, 0) RUNP(PH_ADA2, 0)
#pragma unroll 1
  for (int l = 0; l < 4; ++l) {
    RUNP(PH_T1, l)
    if ((l & 1) == 0) { RUNP(PH_G1E, l) RUNP(PH_R1, l) RUNP(PH_R2, l) RUNP(PH_R3, l) RUNP(PH_G2E, l) }
    else { RUNP(PH_M1, l) RUNP(PH_MN, l) RUNP(PH_M2, l) RUNP(PH_ATT, l) RUNP(PH_M4, l) }
    RUNP(PH_T2, l) RUNP(PH_RB, l) RUNP(PH_E1, l) RUNP(PH_E2, l)
  }
  run_phase(p, PH_FINAL, 0, bid, nb, smem);
}

#endif
static inline size_t al256(size_t x) { return (x + 255) & ~(size_t)255; }

extern "C" void kernel_launch(void* const* d_in, const int* in_sizes, int n_in, void* d_out, int out_size, void* d_ws, size_t ws_size, hipStream_t stream) {
  (void)in_sizes; (void)n_in; (void)out_size;
  Params p; memset(&p, 0, sizeof(p));
  const float** ins = (const float**)&p;
  for (int i = 0; i < 29; ++i) ins[i] = (const float*)d_in[i];
  p.out = (float*)d_out;
  char* w = (char*)d_ws; size_t off = 0;
  auto take = [&](size_t bytes) { char* r = w + off; off = al256(off + bytes); return r; };
  const size_t ZERO_BYTES = 16384;
  p.bar = (unsigned*)take(16384); p.cnt = (int*)take(4 * 32 * 32 * 4);
  p.mod = (float*)take((size_t)4 * 5 * 6144 * 4);
  p.modp = (float*)take((size_t)4 * 8 * 5 * 6144 * 4);
  p.cs1c = (float*)take(4096 * 64 * 4); p.cs1s = (float*)take(4096 * 64 * 4);
  p.cs2c = (float*)take(4096 * 16 * 4); p.cs2s = (float*)take(4096 * 16 * 4);
  p.re = (int*)take((size_t)NTOK * 2 * 4); p.rw = (float*)take((size_t)NTOK * 2 * 4);
  p.list = (int*)take((size_t)32 * NTOK * 4);
  p.RQ = (float*)take((size_t)NTOK * 4); p.RKV = (float*)take((size_t)NTOK * 4);
  p.KR = (AT*)take((size_t)NTOK * 32 * sizeof(AT));
  p.WB = (AT*)take(WB_TOTAL * sizeof(AT));
#if !EXACT
  p.WM = (AT*)take((size_t)3 * 128 * 1024 * 512 * sizeof(AT));
#endif
  p.SSQ = (float*)take((size_t)8 * NTOK * 4);
  p.WR = (unsigned short*)take((size_t)4 * 2 * 128 * 48 * 8 * 2);
  p.CHA = (float*)take((size_t)2 * 4 * 272 * 512 * 4); p.CHH = (float*)take((size_t)2 * 4 * 272 * 512 * 4); p.CAR = (float*)take((size_t)2 * 4 * 272 * 512 * 4);
  p.X = (float*)take((size_t)NTOK * 1024 * 4);
  p.H = (AT*)take((size_t)NTOK * 1024 * sizeof(AT));
  p.PROJ = (AT*)take((size_t)NTOK * 3072 * sizeof(AT));
  p.MIX = (AT*)take((size_t)NTOK * 1024 * sizeof(AT));
  p.Y = (AT*)take((size_t)NTOK * 2 * 1024 * sizeof(AT));
  size_t reg0 = off;
  p.U = (float*)take((size_t)32 * NCH * 16384 * 4);
  p.HL = (float*)take((size_t)2 * NTOK * 512 * 4);
  p.SB = (AT*)p.HL;
  p.AC = (float*)take((size_t)2 * NTOK * 512 * 4);
#if EXACT
  p.SCR = (float*)take((size_t)1024 * 16384 * 4);
#endif
  size_t hb_off = off;
  p.HB = (AT*)take((size_t)(NTOK * 2) * 512 * sizeof(AT));
#if EXACT
  p.HU = (AT*)take((size_t)(NTOK * 2) * 512 * sizeof(AT));
#endif
  size_t reg_end = off;
  off = reg0;
  p.Ql = (AT*)take((size_t)NTOK * QLD * sizeof(AT));
  p.Qc = p.Ql;
  p.Kb = (AT*)take((size_t)NBAT * 16 * KVL * 96 * sizeof(AT));
  p.Vb = (AT*)take((size_t)NBAT * 16 * KVL * 64 * sizeof(AT));
  p.Vt = p.Vb;
  if (off > reg_end) reg_end = off;
  (void)hb_off;
  if (reg_end > ws_size) { fprintf(stderr, "workspace too small: need %zu have %zu\n", reg_end, ws_size); return; }

  (void)hipMemsetAsync(d_ws, 0, ZERO_BYTES, stream);
#if MEGA
  static int grid_blocks = 0;
  if (!grid_blocks) {
    int dev = 0, cus = 0, per_cu = 0;
    hipGetDevice(&dev);
    hipDeviceGetAttribute(&cus, hipDeviceAttributeMultiprocessorCount, dev);
    hipOccupancyMaxActiveBlocksPerMultiprocessor(&per_cu, k_mega, 256, 0);
    if (per_cu > 2) per_cu = 2;
    if (per_cu < 1) per_cu = 1;
    grid_blocks = cus * per_cu;
  }
  void* args[] = {&p};
  hipError_t e = hipLaunchCooperativeKernel((void*)k_mega, dim3(grid_blocks), dim3(256), args, 0, stream);
  if (e != hipSuccess) fprintf(stderr, "cooperative launch failed: %s (grid %d)\n", hipGetErrorString(e), grid_blocks);
#else
  for (int i = 0; i < NPHASE; ++i) { int ph, l; decode_phase(i, ph, l); k_phase<<<1024, 256, 0, stream>>>(p, ph, l); }
#endif
}
```

```cpp
#include <hip/hip_runtime.h>
#include <hip/hip_bf16.h>
#include <stdint.h>
#include <stdio.h>
#include <string.h>

#ifndef EXACT
#define EXACT 0
#endif
#ifndef ENGINE
#define ENGINE 1
#endif
#ifndef PHMASK
#define PHMASK 0x3ffff
#endif
#ifndef E1_FAST
#define E1_FAST 2
#endif
#ifndef MEGA
#define MEGA 1
#endif

constexpr int DM = 1024, NBAT = 4, SEQ = 4096, CTXL = 256, NLAY = 4;
constexpr int NCTX = NBAT * CTXL;
constexpr int NTOK = NCTX + NBAT * SEQ;
constexpr int NRT = NTOK / 128;
constexpr int NCH = 34;
constexpr int KVL = CTXL + SEQ;
constexpr float EPSF = 1e-6f;
constexpr int ST_LD = 132;
constexpr int P1LD = 768;
constexpr int QLD = 1536;
constexpr size_t WB_ABIN = 0, WB_ABOUT = WB_ABIN + 2ull * 1024 * 3072, WB_MIN = WB_ABOUT + 2ull * 1024 * 1024, WB_UQ = WB_MIN + 2ull * 1024 * 672,
                 WB_UKV = WB_UQ + 2ull * 384 * 1536, WB_MOUT = WB_UKV + 2ull * 256 * 2048, WB_TOTAL = WB_MOUT + 2ull * 1024 * 1024;
#if EXACT
#define KSCALE 0.08838834764831845f
#else
#define KSCALE 1.0f
#endif

#if EXACT
typedef float AT;
__device__ __forceinline__ float ldA(const AT* p) { return *p; }
__device__ __forceinline__ void stA(AT* p, float v) { *p = v; }
#else
typedef __hip_bfloat16 AT;
__device__ __forceinline__ float ldA(const AT* p) { return __bfloat162float(*p); }
__device__ __forceinline__ void stA(AT* p, float v) { *p = __float2bfloat16(v); }
#endif

struct Params {
  const float *x, *c, *ctx, *c_ctx, *ada_w, *ada_b, *norm_g, *ab_w_in, *ab_w_out, *ret_decay,
      *conv_w, *conv_b, *gate_w, *gate_b, *lam, *mla_w_in, *q_g, *kv_g, *w_uq, *w_ukv, *mla_w_out,
      *grp_w, *grp_b, *exp_w, *exp_b, *w_gate, *w_up, *w_down, *final_g;
  float* out;
  unsigned* bar; int* cnt;
  float *mod, *modp, *cs1c, *cs1s, *cs2c, *cs2s, *X;
  AT *H, *PROJ, *MIX;
  float *U, *HL, *AC, *CHA, *CHH, *CAR, *SCR;
  int* re; float* rw; int* list;
  AT *HB, *Y, *HU;
  float *RQ, *RKV;
  AT *Ql, *Qc, *Kb, *Vb, *Vt, *KR;
  AT* WB;
  AT* WM;
  AT* SB;
  float* SSQ;
  unsigned short* WR;
};

__device__ __forceinline__ int tidx() { int t = __builtin_amdgcn_workitem_id_x(); asm volatile("" : "+v"(t)); return t; }
__device__ __forceinline__ float silu_f(float x) { return x / (1.f + expf(-x)); }
__device__ __forceinline__ float sigmoid_f(float x) { return 1.f / (1.f + expf(-x)); }
__device__ __forceinline__ float gelu_tanh(float x) {
  float u = 0.7978845608028654f * (x + 0.044715f * x * x * x);
  return 0.5f * x * (1.f + tanhf(u));
}
__device__ __forceinline__ float silu_fast(float x) { return x * __builtin_amdgcn_rcpf(1.f + __builtin_amdgcn_exp2f(-1.4426950408889634f * x)); }
__device__ __forceinline__ float gelu_tanh_fast(float x) {
  float u = 0.7978845608028654f * (x + 0.044715f * x * x * x);
  return x * __builtin_amdgcn_rcpf(1.f + __builtin_amdgcn_exp2f(-2.f * 1.4426950408889634f * u));
}
__device__ __forceinline__ float softplus_f(float x) { return x > 20.f ? x : log1pf(expf(x)); }
__device__ __forceinline__ float wave_sum(float v) {
#pragma unroll
  for (int o = 32; o > 0; o >>= 1) v += __shfl_xor(v, o);
  return v;
}
__device__ __forceinline__ float wave_max(float v) {
#pragma unroll
  for (int o = 32; o > 0; o >>= 1) v = fmaxf(v, __shfl_xor(v, o));
  return v;
}
__device__ __forceinline__ float half_sum(float v) {
#pragma unroll
  for (int o = 16; o > 0; o >>= 1) v += __shfl_xor(v, o);
  return v;
}
__device__ __forceinline__ int tok_modrow(int tok) { return tok < NCTX ? 4 : ((tok - NCTX) >> 12); }
__device__ __forceinline__ int chunk_tok0(int b, int c) { return c < 2 ? b * CTXL + c * 128 : NCTX + b * SEQ + (c - 2) * 128; }
__device__ __forceinline__ void rt_to_bc(int rt, int& b, int& c) {
  if (rt < 8) { b = rt >> 1; c = rt & 1; } else { int r = rt - 8; b = r >> 5; c = 2 + (r & 31); }
}
__device__ __forceinline__ void sincos_acc(float ang, float& s, float& c) {
  double a = (double)ang;
  double q = rint(a * 0.6366197723675814);
  double r = a - q * 1.5707963267948966 - q * 6.123233995736766e-17;
  int qi = ((int)q) & 3;
  double r2 = r * r;
  double sn = r * (1.0 + r2 * (-1.0 / 6 + r2 * (1.0 / 120 + r2 * (-1.0 / 5040 + r2 * (1.0 / 362880 + r2 * (-1.0 / 39916800 + r2 * (1.0 / 6227020800.0)))))));
  double cn = 1.0 + r2 * (-0.5 + r2 * (1.0 / 24 + r2 * (-1.0 / 720 + r2 * (1.0 / 40320 + r2 * (-1.0 / 3628800 + r2 * (1.0 / 479001600 + r2 * (-1.0 / 87178291200.0)))))));
  double ss, cc;
  if (qi == 0) { ss = sn; cc = cn; } else if (qi == 1) { ss = cn; cc = -sn; } else if (qi == 2) { ss = -sn; cc = -cn; } else { ss = -cn; cc = sn; }
  s = (float)ss; c = (float)cc;
}

#define XB_TMO      128
#define XB_XCNT(j)  (256  + 64 * (j))
#define XB_XSUB(j)  (1280 + 64 * (j))
#define XB_XGEN(j)  (2304 + 64 * (j))
#define XB_TOP      3328
#define XB_TOPGEN   3392
#define XCD_BAR_WORDS 3456
#define XB_SPIN_CAP (1u << 22)
#define LAS __attribute__((address_space(3)))
__device__ __forceinline__ unsigned xb_ld(unsigned* p) { return __hip_atomic_load(p, __ATOMIC_RELAXED, __HIP_MEMORY_SCOPE_AGENT); }
__device__ __forceinline__ unsigned xb_add(unsigned* p, unsigned v) { return __hip_atomic_fetch_add(p, v, __ATOMIC_RELAXED, __HIP_MEMORY_SCOPE_AGENT); }
__device__ __forceinline__ unsigned xb_xcc_id() { return (unsigned)__builtin_amdgcn_s_getreg((3 << 11) | 20) & 0xFu; }
#define XB_SPIN(cond, bar) do { unsigned _sp = 0; while (cond) { __builtin_amdgcn_s_sleep(1); \
    if ((++_sp & 255u) == 0u) { if (xb_ld(&(bar)[XB_TMO])) break; if (_sp > XB_SPIN_CAP) { atomicAdd(&(bar)[XB_TMO], 1u); break; } } } } while (0)
struct XcdBarrier { unsigned* bar; unsigned x; volatile LAS unsigned* st; };
__device__ __forceinline__ XcdBarrier xcd_barrier_post(unsigned* bar, volatile LAS unsigned* st) {
  XcdBarrier b; b.bar = bar; b.x = xb_xcc_id(); b.st = st;
  if (tidx() == 0) (void)xb_add(&bar[XB_XCNT(b.x)], 1u);
  return b;
}
__device__ __forceinline__ void xcd_barrier_complete(unsigned* bar, unsigned x, unsigned& nloc, unsigned& nx) {
  const unsigned G = gridDim.x * gridDim.y * gridDim.z;
  unsigned sum, cnt, mine, sp = 0u;
  for (;;) {
    sum = 0u; cnt = 0u; mine = 0u;
#pragma unroll
    for (unsigned j = 0; j < 16; ++j) { const unsigned c = xb_ld(&bar[XB_XCNT(j)]); sum += c; cnt += (c > 0u) ? 1u : 0u; mine = (j == x) ? c : mine; }
    if (sum == G) break;
    __builtin_amdgcn_s_sleep(1);
    if ((++sp & 255u) == 0u) { if (xb_ld(&bar[XB_TMO])) break; if (sp > XB_SPIN_CAP) { atomicAdd(&bar[XB_TMO], 1u); break; } }
  }
  nloc = mine > 0u ? mine : 1u; nx = cnt > 0u ? cnt : 1u;
}
__device__ __forceinline__ void xcd_barrier(const XcdBarrier& b) {
  asm volatile("s_waitcnt vmcnt(0)" ::: "memory");
  __syncthreads();
  if (tidx() == 0) {
    unsigned* bar = b.bar;
    unsigned bx = b.x;
    asm volatile("" : "+s"(bar), "+s"(bx));
    __builtin_amdgcn_s_waitcnt(0);
    unsigned nloc = b.st[0], nx = b.st[1];
    if (nloc == 0u) { xcd_barrier_complete(bar, bx, nloc, nx); b.st[0] = nloc; b.st[1] = nx; }
    const unsigned old = xb_add(&bar[XB_XSUB(bx)], 1u);
    const unsigned gen = old / nloc;
    if (old + 1u == (gen + 1u) * nloc) {
      __builtin_amdgcn_fence(__ATOMIC_RELEASE, "agent");
      asm volatile("s_waitcnt vmcnt(0)" ::: "memory");
      const unsigned og = xb_add(&bar[XB_TOP], 1u);
      const unsigned tg = og / nx;
      if (og + 1u == (tg + 1u) * nx) xb_add(&bar[XB_TOPGEN], 1u);
      else XB_SPIN(xb_ld(&bar[XB_TOPGEN]) == tg, bar);
      __builtin_amdgcn_fence(__ATOMIC_ACQUIRE, "agent");
      xb_add(&bar[XB_XGEN(bx)], 1u);
      asm volatile("s_waitcnt vmcnt(0)" ::: "memory");
    } else {
      XB_SPIN(xb_ld(&bar[XB_XGEN(bx)]) == gen, bar);
      __builtin_amdgcn_fence(__ATOMIC_ACQUIRE, "agent");
      asm volatile("s_waitcnt vmcnt(0)" ::: "memory");
    }
  }
  __syncthreads();
}

constexpr int STAGE_BYTES = 128 * ST_LD * 4;
#if ENGINE == 0
constexpr int OPS_OFF = STAGE_BYTES;
#else
constexpr int OPS_OFF = 0;
#endif
#if EXACT
constexpr int MISC_OFF = STAGE_BYTES + 2 * 32 * ST_LD * 4;
#define LB2
#else
constexpr int MISC_OFF = STAGE_BYTES;
#define LB2 , 2
#endif
constexpr int LDS_BYTES = MISC_OFF + 512 + 1024;

#if ENGINE == 0
template <class FA, class FB>
__device__ __forceinline__ void engine(char* lds, int K, FA fa, FB fb) {
  float* stage = (float*)lds;
  float* As = (float*)(lds + OPS_OFF);
  float* Bs = As + 32 * ST_LD;
  const int tid = tidx(), ty = tid >> 4, tx = tid & 15;
  float acc[8][8];
#pragma unroll
  for (int i = 0; i < 8; ++i)
#pragma unroll
    for (int j = 0; j < 8; ++j) acc[i][j] = 0.f;
  __syncthreads();
  for (int k0 = 0; k0 < K; k0 += 32) {
    for (int e = tid; e < 4096; e += 256) { int r = e >> 5, kk = e & 31; As[kk * ST_LD + r] = fa(r, k0 + kk); }
    for (int e = tid; e < 4096; e += 256) { int kk = e >> 7, c = e & 127; Bs[kk * ST_LD + c] = fb(k0 + kk, c); }
    __syncthreads();
#pragma unroll 4
    for (int kk = 0; kk < 32; ++kk) {
      float4 a0 = *(const float4*)(As + kk * ST_LD + ty * 4), a1 = *(const float4*)(As + kk * ST_LD + 64 + ty * 4);
      float4 b0 = *(const float4*)(Bs + kk * ST_LD + tx * 4), b1 = *(const float4*)(Bs + kk * ST_LD + 64 + tx * 4);
      float a[8] = {a0.x, a0.y, a0.z, a0.w, a1.x, a1.y, a1.z, a1.w};
      float b[8] = {b0.x, b0.y, b0.z, b0.w, b1.x, b1.y, b1.z, b1.w};
#pragma unroll
      for (int i = 0; i < 8; ++i)
#pragma unroll
        for (int j = 0; j < 8; ++j) acc[i][j] = fmaf(a[i], b[j], acc[i][j]);
    }
    __syncthreads();
  }
#pragma unroll
  for (int i = 0; i < 8; ++i) {
    int row = (i < 4) ? ty * 4 + i : 64 + ty * 4 + (i - 4);
    *(float4*)(stage + row * ST_LD + tx * 4) = make_float4(acc[i][0], acc[i][1], acc[i][2], acc[i][3]);
    *(float4*)(stage + row * ST_LD + 64 + tx * 4) = make_float4(acc[i][4], acc[i][5], acc[i][6], acc[i][7]);
  }
  __syncthreads();
}
#else
using bf16x8 = __attribute__((ext_vector_type(8))) short;
using f32x4 = __attribute__((ext_vector_type(4))) float;
__device__ __forceinline__ int lrow_off(int row, int k) {
  return row * 32 + ((((k >> 3) ^ ((-(row >> 2)) & 3))) << 3) + (k & 7);
}
template <class FA, class FB>
__device__ __forceinline__ void engine(char* lds, int K, FA fa, FB fb) {
  float* stage = (float*)lds;
  __hip_bfloat16* Ab = (__hip_bfloat16*)(lds + OPS_OFF);
  __hip_bfloat16* Bb = Ab + 128 * 32;
  const int tid = tidx(), lane = tid & 63, wid = tid >> 6, wr = wid >> 1, wc = wid & 1, fr = lane & 15, fq = lane >> 4;
  f32x4 acc[4][4];
#pragma unroll
  for (int m = 0; m < 4; ++m)
#pragma unroll
    for (int n = 0; n < 4; ++n) acc[m][n] = (f32x4){0.f, 0.f, 0.f, 0.f};
  __syncthreads();
  for (int k0 = 0; k0 < K; k0 += 32) {
    for (int e = tid; e < 4096; e += 256) { int r = e >> 5, kk = e & 31; Ab[lrow_off(r, kk)] = __float2bfloat16(fa(r, k0 + kk)); }
    for (int e = tid; e < 4096; e += 256) { int kk = e >> 7, c = e & 127; Bb[lrow_off(c, kk)] = __float2bfloat16(fb(k0 + kk, c)); }
    __syncthreads();
    bf16x8 af[4], bfr[4];
#pragma unroll
    for (int m = 0; m < 4; ++m) af[m] = *(const bf16x8*)(Ab + lrow_off(wr * 64 + m * 16 + fr, fq * 8));
#pragma unroll
    for (int n = 0; n < 4; ++n) bfr[n] = *(const bf16x8*)(Bb + lrow_off(wc * 64 + n * 16 + fr, fq * 8));
#pragma unroll
    for (int m = 0; m < 4; ++m)
#pragma unroll
      for (int n = 0; n < 4; ++n) acc[m][n] = __builtin_amdgcn_mfma_f32_16x16x32_bf16(af[m], bfr[n], acc[m][n], 0, 0, 0);
    __syncthreads();
  }
#pragma unroll
  for (int m = 0; m < 4; ++m)
#pragma unroll
    for (int n = 0; n < 4; ++n)
#pragma unroll
      for (int j = 0; j < 4; ++j) stage[(wr * 64 + m * 16 + fq * 4 + j) * ST_LD + wc * 64 + n * 16 + fr] = acc[m][n][j];
  __syncthreads();
}
#endif


#if !EXACT
typedef __attribute__((ext_vector_type(2))) __bf16 bf2_t;
typedef __attribute__((ext_vector_type(2))) float f2_t;
__device__ __forceinline__ unsigned pk2(float a, float b) { f2_t f = {a, b}; bf2_t r = __builtin_convertvector(f, bf2_t); return *(unsigned*)&r; }
__device__ __forceinline__ float bf_lo(unsigned u) { return __uint_as_float(u << 16); }
__device__ __forceinline__ float bf_hi(unsigned u) { return __uint_as_float(u & 0xffff0000u); }
__device__ __forceinline__ int row_off(int r, int c) { return r * 64 + ((c ^ ((-(r >> 2)) & 3)) << 4); }
__device__ __forceinline__ int col_perm(int n) { return (n & ~31) | ((n >> 2) & 3) | ((((n >> 4) ^ n) & 1) << 2) | (((n >> 1) & 1) << 3) | ((n & 1) << 4); }
__device__ __forceinline__ int col_off(int n, int c) { return (c * 128 + col_perm(n)) * 16; }

typedef unsigned u32x4 __attribute__((ext_vector_type(4)));
typedef unsigned u32x2 __attribute__((ext_vector_type(2)));
typedef float fx4 __attribute__((ext_vector_type(4)));
template <bool CHK>
struct LdRow {
  static constexpr bool COL = false;
  const __hip_bfloat16 *p0, *p1; u32x4 v0[2], v1[2]; int o0;
  template <class RP> __device__ __forceinline__ void init(RP rp) {
    int ch = tidx() & 3, r0 = tidx() >> 2;
    const __hip_bfloat16* a = rp(r0); const __hip_bfloat16* b = rp(r0 + 64);
    p0 = a ? a + ch * 8 : nullptr; p1 = b ? b + ch * 8 : nullptr;
    o0 = row_off(r0, ch);
  }
  template <int S> __device__ __forceinline__ void fetch(int kt) {
    const u32x4 z = {0u, 0u, 0u, 0u};
    if (CHK) {
      v0[S] = z; v1[S] = z;
      if (p0) v0[S] = *(const u32x4*)(p0 + kt * 32);
      if (p1) v1[S] = *(const u32x4*)(p1 + kt * 32);
    } else { v0[S] = *(const u32x4*)(p0 + kt * 32); v1[S] = *(const u32x4*)(p1 + kt * 32); }
  }
  template <int S> __device__ __forceinline__ void commit(char* buf, int) { *(u32x4*)(buf + o0) = v0[S]; *(u32x4*)(buf + o0 + 4096) = v1[S]; }
};
__device__ __forceinline__ u32x4 scale8(u32x4 v, float s) {
  u32x4 r;
  r.x = pk2(bf_lo(v.x) * s, bf_hi(v.x) * s); r.y = pk2(bf_lo(v.y) * s, bf_hi(v.y) * s);
  r.z = pk2(bf_lo(v.z) * s, bf_hi(v.z) * s); r.w = pk2(bf_lo(v.w) * s, bf_hi(v.w) * s);
  return r;
}
struct LdRowS {
  static constexpr bool COL = false;
  const __hip_bfloat16 *p0, *p1; u32x4 v0[2], v1[2]; int o0; float s0, s1;
  template <class RP, class SC> __device__ __forceinline__ void init(RP rp, SC sc) {
    int ch = tidx() & 3, r0 = tidx() >> 2;
    p0 = rp(r0) + ch * 8; p1 = rp(r0 + 64) + ch * 8; s0 = sc(r0); s1 = sc(r0 + 64);
    o0 = row_off(r0, ch);
  }
  template <int S> __device__ __forceinline__ void fetch(int kt) { v0[S] = *(const u32x4*)(p0 + kt * 32); v1[S] = *(const u32x4*)(p1 + kt * 32); }
  template <int S> __device__ __forceinline__ void commit(char* buf, int) { *(u32x4*)(buf + o0) = scale8(v0[S], s0); *(u32x4*)(buf + o0 + 4096) = scale8(v1[S], s1); }
};
__device__ __forceinline__ unsigned silu_mul2(unsigned g, unsigned u) {
  float g0 = bf_lo(g), g1 = bf_hi(g), u0 = bf_lo(u), u1 = bf_hi(u);
  return pk2(g0 / (1.f + __expf(-g0)) * u0, g1 / (1.f + __expf(-g1)) * u1);
}
struct LdRowGU {
  static constexpr bool COL = false;
  const __hip_bfloat16 *p0, *p1; u32x4 g0[2], g1[2], u0[2], u1[2]; int o0; ptrdiff_t du;
  template <class RP> __device__ __forceinline__ void init(RP rp, ptrdiff_t du_) {
    int ch = tidx() & 3, r0 = tidx() >> 2;
    const __hip_bfloat16* a = rp(r0); const __hip_bfloat16* b = rp(r0 + 64);
    p0 = a ? a + ch * 8 : nullptr; p1 = b ? b + ch * 8 : nullptr; du = du_;
    o0 = row_off(r0, ch);
  }
  template <int S> __device__ __forceinline__ void fetch(int kt) {
    const u32x4 z = {0u, 0u, 0u, 0u};
    g0[S] = z; g1[S] = z; u0[S] = z; u1[S] = z;
    if (p0) { g0[S] = *(const u32x4*)(p0 + kt * 32); u0[S] = *(const u32x4*)(p0 + du + kt * 32); }
    if (p1) { g1[S] = *(const u32x4*)(p1 + kt * 32); u1[S] = *(const u32x4*)(p1 + du + kt * 32); }
  }
  template <int S> __device__ __forceinline__ void commit(char* buf, int) {
    u32x4 a, b;
    a.x = silu_mul2(g0[S].x, u0[S].x); a.y = silu_mul2(g0[S].y, u0[S].y); a.z = silu_mul2(g0[S].z, u0[S].z); a.w = silu_mul2(g0[S].w, u0[S].w);
    b.x = silu_mul2(g1[S].x, u1[S].x); b.y = silu_mul2(g1[S].y, u1[S].y); b.z = silu_mul2(g1[S].z, u1[S].z); b.w = silu_mul2(g1[S].w, u1[S].w);
    *(u32x4*)(buf + o0) = a; *(u32x4*)(buf + o0 + 4096) = b;
  }
};
struct LdColF {
  static constexpr bool COL = true;
  const float* p; size_t ld; fx4 w0[2], w1[2], w2[2], w3[2]; int ob; bool ok;
  __device__ __forceinline__ void init(const float* W, size_t ld_, int nvalid) {
    int half = tidx() & 1, n4 = (tidx() >> 1) & 31, ch = tidx() >> 6;
    ld = ld_; ok = 4 * n4 < nvalid;
    p = W + (size_t)(ch * 8 + half * 4) * ld + 4 * n4;
    ob = col_off(4 * n4, ch) + half * 8;
  }
  template <int S> __device__ __forceinline__ void fetch(int kt) {
    const fx4 z = {0.f, 0.f, 0.f, 0.f};
    w0[S] = z; w1[S] = z; w2[S] = z; w3[S] = z;
    if (ok) {
      const float* q = p + (size_t)(kt * 32) * ld;
      w0[S] = *(const fx4*)q; w1[S] = *(const fx4*)(q + ld); w2[S] = *(const fx4*)(q + 2 * ld); w3[S] = *(const fx4*)(q + 3 * ld);
    }
  }
  template <int S> __device__ __forceinline__ void commit(char* buf, int) {
    const int x1 = ob ^ 64;
    u32x2 t;
    t.x = pk2(w0[S].x, w1[S].x); t.y = pk2(w2[S].x, w3[S].x); *(u32x2*)(buf + ob) = t;
    t.x = pk2(w0[S].y, w1[S].y); t.y = pk2(w2[S].y, w3[S].y); *(u32x2*)(buf + x1 + 256) = t;
    t.x = pk2(w0[S].z, w1[S].z); t.y = pk2(w2[S].z, w3[S].z); *(u32x2*)(buf + ob + 128) = t;
    t.x = pk2(w0[S].w, w1[S].w); t.y = pk2(w2[S].w, w3[S].w); *(u32x2*)(buf + x1 + 384) = t;
  }
};
template <int SMODE>
struct LdColH {
  static constexpr bool COL = true;
  const __hip_bfloat16* p; size_t ld; u32x2 h0[2], h1[2], h2[2], h3[2]; int ob; float sl; int kb; bool ok;
  __device__ __forceinline__ void init(const __hip_bfloat16* W, size_t ld_, float sl_, int nvalid = 128) {
    int half = tidx() & 1, n4 = (tidx() >> 1) & 31, ch = tidx() >> 6;
    ld = ld_; sl = sl_; kb = ch * 8 + half * 4; ok = 4 * n4 < nvalid;
    p = W + (size_t)kb * ld + 4 * n4;
    ob = col_off(4 * n4, ch) + half * 8;
  }
  template <int S> __device__ __forceinline__ void fetch(int kt) {
    const __hip_bfloat16* q = p + (size_t)(kt * 32) * ld;
    const u32x2 z = {0u, 0u};
    h0[S] = z; h1[S] = z; h2[S] = z; h3[S] = z;
    if (ok) { h0[S] = *(const u32x2*)q; h1[S] = *(const u32x2*)(q + ld); h2[S] = *(const u32x2*)(q + 2 * ld); h3[S] = *(const u32x2*)(q + 3 * ld); }
  }
  template <int S> __device__ __forceinline__ void commit(char* buf, int kt) {
    const int x1 = ob ^ 64;
    const u32x2 a0 = h0[S], a1 = h1[S], a2 = h2[S], a3 = h3[S];
    u32x2 t;
    if (SMODE == 0) {
      t.x = (a0.x & 0xffffu) | (a1.x << 16); t.y = (a2.x & 0xffffu) | (a3.x << 16); *(u32x2*)(buf + ob) = t;
      t.x = (a0.x >> 16) | (a1.x & 0xffff0000u); t.y = (a2.x >> 16) | (a3.x & 0xffff0000u); *(u32x2*)(buf + x1 + 256) = t;
      t.x = (a0.y & 0xffffu) | (a1.y << 16); t.y = (a2.y & 0xffffu) | (a3.y << 16); *(u32x2*)(buf + ob + 128) = t;
      t.x = (a0.y >> 16) | (a1.y & 0xffff0000u); t.y = (a2.y >> 16) | (a3.y & 0xffff0000u); *(u32x2*)(buf + x1 + 384) = t;
    } else {
      const int k = kt * 32 + kb;
      const float z0 = __builtin_amdgcn_exp2f(sl * (float)(SMODE == 1 ? 127 - k : k)), z1 = __builtin_amdgcn_exp2f(sl * (float)(SMODE == 1 ? 126 - k : k + 1)),
                  z2 = __builtin_amdgcn_exp2f(sl * (float)(SMODE == 1 ? 125 - k : k + 2)), z3 = __builtin_amdgcn_exp2f(sl * (float)(SMODE == 1 ? 124 - k : k + 3));
      t.x = pk2(bf_lo(a0.x) * z0, bf_lo(a1.x) * z1); t.y = pk2(bf_lo(a2.x) * z2, bf_lo(a3.x) * z3); *(u32x2*)(buf + ob) = t;
      t.x = pk2(bf_hi(a0.x) * z0, bf_hi(a1.x) * z1); t.y = pk2(bf_hi(a2.x) * z2, bf_hi(a3.x) * z3); *(u32x2*)(buf + x1 + 256) = t;
      t.x = pk2(bf_lo(a0.y) * z0, bf_lo(a1.y) * z1); t.y = pk2(bf_lo(a2.y) * z2, bf_lo(a3.y) * z3); *(u32x2*)(buf + ob + 128) = t;
      t.x = pk2(bf_hi(a0.y) * z0, bf_hi(a1.y) * z1); t.y = pk2(bf_hi(a2.y) * z2, bf_hi(a3.y) * z3); *(u32x2*)(buf + x1 + 384) = t;
    }
  }
};
template <bool COL> __device__ __forceinline__ int frag_off(int base, int t, int fr, int fq) {
  return COL ? col_off(base + t * 16 + fr, fq) : row_off(base + t * 16 + fr, fq);
}
constexpr int FBUF_A0 = 0, FBUF_B0 = 32768;

__device__ __forceinline__ void mma_step(const char* bA, const char* bB, const int (&ao)[4], const int (&bo)[4], f32x4 (&acc)[4][4]) {
  bf16x8 af[4], bfr[4];
#pragma unroll
  for (int t = 0; t < 4; ++t) { af[t] = *(const bf16x8*)(bA + ao[t]); bfr[t] = *(const bf16x8*)(bB + bo[t]); }
#pragma unroll
  for (int m = 0; m < 4; ++m)
#pragma unroll
    for (int n = 0; n < 4; ++n) acc[m][n] = __builtin_amdgcn_mfma_f32_16x16x32_bf16(af[m], bfr[n], acc[m][n], 0, 0, 0);
}
template <class LA, class LB, int VAR = 0, bool PIN = true>
__device__ __forceinline__ void gemm_core(char* lds, int nk, LA& la, LB& lb, f32x4 (&acc)[4][4]) {
  const int lane = tidx() & 63, wid = tidx() >> 6, wr = wid >> 1, wc = wid & 1, fr = lane & 15, fq = lane >> 4;
  int ao[4], bo[4];
#pragma unroll
  for (int t = 0; t < 4; ++t) { ao[t] = frag_off<LA::COL>(wr * 64, t, fr, fq); bo[t] = frag_off<LB::COL>(wc * 64, t, fr, fq); }
  la.template fetch<0>(0); lb.template fetch<0>(0);
  la.template fetch<1>(1); lb.template fetch<1>(1);
  __syncthreads();
  la.template commit<0>(lds + FBUF_A0, 0); lb.template commit<0>(lds + FBUF_B0, 0);
  la.template commit<1>(lds + FBUF_A0 + 8192, 1); lb.template commit<1>(lds + FBUF_B0 + 8192, 1);
  __syncthreads();
  for (int kt = 0; kt < nk; kt += 2) {
    const int cur = (kt & 2) << 13;
    const bool more = kt + 2 < nk;
    if (VAR != 1 && more) {
      const int k0 = kt + 2;
      la.template fetch<0>(k0); lb.template fetch<0>(k0);
      la.template fetch<1>(k0 + 1); lb.template fetch<1>(k0 + 1);
    }
    if (PIN) __builtin_amdgcn_sched_barrier(0);
    if (VAR != 2) {
      mma_step(lds + FBUF_A0 + cur, lds + FBUF_B0 + cur, ao, bo, acc);
      mma_step(lds + FBUF_A0 + cur + 8192, lds + FBUF_B0 + cur + 8192, ao, bo, acc);
    }
    if (PIN) __builtin_amdgcn_sched_barrier(0);
    if (VAR != 3 && more) {
      const int nxt = cur ^ 16384;
      la.template commit<0>(lds + FBUF_A0 + nxt, kt + 2); lb.template commit<0>(lds + FBUF_B0 + nxt, kt + 2);
      la.template commit<1>(lds + FBUF_A0 + nxt + 8192, kt + 3); lb.template commit<1>(lds + FBUF_B0 + nxt + 8192, kt + 3);
    }
    __syncthreads();
  }
}
__device__ __forceinline__ void glds16(const void* g, char* l) {
  __builtin_amdgcn_global_load_lds((const void*)g, (LAS void*)l, 16, 0, 0);
}
__device__ __forceinline__ int glds_chunk_off() {
  const int r0 = tidx() >> 2, cp = tidx() & 3;
  return ((cp ^ ((-(r0 >> 2)) & 3)) << 3);
}
__device__ __forceinline__ void gemm_core_g(char* lds, int nk, const __hip_bfloat16* a0, const __hip_bfloat16* a1,
                                            const __hip_bfloat16* b0, const __hip_bfloat16* b1, f32x4 (&acc)[4][4]) {
  const int tid = tidx(), lane = tid & 63, wid = tid >> 6, wr = wid >> 1, wc = wid & 1, fr = lane & 15, fq = lane >> 4;
  int ao[4], bo[4];
#pragma unroll
  for (int t = 0; t < 4; ++t) { ao[t] = row_off(wr * 64 + t * 16 + fr, fq); bo[t] = row_off(wc * 64 + t * 16 + fr, fq); }
  char* my = lds + tid * 16;
  __syncthreads();
  glds16(a0, my); glds16(a1, my + 4096); glds16(b0, my + 8192); glds16(b1, my + 12288);
  glds16(a0 + 32, my + 16384); glds16(a1 + 32, my + 16384 + 4096); glds16(b0 + 32, my + 16384 + 8192); glds16(b1 + 32, my + 16384 + 12288);
  for (int kt = 0; kt < nk - 2; ++kt) {
    { const int kf = (kt + 2) * 32; char* d = my + ((kt + 2) & 3) * 16384;
      glds16(a0 + kf, d); glds16(a1 + kf, d + 4096); glds16(b0 + kf, d + 8192); glds16(b1 + kf, d + 12288); }
    asm volatile("s_waitcnt vmcnt(8)" ::: "memory");
    __builtin_amdgcn_s_barrier();
    asm volatile("" ::: "memory");
    const char* st = lds + (kt & 3) * 16384;
    mma_step(st, st + 8192, ao, bo, acc);
  }
  {
    asm volatile("s_waitcnt vmcnt(4)" ::: "memory");
    __builtin_amdgcn_s_barrier();
    asm volatile("" ::: "memory");
    const char* st = lds + ((nk - 2) & 3) * 16384;
    mma_step(st, st + 8192, ao, bo, acc);
    asm volatile("s_waitcnt vmcnt(0)" ::: "memory");
    __builtin_amdgcn_s_barrier();
    asm volatile("" ::: "memory");
    st = lds + ((nk - 1) & 3) * 16384;
    mma_step(st, st + 8192, ao, bo, acc);
  }
  __syncthreads();
}
__device__ __forceinline__ void acc_zero(f32x4 (&acc)[4][4]) {
#pragma unroll
  for (int m = 0; m < 4; ++m)
#pragma unroll
    for (int n = 0; n < 4; ++n) acc[m][n] = (f32x4){0.f, 0.f, 0.f, 0.f};
}
__device__ __forceinline__ void acc_to_stage(char* lds, f32x4 (&acc)[4][4]) {
  float* stage = (float*)lds;
  const int lane = tidx() & 63, wid = tidx() >> 6, wr = wid >> 1, wc = wid & 1, fr = lane & 15, fq = lane >> 4;
#pragma unroll
  for (int m = 0; m < 4; ++m)
#pragma unroll
    for (int n = 0; n < 4; ++n)
#pragma unroll
      for (int j = 0; j < 4; ++j) stage[(wr * 64 + m * 16 + fq * 4 + j) * ST_LD + wc * 64 + n * 16 + fr] = acc[m][n][j];
  __syncthreads();
}
__device__ __forceinline__ void st4bf(__hip_bfloat16* p, float4 v) { *(uint2*)p = make_uint2(pk2(v.x, v.y), pk2(v.z, v.w)); }
#endif

__device__ __forceinline__ void stA4(AT* p, float4 v) { stA(p, v.x); stA(p + 1, v.y); stA(p + 2, v.z); stA(p + 3, v.w); }

__device__ __forceinline__ void ph_ada1(const Params& p, int bid, int nb, char* lds) {
  float* s = (float*)lds;
  for (int item = bid; item < 4 * 24 * 8; item += nb) {
    int ks = item & 7, cb = (item >> 3) % 24, l = item / 192;
    __syncthreads();
    for (int e = tidx(); e < 5 * 128; e += 256) {
      int r = e >> 7, k = (e & 127) + ks * 128;
      float cv = r < 4 ? p.c[r * 1024 + k] : p.c_ctx[k];
      s[e] = silu_f(cv);
    }
    __syncthreads();
    int col = cb * 256 + tidx();
    float a0 = 0.f, a1 = 0.f, a2 = 0.f, a3 = 0.f, a4 = 0.f;
    const float* w = p.ada_w + ((size_t)l * 1024 + ks * 128) * 6144 + col;
    for (int k = 0; k < 128; ++k) {
      float wv = w[(size_t)k * 6144];
      a0 = fmaf(s[k], wv, a0); a1 = fmaf(s[128 + k], wv, a1); a2 = fmaf(s[256 + k], wv, a2); a3 = fmaf(s[384 + k], wv, a3); a4 = fmaf(s[512 + k], wv, a4);
    }
    float* mp = p.modp + ((size_t)(l * 8 + ks) * 5) * 6144 + col;
    mp[0] = a0; mp[6144] = a1; mp[2 * 6144] = a2; mp[3 * 6144] = a3; mp[4 * 6144] = a4;
  }
}
#if !EXACT
__device__ __forceinline__ void conv_dense_weights(const Params& p, int bid, int nb, char* lds) {
  float* tile = (float*)lds;
  const int tid = tidx(), tx = tid & 31, ty = tid >> 5;
  const int tiles_abin = 16 * 96, tiles_about = 16 * 32, tiles_min = 16 * 21, tiles_uq = 6 * 48, tiles_ukv = 4 * 64, tiles_mout = 16 * 32;
  const int per_layer = tiles_abin + tiles_about + tiles_min + tiles_uq + tiles_ukv + tiles_mout;
  for (int item = bid; item < 2 * per_layer; item += nb) {
    const int li = item / per_layer; int t = item % per_layer;
    const float* src; AT* dst; int K, N;
    if (t < tiles_abin) { src = p.ab_w_in + (size_t)li * 1024 * 3072; dst = p.WB + WB_ABIN + (size_t)li * 1024 * 3072; K = 1024; N = 3072; }
    else if ((t -= tiles_abin) < tiles_about) { src = p.ab_w_out + (size_t)li * 1024 * 1024; dst = p.WB + WB_ABOUT + (size_t)li * 1024 * 1024; K = 1024; N = 1024; }
    else if ((t -= tiles_about) < tiles_min) { src = p.mla_w_in + (size_t)li * 1024 * 672; dst = p.WB + WB_MIN + (size_t)li * 1024 * 672; K = 1024; N = 672; }
    else if ((t -= tiles_min) < tiles_uq) { src = p.w_uq + (size_t)li * 384 * 1536; dst = p.WB + WB_UQ + (size_t)li * 384 * 1536; K = 384; N = 1536; }
    else if ((t -= tiles_uq) < tiles_ukv) { src = p.w_ukv + (size_t)li * 256 * 2048; dst = p.WB + WB_UKV + (size_t)li * 256 * 2048; K = 256; N = 2048; }
    else { t -= tiles_ukv; src = p.mla_w_out + (size_t)li * 1024 * 1024; dst = p.WB + WB_MOUT + (size_t)li * 1024 * 1024; K = 1024; N = 1024; }
    const int ntn = N / 32, kt = t / ntn, nt = t % ntn;
    __syncthreads();
#pragma unroll
    for (int i = 0; i < 8; ++i) tile[(ty + 8 * i) * 33 + tx] = src[(size_t)(kt * 64 + ty + 8 * i) * N + nt * 32 + tx];
    __syncthreads();
    {
      const int n = tid >> 3, k8 = (tid & 7) * 8;
      const float* c = tile + k8 * 33 + n;
      u32x4 o;
      o.x = pk2(c[0], c[33]); o.y = pk2(c[2 * 33], c[3 * 33]); o.z = pk2(c[4 * 33], c[5 * 33]); o.w = pk2(c[6 * 33], c[7 * 33]);
      *(u32x4*)(dst + (size_t)(nt * 32 + n) * K + kt * 64 + k8) = o;
    }
  }
}
#endif

#if !EXACT
constexpr size_t WM_GATE = 0, WM_UP = (size_t)128 * 1024 * 512, WM_DOWN = (size_t)2 * 128 * 1024 * 512;
__device__ __forceinline__ void conv_moe_weights(const Params& p, int bid, int nb, char* lds) {
  float* tile = (float*)lds;
  const int tid = tidx();
  const int rk = tid >> 5, rn4 = (tid & 31) * 4;
  const int wn = tid >> 1, wk = (tid & 1) * 64;
  const int NT = 3 * 128 * 32;
  for (int item = bid; item < NT; item += nb) {
    const int tns = item / (128 * 32), rem = item % (128 * 32), mat = rem >> 5, t = rem & 31;
    const float* src; AT* dst; int K, N;
    if (tns == 0) { src = p.w_gate + (size_t)mat * 1024 * 512; dst = p.WM + WM_GATE + (size_t)mat * 1024 * 512; K = 1024; N = 512; }
    else if (tns == 1) { src = p.w_up + (size_t)mat * 1024 * 512; dst = p.WM + WM_UP + (size_t)mat * 1024 * 512; K = 1024; N = 512; }
    else { src = p.w_down + (size_t)mat * 512 * 1024; dst = p.WM + WM_DOWN + (size_t)mat * 512 * 1024; K = 512; N = 1024; }
    const int ntn = N >> 7, kt = t / ntn, nt = t % ntn;
    fx4 v[16];
    const float* q = src + (size_t)(kt * 128 + rk) * N + nt * 128 + rn4;
#pragma unroll
    for (int i = 0; i < 16; ++i) v[i] = *(const fx4*)(q + (size_t)(8 * i) * N);
    __syncthreads();
#pragma unroll
    for (int i = 0; i < 16; ++i) {
      float* t0 = tile + (rk + 8 * i) * 129 + rn4;
      t0[0] = v[i].x; t0[1] = v[i].y; t0[2] = v[i].z; t0[3] = v[i].w;
    }
    __syncthreads();
    AT* d = dst + (size_t)(nt * 128 + wn) * K + kt * 128 + wk;
    const float* c = tile + wk * 129 + wn;
#pragma unroll
    for (int g = 0; g < 8; ++g) {
      u32x4 o;
      o.x = pk2(c[(8 * g + 0) * 129], c[(8 * g + 1) * 129]); o.y = pk2(c[(8 * g + 2) * 129], c[(8 * g + 3) * 129]);
      o.z = pk2(c[(8 * g + 4) * 129], c[(8 * g + 5) * 129]); o.w = pk2(c[(8 * g + 6) * 129], c[(8 * g + 7) * 129]);
      *(u32x4*)(d + 8 * g) = o;
    }
  }
}
#endif
__device__ __forceinline__ void ph_ada2(const Params& p, int bid, int nb) {
  int gtid = bid * 256 + tidx(), gsz = nb * 256;
  for (int i = gtid; i < 4 * 5 * 6144; i += gsz) {
    int l = i / 30720, rem = i % 30720, r = rem / 6144, col = rem % 6144;
    float v = p.ada_b[l * 6144 + col];
    for (int ks = 0; ks < 8; ++ks) v += p.modp[((size_t)(l * 8 + ks) * 5 + r) * 6144 + col];
    p.mod[i] = v;
  }
  for (int i = gtid; i < 4096 * 64; i += gsz) {
    int t = i >> 6, k = i & 63;
    float inv = (float)exp(-(double)(2 * k) / 128.0 * 9.210340371976184);
    float ang = (float)t * inv, sn, cs;
    sincos_acc(ang, sn, cs);
    p.cs1c[i] = cs; p.cs1s[i] = sn;
  }
#if !EXACT
  for (int i = gtid; i < 4 * 128 * 48 * 8; i += gsz) {
    int j = i & 7, n = (i >> 3) % 48, c = (i / 384) & 127, l = i / (384 * 128), k = c * 8 + j;
    float w = n < 4 ? p.grp_w[((size_t)l * 1024 + k) * 4 + n] : (n < 36 ? p.exp_w[((size_t)l * 1024 + k) * 32 + n - 4] : 0.f);
    __hip_bfloat16 hi = __float2bfloat16(w);
    __hip_bfloat16 lo = __float2bfloat16(w - __bfloat162float(hi));
    size_t o = (((size_t)(l * 2 + 0) * 128 + c) * 48 + n) * 8 + j;
    p.WR[o] = *(unsigned short*)&hi;
    p.WR[o + (size_t)128 * 48 * 8] = *(unsigned short*)&lo;
  }
#endif
  for (int i = gtid; i < 4096 * 16; i += gsz) {
    int t = i >> 4, a = i & 15, j = a & 7;
    float inv = (float)exp(-(double)(2 * j) / 16.0 * 9.210340371976184);
    float pos = a < 8 ? (float)(t >> 6) : (float)(t & 63);
    float ang = pos * inv, sn, cs;
    sincos_acc(ang, sn, cs);
    p.cs2c[i] = cs; p.cs2s[i] = sn;
  }
}

__device__ __forceinline__ void ph_T1(const Params& p, int l, int bid, int nb) {
  int wave = tidx() >> 6, lane = tidx() & 63;
  const float* g = p.norm_g + (l * 2 + 0) * 1024;
  for (int tok = bid * 4 + wave; tok < NTOK; tok += nb * 4) {
    int mr = tok_modrow(tok);
    const float* src = (l == 0) ? (tok < NCTX ? p.ctx + (size_t)tok * 1024 : p.x + (size_t)(tok - NCTX) * 1024) : p.X + (size_t)tok * 1024;
    float v[16];
#pragma unroll
    for (int i = 0; i < 4; ++i) { float4 t4 = *(const float4*)(src + i * 256 + lane * 4); v[i * 4] = t4.x; v[i * 4 + 1] = t4.y; v[i * 4 + 2] = t4.z; v[i * 4 + 3] = t4.w; }
    if (l > 0) {
      const float* gm = p.mod + ((size_t)(l - 1) * 5 + mr) * 6144 + 5 * 1024;
      const AT* y0 = p.Y + (size_t)(tok * 2) * 1024; const AT* y1 = y0 + 1024;
#pragma unroll
      for (int i = 0; i < 4; ++i)
#pragma unroll
        for (int cc = 0; cc < 4; ++cc) { int col = i * 256 + lane * 4 + cc; v[i * 4 + cc] += gm[col] * (ldA(y0 + col) + ldA(y1 + col)); }
    }
    float ss = 0.f;
#pragma unroll
    for (int i = 0; i < 16; ++i) ss += v[i] * v[i];
    ss = wave_sum(ss);
    float rstd = rsqrtf(ss * (1.f / 1024.f) + EPSF);
    const float* md = p.mod + ((size_t)l * 5 + mr) * 6144;
#pragma unroll
    for (int i = 0; i < 4; ++i) {
      int col = i * 256 + lane * 4;
      *(float4*)(p.X + (size_t)tok * 1024 + col) = make_float4(v[i * 4], v[i * 4 + 1], v[i * 4 + 2], v[i * 4 + 3]);
#pragma unroll
      for (int cc = 0; cc < 4; ++cc) {
        float h = v[i * 4 + cc] * rstd * g[col + cc] * (1.f + md[1024 + col + cc]) + md[col + cc];
        stA(p.H + (size_t)tok * 1024 + col + cc, h);
      }
    }
  }
}
__device__ __forceinline__ void ph_final(const Params& p, int bid, int nb) {
  int wave = tidx() >> 6, lane = tidx() & 63;
  for (int tok = NCTX + bid * 4 + wave; tok < NTOK; tok += nb * 4) {
    int mr = tok_modrow(tok);
    const float* src = p.X + (size_t)tok * 1024;
    const float* gm = p.mod + ((size_t)3 * 5 + mr) * 6144 + 5 * 1024;
    const AT* y0 = p.Y + (size_t)(tok * 2) * 1024; const AT* y1 = y0 + 1024;
    float v[16];
    float ss = 0.f;
#pragma unroll
    for (int i = 0; i < 4; ++i)
#pragma unroll
      for (int cc = 0; cc < 4; ++cc) { int col = i * 256 + lane * 4 + cc; float t = src[col] + gm[col] * (ldA(y0 + col) + ldA(y1 + col)); v[i * 4 + cc] = t; ss += t * t; }
    ss = wave_sum(ss);
    float rstd = rsqrtf(ss * (1.f / 1024.f) + EPSF);
#pragma unroll
    for (int i = 0; i < 4; ++i) {
      int col = i * 256 + lane * 4;
      *(float4*)(p.out + (size_t)(tok - NCTX) * 1024 + col) = make_float4(v[i * 4] * rstd * p.final_g[col], v[i * 4 + 1] * rstd * p.final_g[col + 1],
                                                                           v[i * 4 + 2] * rstd * p.final_g[col + 2], v[i * 4 + 3] * rstd * p.final_g[col + 3]);
    }
  }
}

#define EPI_BEGIN for (int e_ = tidx(); e_ < 128 * 32; e_ += 256) { const int row = e_ >> 5, c4 = (e_ & 31) << 2; float4 v = *(const float4*)(stage + row * ST_LD + c4);
#define EPI_END }

__device__ __forceinline__ void ph_gemm_store(const Params& p, const AT* A, int lda, const float* W, int K, int N, AT* O, int ldo, int rt0, int bid, int nb, char* lds) {
  float* stage = (float*)lds;
  const int nct = (N + 127) / 128;
  const int nitems = (NRT - rt0) * nct;
  for (int item = bid; item < nitems; item += nb) {
    int ct = item % nct, rt = rt0 + item / nct;
    engine(lds, K,
           [&](int r, int k) { return ldA(A + (size_t)(rt * 128 + r) * lda + k); },
           [&](int k, int c) { int col = ct * 128 + c; return col < N ? W[(size_t)k * N + col] : 0.f; });
    EPI_BEGIN
      int col = ct * 128 + c4;
      if (col < N) stA4(O + (size_t)(rt * 128 + row) * ldo + col, v);
    EPI_END
  }
}
__device__ __forceinline__ void ph_gemm_resid(const Params& p, int l, const AT* A, const float* W, int rt0, int bid, int nb, char* lds) {
  float* stage = (float*)lds;
  const int nitems = (NRT - rt0) * 8;
  for (int item = bid; item < nitems; item += nb) {
    int ct = item & 7, rt = rt0 + (item >> 3);
    engine(lds, 1024,
           [&](int r, int k) { return ldA(A + (size_t)(rt * 128 + r) * 1024 + k); },
           [&](int k, int c) { return W[(size_t)k * 1024 + ct * 128 + c]; });
    int mr = tok_modrow(rt * 128);
    const float* gm = p.mod + ((size_t)l * 5 + mr) * 6144 + 2 * 1024 + ct * 128;
    EPI_BEGIN
      float* xp = p.X + (size_t)(rt * 128 + row) * 1024 + ct * 128 + c4;
      float4 xv = *(float4*)xp;
      xv.x += gm[c4] * v.x; xv.y += gm[c4 + 1] * v.y; xv.z += gm[c4 + 2] * v.z; xv.w += gm[c4 + 3] * v.w;
      *(float4*)xp = xv;
    EPI_END
  }
}

struct RetCtx { const AT* proj; const float* cc; const float* ss; int tok0; int t0; bool lat; int h; };
__device__ __forceinline__ float ret_rot(const RetCtx& r, int off, int j, int d) {
  const AT* base = r.proj + (size_t)(r.tok0 + j) * 3072 + off + r.h * 128;
#if !EXACT
  return ldA(base + d);
#endif
  if (!r.lat) return ldA(base + d);
  int i = d & 63;
  float x1 = ldA(base + i), x2 = ldA(base + 64 + i);
  float cs = r.cc[(r.t0 + j) * 64 + i], sn = r.ss[(r.t0 + j) * 64 + i];
  return d < 64 ? x1 * cs - x2 * sn : x1 * sn + x2 * cs;
}
__device__ __forceinline__ float ret_v(const RetCtx& r, int m, int e) { return ldA(r.proj + (size_t)(r.tok0 + m) * 3072 + 1024 + r.h * 128 + e); }

__device__ __forceinline__ void ph_R1(const Params& p, int l, int bid, int nb, char* lds) {
  const int li = l >> 1;
  float* stage = (float*)lds;
  const int NRET = NBAT * 4 * NCH;
  const int NLRU = NBAT * NCH * 8;
  for (int item = bid; item < NRET + NLRU; item += nb) {
    if (item < NRET) {
      int c = item % NCH, bh = item / NCH, h = bh & 3, b = bh >> 2;
      RetCtx rc{p.PROJ, p.cs1c, p.cs1s, chunk_tok0(b, c), (c - 2) * 128, c >= 2, h};
      for (int d = 0; d < 2; ++d) {
        float lg = -softplus_f(-p.ret_decay[(li * 2 + d) * 4 + h]);
        engine(lds, 128,
               [&](int r, int k) { float z = d == 0 ? expf(lg * (float)(127 - k)) : expf(lg * (float)k); return ret_rot(rc, 512, k, r) * KSCALE * z; },
               [&](int k, int cc) { return ret_v(rc, k, cc); });
        float* U = p.U + ((size_t)((b * 4 + h) * 2 + d) * NCH + c) * 16384;
        EPI_BEGIN
          *(float4*)(U + row * 128 + c4) = v;
        EPI_END
      }
    } else {
      int it = item - NRET;
      int kb = it & 7, c = (it >> 3) % NCH, b = it / (8 * NCH);
      float* us = (float*)lds;
      float* Wl = us + 128 * 64;
      int tok0 = chunk_tok0(b, c);
      int seqbase = c < 2 ? b * CTXL : NCTX + b * SEQ;
      int n = c < 2 ? CTXL : SEQ;
      int t0 = tok0 - seqbase;
      __syncthreads();
      for (int e = tidx(); e < 128 * 64; e += 256) {
        int pos = e >> 6, i = e & 63, ch = kb * 64 + i, t = t0 + pos;
        float acc = p.conv_b[li * 512 + ch];
#pragma unroll
        for (int tap = 0; tap < 4; ++tap) {
          int tt = t + tap - 2;
          if (tt >= 0 && tt < n) acc += p.conv_w[(li * 4 + tap) * 512 + ch] * ldA(p.PROJ + (size_t)(seqbase + tt) * 3072 + 2048 + ch);
        }
        us[e] = acc;
      }
      for (int e = tidx(); e < 4 * 4096; e += 256) {
        int dg = e >> 12, i = (e >> 6) & 63, j = e & 63, d = dg >> 1, g = dg & 1;
        Wl[e] = p.gate_w[((size_t)(((li * 2 + d) * 2 + g) * 8 + kb) * 64 + i) * 64 + j];
      }
      __syncthreads();
      if (tidx() < 128) {
        int d = tidx() >> 6, j = tidx() & 63, ch = kb * 64 + j;
        float sp = softplus_f(-p.lam[(li * 2 + d) * 512 + ch]);
        float br = p.gate_b[((li * 2 + d) * 2 + 0) * 512 + ch], bi = p.gate_b[((li * 2 + d) * 2 + 1) * 512 + ch];
        float h = 0.f, A = 1.f;
        const float* Wr = Wl + (d * 2 + 0) * 4096 + j;
        const float* Wi = Wl + (d * 2 + 1) * 4096 + j;
        for (int s = 0; s < 128; ++s) {
          int pos = d ? 127 - s : s;
          float r = br, ig = bi;
          const float* up = us + pos * 64;
#pragma unroll 8
          for (int i = 0; i < 64; ++i) { float uv = up[i]; r = fmaf(uv, Wr[i * 64], r); ig = fmaf(uv, Wi[i * 64], ig); }
          r = sigmoid_f(r); ig = sigmoid_f(ig);
          float la = -8.f * r * sp;
          float a = expf(la);
          float bt = sqrtf(-expm1f(2.f * la)) * (ig * up[j]);
          h = fmaf(a, h, bt); A *= a;
          size_t o = ((size_t)d * NTOK + tok0 + pos) * 512 + ch;
          p.HL[o] = h; p.AC[o] = A;
        }
        p.CHA[((d * 4 + b) * NCH + c) * 512 + ch] = A;
        p.CHH[((d * 4 + b) * NCH + c) * 512 + ch] = h;
      }
      __syncthreads();
    }
  }
}
__device__ __forceinline__ void ph_R2(const Params& p, int l, int bid, int nb) {
  const int li = l >> 1;
  int gtid = bid * 256 + tidx(), gsz = nb * 256;
  for (int i = gtid; i < 32 * 16384; i += gsz) {
    int el = i & 16383, bhd = i >> 14, d = bhd & 1, h = (bhd >> 1) & 3;
    float lg = -softplus_f(-p.ret_decay[(li * 2 + d) * 4 + h]);
    float dec = expf(lg * 128.f);
    float* base = p.U + (size_t)bhd * NCH * 16384 + el;
    float S = 0.f;
    for (int idx = 0; idx < NCH; ++idx) {
      int c = d == 0 ? idx : (idx < 2 ? 1 - idx : 35 - idx);
      float u = base[(size_t)c * 16384];
      base[(size_t)c * 16384] = S;
      S = fmaf(dec, S, u);
    }
  }
  for (int i = gtid; i < 2 * 4 * 512; i += gsz) {
    int ch = i & 511, db = i >> 9, d = db >> 2;
    float carry = 0.f;
    for (int idx = 0; idx < NCH; ++idx) {
      int c = d == 0 ? idx : (idx < 2 ? 1 - idx : 35 - idx);
      size_t o = ((size_t)db * NCH + c) * 512 + ch;
      p.CAR[o] = carry;
      carry = fmaf(p.CHA[o], carry, p.CHH[o]);
    }
  }
}
__device__ __forceinline__ void ph_R3(const Params& p, int l, int bid, int nb, char* lds) {
  const int li = l >> 1;
  float* stage = (float*)lds;
  const int NRET = NBAT * 4 * NCH;
  float* scr = p.SCR + (size_t)bid * 16384;
  for (int item = bid; item < NRET + NRT; item += nb) {
    if (item < NRET) {
      int c = item % NCH, bh = item / NCH, h = bh & 3, b = bh >> 2;
      RetCtx rc{p.PROJ, p.cs1c, p.cs1s, chunk_tok0(b, c), (c - 2) * 128, c >= 2, h};
      float lg0 = -softplus_f(-p.ret_decay[(li * 2 + 0) * 4 + h]);
      float lg1 = -softplus_f(-p.ret_decay[(li * 2 + 1) * 4 + h]);
      engine(lds, 128,
             [&](int r, int k) { return ret_rot(rc, 0, r, k); },
             [&](int k, int cc) { return ret_rot(rc, 512, cc, k) * KSCALE; });
      EPI_BEGIN
        float o4[4] = {v.x, v.y, v.z, v.w};
#pragma unroll
        for (int q = 0; q < 4; ++q) {
          int m = c4 + q;
          float M = row > m ? expf(lg0 * (float)(row - m)) : (row < m ? expf(lg1 * (float)(m - row)) : 2.f);
          scr[row * 128 + m] = o4[q] * M;
        }
      EPI_END
      __syncthreads();
      const float* S0 = p.U + ((size_t)((b * 4 + h) * 2 + 0) * NCH + c) * 16384;
      const float* S1 = p.U + ((size_t)((b * 4 + h) * 2 + 1) * NCH + c) * 16384;
      engine(lds, 384,
             [&](int r, int k) {
               if (k < 128) return scr[r * 128 + k];
               if (k < 256) return ret_rot(rc, 0, r, k - 128) * expf(lg0 * (float)(r + 1));
               return ret_rot(rc, 0, r, k - 256) * expf(lg1 * (float)(128 - r));
             },
             [&](int k, int cc) {
               if (k < 128) return ret_v(rc, k, cc);
               if (k < 256) return S0[(k - 128) * 128 + cc];
               return S1[(k - 256) * 128 + cc];
             });
      EPI_BEGIN
        float ss = v.x * v.x + v.y * v.y + v.z * v.z + v.w * v.w;
        ss = half_sum(ss);
        float rs = rsqrtf(ss * (1.f / 128.f) + EPSF);
        int tok = rc.tok0 + row;
        const AT* gp = p.PROJ + (size_t)tok * 3072 + 1536 + h * 128 + c4;
        float4 o = make_float4(v.x * rs * silu_f(ldA(gp)), v.y * rs * silu_f(ldA(gp + 1)), v.z * rs * silu_f(ldA(gp + 2)), v.w * rs * silu_f(ldA(gp + 3)));
        stA4(p.MIX + (size_t)tok * 1024 + h * 128 + c4, o);
      EPI_END
      __syncthreads();
    } else {
      int rt = item - NRET, b, c;
      rt_to_bc(rt, b, c);
      for (int e = tidx(); e < 128 * 512; e += 256) {
        int pos = e >> 9, ch = e & 511, tok = rt * 128 + pos;
        size_t o0 = ((size_t)0 * NTOK + tok) * 512 + ch, o1 = ((size_t)1 * NTOK + tok) * 512 + ch;
        float hf = p.HL[o0] + p.AC[o0] * p.CAR[((0 * 4 + b) * NCH + c) * 512 + ch];
        float hb = p.HL[o1] + p.AC[o1] * p.CAR[((1 * 4 + b) * NCH + c) * 512 + ch];
        float y = ldA(p.PROJ + (size_t)tok * 3072 + 2560 + ch);
        stA(p.MIX + (size_t)tok * 1024 + 512 + ch, (hf + hb) * gelu_tanh(y));
      }
    }
  }
}

__device__ __forceinline__ void ph_T2(const Params& p, int l, int bid, int nb, char* lds) {
  int wave = tidx() >> 6, lane = tidx() & 63;
  float* lg = (float*)(lds) + wave * 64;
  const float* g = p.norm_g + (l * 2 + 1) * 1024;
  const float* gw = p.grp_w + (size_t)l * 1024 * 4;
  const float* ew = p.exp_w + (size_t)l * 1024 * 32;
  const int gbeg = (l == 3) ? NCTX / 16 : 0;
  for (int grp = gbeg + bid; grp < NTOK / 16; grp += nb)
  for (int k4 = 0; k4 < 4; ++k4) {
    const int tok = grp * 16 + wave * 4 + k4;
    int mr = tok_modrow(tok);
    const float* src = p.X + (size_t)tok * 1024;
    const float* md = p.mod + ((size_t)l * 5 + mr) * 6144;
    float ss = 0.f;
#pragma unroll
    for (int i = 0; i < 4; ++i) { float4 t4 = *(const float4*)(src + i * 256 + lane * 4); ss += t4.x * t4.x + t4.y * t4.y + t4.z * t4.z + t4.w * t4.w; }
    ss = wave_sum(ss);
    float rstd = rsqrtf(ss * (1.f / 1024.f) + EPSF);
    float part[36];
#pragma unroll
    for (int j = 0; j < 36; ++j) part[j] = 0.f;
#pragma unroll 1
    for (int q = 0; q < 16; ++q) {
      int col = (q >> 2) * 256 + lane * 4 + (q & 3);
      float h = src[col] * rstd * g[col] * (1.f + md[4 * 1024 + col]) + md[3 * 1024 + col];
      stA(p.H + (size_t)tok * 1024 + col, h);
      float4 gv = *(const float4*)(gw + col * 4);
      part[0] = fmaf(h, gv.x, part[0]); part[1] = fmaf(h, gv.y, part[1]); part[2] = fmaf(h, gv.z, part[2]); part[3] = fmaf(h, gv.w, part[3]);
      const float4* ep = (const float4*)(ew + col * 32);
#pragma unroll
      for (int qq = 0; qq < 8; ++qq) { float4 e4 = ep[qq]; part[4 + qq * 4] = fmaf(h, e4.x, part[4 + qq * 4]); part[5 + qq * 4] = fmaf(h, e4.y, part[5 + qq * 4]); part[6 + qq * 4] = fmaf(h, e4.z, part[6 + qq * 4]); part[7 + qq * 4] = fmaf(h, e4.w, part[7 + qq * 4]); }
    }
#pragma unroll
    for (int j = 0; j < 36; ++j) { float t = wave_sum(part[j]); if (lane == 0) lg[j] = t; }
    if (lane == 0) {
      const float* gb = p.grp_b + l * 4;
      int gs = 0; float gm = lg[0] + gb[0];
      for (int j = 1; j < 4; ++j) { float t = lg[j] + gb[j]; if (t > gm) { gm = t; gs = j; } }
      float gsum = 0.f;
      for (int j = 0; j < 4; ++j) gsum += expf(lg[j] + gb[j] - gm);
      float gtop = 1.f / gsum;
      const float* wlp = lg + 4 + gs * 8;
      const float* eb = p.exp_b + l * 32 + gs * 8;
      int i0 = 0; float m0 = wlp[0] + eb[0];
      for (int j = 1; j < 8; ++j) { float t = wlp[j] + eb[j]; if (t > m0) { m0 = t; i0 = j; } }
      int i1 = -1; float m1 = -3.4e38f;
      for (int j = 0; j < 8; ++j) { float t = wlp[j] + eb[j]; if (j != i0 && t > m1) { m1 = t; i1 = j; } }
      float e1 = expf(m1 - m0);
      float p0 = 1.f / (1.f + e1), p1 = e1 / (1.f + e1);
      int ex0 = gs * 8 + i0, ex1 = gs * 8 + i1;
      p.re[tok * 2] = ex0; p.re[tok * 2 + 1] = ex1;
      p.rw[tok * 2] = gtop * p0; p.rw[tok * 2 + 1] = gtop * p1;

    }
  }
}

__device__ __forceinline__ void ph_RB(const Params& p, int l, int bid, int nb, char* lds) {
  int* sc = (int*)lds;
  const int tid = tidx(), lane = tid & 63, wid = tid >> 6;
  const int abeg = (l == 3) ? 2 * NCTX : 0;
  constexpr int PER = 136;
  for (int e = bid; e < 32; e += nb) {
    const int a0 = tid * PER;
    const int4* src = (const int4*)(p.re + a0);
    int c = 0;
    if (a0 + PER > abeg) {
#pragma unroll 34
      for (int i = 0; i < PER / 4; ++i) {
        const int4 q = src[i]; const int a = a0 + 4 * i;
        c += (q.x == e && a >= abeg) + (q.y == e && a + 1 >= abeg) + (q.z == e && a + 2 >= abeg) + (q.w == e && a + 3 >= abeg);
      }
    }
    int inc = c;
#pragma unroll
    for (int o = 1; o < 64; o <<= 1) { int t = __shfl_up(inc, o); if (lane >= o) inc += t; }
    __syncthreads();
    if (lane == 63) sc[wid] = inc;
    __syncthreads();
    int woff = 0;
    for (int w = 0; w < wid; ++w) woff += sc[w];
    const int total = sc[0] + sc[1] + sc[2] + sc[3];
    int o = woff + inc - c;
    int* lst = p.list + (size_t)e * NTOK;
    if (c > 0) {
#pragma unroll 17
      for (int i = 0; i < PER / 4; ++i) {
        const int4 q = src[i]; const int a = a0 + 4 * i;
        if (q.x == e && a >= abeg) lst[o++] = a;
        if (q.y == e && a + 1 >= abeg) lst[o++] = a + 1;
        if (q.z == e && a + 2 >= abeg) lst[o++] = a + 2;
        if (q.w == e && a + 3 >= abeg) lst[o++] = a + 3;
      }
    }
    if (tid == 0) p.cnt[(l * 32 + e) * 32] = total;
  }
}
__device__ __forceinline__ void moe_setup(const Params& p, int l, int* si) {
  __syncthreads();
  if (tidx() < 32) si[tidx()] = p.cnt[(l * 32 + tidx()) * 32];
  __syncthreads();
  if (tidx() == 0) {
    int b = 0, k = 0;
    for (int e = 0; e < 32; ++e) { si[32 + e] = b; si[65 + e] = k; b += si[e]; k += (si[e] + 127) >> 7; }
    si[64] = b; si[97] = k;
  }
  __syncthreads();
}
__device__ __forceinline__ void ph_E1(const Params& p, int l, int bid, int nb, char* lds) {
  float* stage = (float*)lds;
  int* si = (int*)(lds + MISC_OFF);
  moe_setup(p, l, si);
  const int nblk = si[97];
  for (int item = bid; item < nblk * 8; item += nb) {
    int nt = item & 7, bi = item >> 3;
    int e = 0;
    while (e < 31 && si[65 + e + 1] <= bi) ++e;
    int rb = bi - si[65 + e], cnt = si[e], base = si[32 + e];
    const int* lst = p.list + (size_t)e * NTOK + rb * 128;
    int nrow = cnt - rb * 128; if (nrow > 128) nrow = 128;
    const float* wg = p.w_gate + ((size_t)(l * 32 + e) * 1024) * 512 + nt * 64;
    const float* wu = p.w_up + ((size_t)(l * 32 + e) * 1024) * 512 + nt * 64;
    engine(lds, 1024,
           [&](int r, int k) { return r < nrow ? ldA(p.H + (size_t)(lst[r] >> 1) * 1024 + k) : 0.f; },
           [&](int k, int c) { return c < 64 ? wg[(size_t)k * 512 + c] : wu[(size_t)k * 512 + c - 64]; });
    for (int e_ = tidx(); e_ < 128 * 16; e_ += 256) {
      int row = e_ >> 4, c4 = (e_ & 15) << 2;
      if (row < nrow) {
        float4 gv = *(const float4*)(stage + row * ST_LD + c4), uv = *(const float4*)(stage + row * ST_LD + 64 + c4);
        float4 o = make_float4(silu_f(gv.x) * uv.x, silu_f(gv.y) * uv.y, silu_f(gv.z) * uv.z, silu_f(gv.w) * uv.w);
        stA4(p.HB + (size_t)(base + rb * 128 + row) * 512 + nt * 64 + c4, o);
      }
    }
  }
}
__device__ __forceinline__ void ph_E2(const Params& p, int l, int bid, int nb, char* lds) {
  float* stage = (float*)lds;
  int* si = (int*)(lds + MISC_OFF);
  moe_setup(p, l, si);
  const int nblk = si[97];
  for (int item = bid; item < nblk * 8; item += nb) {
    int ct = item & 7, bi = item >> 3;
    int e = 0;
    while (e < 31 && si[65 + e + 1] <= bi) ++e;
    int rb = bi - si[65 + e], cnt = si[e], base = si[32 + e];
    const int* lst = p.list + (size_t)e * NTOK + rb * 128;
    int nrow = cnt - rb * 128; if (nrow > 128) nrow = 128;
    const float* wd = p.w_down + ((size_t)(l * 32 + e) * 512) * 1024 + ct * 128;
    const AT* hb = p.HB + (size_t)(base + rb * 128) * 512;
    engine(lds, 512,
           [&](int r, int k) { return r < nrow ? ldA(hb + (size_t)r * 512 + k) : 0.f; },
           [&](int k, int c) { return wd[(size_t)k * 1024 + c]; });
    EPI_BEGIN
      if (row < nrow) {
        int a = lst[row];
        float w = p.rw[a];
        stA4(p.Y + (size_t)a * 1024 + ct * 128 + c4, make_float4(v.x * w, v.y * w, v.z * w, v.w * w));
      }
    EPI_END
  }
}

__device__ __forceinline__ void ph_MN(const Params& p, int l, int bid, int nb) {
  int wave = tidx() >> 6, lane = tidx() & 63;
  for (int grp = bid; grp < NTOK / 32; grp += nb)
#pragma unroll 4
  for (int k8 = 0; k8 < 8; ++k8) {
    const int tok = grp * 32 + wave * 8 + k8;
    const AT* pr = p.PROJ + (size_t)tok * P1LD;
    float sq = 0.f, skv = 0.f;
#pragma unroll
    for (int i = 0; i < 6; ++i) { float t = ldA(pr + i * 64 + lane); sq += t * t; }
#pragma unroll
    for (int i = 0; i < 4; ++i) { float t = ldA(pr + 384 + i * 64 + lane); skv += t * t; }
    sq = wave_sum(sq); skv = wave_sum(skv);
#if EXACT
    if (lane == 0) { p.RQ[tok] = rsqrtf(sq * (1.f / 384.f) + EPSF); p.RKV[tok] = rsqrtf(skv * (1.f / 256.f) + EPSF); }
#else
    {
      const float rq = rsqrtf(sq * (1.f / 384.f) + EPSF), rkv = rsqrtf(skv * (1.f / 256.f) + EPSF);
      const float* qg = p.q_g + (l >> 1) * 384; const float* kvg = p.kv_g + (l >> 1) * 256;
      AT* pw = p.PROJ + (size_t)tok * P1LD;
#pragma unroll
      for (int i = 0; i < 6; ++i) { int k = i * 64 + lane; stA(pw + k, ldA(pr + k) * rq * qg[k]); }
#pragma unroll
      for (int i = 0; i < 4; ++i) { int k = i * 64 + lane; stA(pw + 384 + k, ldA(pr + 384 + k) * rkv * kvg[k]); }
    }
#endif
    float kr = lane < 32 ? ldA(pr + 640 + lane) : 0.f;
    float other = __shfl_xor(kr, 16);
    int b, kpos; float outv = kr;
    if (tok < NCTX) { b = tok >> 8; kpos = tok & 255; }
    else {
      int t = (tok - NCTX) & 4095; b = (tok - NCTX) >> 12; kpos = CTXL + t;
      int i = lane & 15;
      float cs = p.cs2c[t * 16 + i], sn = p.cs2s[t * 16 + i];
      outv = (lane & 16) ? (other * sn + kr * cs) : (kr * cs - other * sn);
    }
#if EXACT
    if (lane < 32) {
      for (int h = 0; h < 16; ++h) stA(p.Kb + ((size_t)(b * 16 + h) * KVL + kpos) * 96 + 64 + lane, outv);
    }
#else
    if (lane < 32) stA(p.KR + (size_t)tok * 32 + lane, outv);
#endif
    (void)b; (void)kpos;
  }
}
__device__ __forceinline__ void ph_M2(const Params& p, int l, int bid, int nb, char* lds) {
  const int li = l >> 1;
  float* stage = (float*)lds;
  const float* wq = p.w_uq + (size_t)li * 384 * 1536;
  const float* wkv = p.w_ukv + (size_t)li * 256 * 2048;
  const float* qg = p.q_g + li * 384;
  const float* kvg = p.kv_g + li * 256;
  const int NQ = NRT * 12, NKV = NRT * 16;
  for (int item = bid; item < NQ + NKV; item += nb) {
    if (item < NQ) {
      int ct = item % 12, rt = item / 12;
      engine(lds, 384,
             [&](int r, int k) { int tok = rt * 128 + r; return ldA(p.PROJ + (size_t)tok * P1LD + k) * p.RQ[tok] * qg[k]; },
             [&](int k, int c) { return wq[(size_t)k * 1536 + ct * 128 + c]; });
      EPI_BEGIN
        int tok = rt * 128 + row, col = ct * 128 + c4, head = col / 96, d = col % 96;
        AT* dst = p.Ql + (size_t)tok * QLD + head * 96 + d;
        stA4(dst, v);
      EPI_END
    } else {
      int it = item - NQ, h = it & 15, rt = it >> 4;
      engine(lds, 256,
             [&](int r, int k) { int tok = rt * 128 + r; return ldA(p.PROJ + (size_t)tok * P1LD + 384 + k) * p.RKV[tok] * kvg[k]; },
             [&](int k, int c) { return wkv[(size_t)k * 2048 + h * 128 + c]; });
      EPI_BEGIN
        int tok = rt * 128 + row, b, kpos;
        if (tok < NCTX) { b = tok >> 8; kpos = tok & 255; } else { int tt = tok - NCTX; b = tt >> 12; kpos = CTXL + (tt & 4095); }
        if (c4 < 64) stA4(p.Kb + ((size_t)(b * 16 + h) * KVL + kpos) * 96 + c4, v);
        else stA4(p.Vb + ((size_t)(b * 16 + h) * KVL + kpos) * 64 + c4 - 64, v);
      EPI_END
    }
  }
}
__device__ __forceinline__ void ph_ATT(const Params& p, int l, int bid, int nb, char* lds) {
  float* Ks = (float*)lds;
  float* Vs = Ks + 64 * 97;
  float* Qs = Vs + 64 * 64;
  const int wave = tidx() >> 6, lane = tidx() & 63;
  const int NLAT = NBAT * 16 * 64, NCT = (l == 1) ? NBAT * 16 * 4 : 0;
  const float scale = 0.10206207261596577f;
  for (int item = bid; item < NLAT + NCT; item += nb) {
    bool lat = item < NLAT;
    int qb, bh, nkeys;
    if (lat) { qb = item & 63; bh = item >> 6; nkeys = KVL; } else { int it = item - NLAT; qb = it & 3; bh = it >> 2; nkeys = CTXL; }
    int b = bh >> 4, h = bh & 15;
    const AT* Q = p.Ql + (size_t)(lat ? NCTX + b * SEQ + qb * 64 : b * CTXL + qb * 64) * QLD + h * 96;
    __syncthreads();
    for (int e = tidx(); e < 64 * 96; e += 256) {
      int r = e / 96, d = e % 96;
      float val;
      if (lat && d >= 64) {
        int t = qb * 64 + r, i = (d - 64) & 15;
        float x1 = ldA(Q + (size_t)r * QLD + 64 + i), x2 = ldA(Q + (size_t)r * QLD + 80 + i);
        float cs = p.cs2c[t * 16 + i], sn = p.cs2s[t * 16 + i];
        val = d < 80 ? x1 * cs - x2 * sn : x1 * sn + x2 * cs;
      } else val = ldA(Q + (size_t)r * QLD + d);
      Qs[e] = val * scale;
    }
    float* Os = Qs + 64 * 96;
    float* Ms = Os + 64 * 64;
    float* Ls = Ms + 64;
    for (int e = tidx(); e < 64 * 64; e += 256) Os[e] = 0.f;
    if (tidx() < 64) { Ms[tidx()] = -3.0e38f; Ls[tidx()] = 0.f; }
    const AT* Kg = p.Kb + (size_t)bh * KVL * 96;
    const AT* Vg = p.Vb + (size_t)bh * KVL * 64;
    for (int kt = 0; kt < nkeys; kt += 64) {
      __syncthreads();
      for (int e = tidx(); e < 64 * 96; e += 256) { int r = e / 96, d = e % 96; Ks[r * 97 + d] = ldA(Kg + (size_t)(kt + r) * 96 + d); }
      for (int e = tidx(); e < 64 * 64; e += 256) Vs[e] = ldA(Vg + (size_t)kt * 64 + e);
      __syncthreads();
#pragma unroll 1
      for (int g = 0; g < 4; ++g) {
        float s0 = 0.f, s1 = 0.f, s2 = 0.f, s3 = 0.f;
        const int q0 = wave * 16 + g * 4;
        const float* qp = Qs + q0 * 96;
        for (int d = 0; d < 96; ++d) {
          float kv = Ks[lane * 97 + d];
          s0 = fmaf(qp[d], kv, s0); s1 = fmaf(qp[96 + d], kv, s1); s2 = fmaf(qp[192 + d], kv, s2); s3 = fmaf(qp[288 + d], kv, s3);
        }
        float p0, p1, p2, p3, o0, o1, o2, o3;
#define ATT_ROW(SI, PI, OI, I) { float mold = Ms[q0 + I]; float mx = wave_max(SI); float mn = fmaxf(mold, mx); float alpha = expf(mold - mn); \
          PI = expf(SI - mn); float sm = wave_sum(PI); OI = Os[(q0 + I) * 64 + lane] * alpha; if (lane == 0) { Ls[q0 + I] = Ls[q0 + I] * alpha + sm; Ms[q0 + I] = mn; } }
        ATT_ROW(s0, p0, o0, 0) ATT_ROW(s1, p1, o1, 1) ATT_ROW(s2, p2, o2, 2) ATT_ROW(s3, p3, o3, 3)
        for (int j = 0; j < 64; ++j) {
          float vv = Vs[j * 64 + lane];
          o0 = fmaf(__int_as_float(__builtin_amdgcn_readlane(__float_as_int(p0), j)), vv, o0);
          o1 = fmaf(__int_as_float(__builtin_amdgcn_readlane(__float_as_int(p1), j)), vv, o1);
          o2 = fmaf(__int_as_float(__builtin_amdgcn_readlane(__float_as_int(p2), j)), vv, o2);
          o3 = fmaf(__int_as_float(__builtin_amdgcn_readlane(__float_as_int(p3), j)), vv, o3);
        }
        Os[(q0 + 0) * 64 + lane] = o0; Os[(q0 + 1) * 64 + lane] = o1; Os[(q0 + 2) * 64 + lane] = o2; Os[(q0 + 3) * 64 + lane] = o3;
      }
    }
    __syncthreads();
    for (int qi = 0; qi < 16; ++qi) {
      int r = qb * 64 + wave * 16 + qi;
      int tok = lat ? NCTX + b * SEQ + r : b * CTXL + r;
      stA(p.MIX + (size_t)tok * 1024 + h * 64 + lane, Os[(wave * 16 + qi) * 64 + lane] / Ls[wave * 16 + qi]);
    }
  }
}


#if !EXACT
__device__ __forceinline__ void ph_T1_f(const Params& p, int l, int bid, int nb) {
  const int wave = tidx() >> 6, lane = tidx() & 63;
  const float* g = p.norm_g + (l * 2 + 0) * 1024;
  for (int pair = bid * 4 + wave; pair < NTOK / 2; pair += nb * 4) {
    float v[2][16];
    int mrs[2];
#pragma unroll
    for (int u = 0; u < 2; ++u) {
      const int tok = pair * 2 + u;
      const int mr = tok_modrow(tok); mrs[u] = mr;
      const float* src = (l == 0) ? (tok < NCTX ? p.ctx + (size_t)tok * 1024 : p.x + (size_t)(tok - NCTX) * 1024) : p.X + (size_t)tok * 1024;
#pragma unroll
      for (int i = 0; i < 4; ++i) { const fx4 t4 = *(const fx4*)(src + i * 256 + lane * 4); v[u][i * 4] = t4.x; v[u][i * 4 + 1] = t4.y; v[u][i * 4 + 2] = t4.z; v[u][i * 4 + 3] = t4.w; }
      if (l > 0) {
        const float* gm = p.mod + ((size_t)(l - 1) * 5 + mr) * 6144 + 5 * 1024;
        const AT* y0 = p.Y + (size_t)(tok * 2) * 1024;
#pragma unroll
        for (int i = 0; i < 4; ++i) {
          const int col = i * 256 + lane * 4;
          const u32x2 a = *(const u32x2*)(y0 + col), b = *(const u32x2*)(y0 + 1024 + col);
          const fx4 gg = *(const fx4*)(gm + col);
          v[u][i * 4 + 0] += gg.x * (bf_lo(a.x) + bf_lo(b.x)); v[u][i * 4 + 1] += gg.y * (bf_hi(a.x) + bf_hi(b.x));
          v[u][i * 4 + 2] += gg.z * (bf_lo(a.y) + bf_lo(b.y)); v[u][i * 4 + 3] += gg.w * (bf_hi(a.y) + bf_hi(b.y));
        }
      }
    }
#pragma unroll
    for (int u = 0; u < 2; ++u) {
      const int tok = pair * 2 + u;
      float ss = 0.f;
#pragma unroll
      for (int i = 0; i < 16; ++i) ss += v[u][i] * v[u][i];
      ss = wave_sum(ss);
      const float rstd = rsqrtf(ss * (1.f / 1024.f) + EPSF);
      const float* md = p.mod + ((size_t)l * 5 + mrs[u]) * 6144;
#pragma unroll
      for (int i = 0; i < 4; ++i) {
        const int col = i * 256 + lane * 4;
        fx4 xo = {v[u][i * 4], v[u][i * 4 + 1], v[u][i * 4 + 2], v[u][i * 4 + 3]};
        *(fx4*)(p.X + (size_t)tok * 1024 + col) = xo;
        const fx4 gg = *(const fx4*)(g + col), sc = *(const fx4*)(md + 1024 + col), sh = *(const fx4*)(md + col);
        u32x2 o;
        o.x = pk2(xo.x * rstd * gg.x * (1.f + sc.x) + sh.x, xo.y * rstd * gg.y * (1.f + sc.y) + sh.y);
        o.y = pk2(xo.z * rstd * gg.z * (1.f + sc.z) + sh.z, xo.w * rstd * gg.w * (1.f + sc.w) + sh.w);
        *(u32x2*)(p.H + (size_t)tok * 1024 + col) = o;
      }
    }
  }
}
__device__ __forceinline__ void ph_final_f(const Params& p, int bid, int nb) {
  const int wave = tidx() >> 6, lane = tidx() & 63;
  for (int pair = NCTX / 2 + bid * 4 + wave; pair < NTOK / 2; pair += nb * 4) {
    float v[2][16];
#pragma unroll
    for (int u = 0; u < 2; ++u) {
      const int tok = pair * 2 + u;
      const int mr = tok_modrow(tok);
      const float* src = p.X + (size_t)tok * 1024;
      const float* gm = p.mod + ((size_t)3 * 5 + mr) * 6144 + 5 * 1024;
      const AT* y0 = p.Y + (size_t)(tok * 2) * 1024;
#pragma unroll
      for (int i = 0; i < 4; ++i) {
        const int col = i * 256 + lane * 4;
        const fx4 t4 = *(const fx4*)(src + col);
        const u32x2 a = *(const u32x2*)(y0 + col), b = *(const u32x2*)(y0 + 1024 + col);
        const fx4 gg = *(const fx4*)(gm + col);
        v[u][i * 4 + 0] = t4.x + gg.x * (bf_lo(a.x) + bf_lo(b.x)); v[u][i * 4 + 1] = t4.y + gg.y * (bf_hi(a.x) + bf_hi(b.x));
        v[u][i * 4 + 2] = t4.z + gg.z * (bf_lo(a.y) + bf_lo(b.y)); v[u][i * 4 + 3] = t4.w + gg.w * (bf_hi(a.y) + bf_hi(b.y));
      }
    }
#pragma unroll
    for (int u = 0; u < 2; ++u) {
      const int tok = pair * 2 + u;
      float ss = 0.f;
#pragma unroll
      for (int i = 0; i < 16; ++i) ss += v[u][i] * v[u][i];
      ss = wave_sum(ss);
      const float rstd = rsqrtf(ss * (1.f / 1024.f) + EPSF);
#pragma unroll
      for (int i = 0; i < 4; ++i) {
        const int col = i * 256 + lane * 4;
        const fx4 fg = *(const fx4*)(p.final_g + col);
        fx4 o = {v[u][i * 4] * rstd * fg.x, v[u][i * 4 + 1] * rstd * fg.y, v[u][i * 4 + 2] * rstd * fg.z, v[u][i * 4 + 3] * rstd * fg.w};
        *(fx4*)(p.out + (size_t)(tok - NCTX) * 1024 + col) = o;
      }
    }
  }
}
#endif
#if !EXACT
template <int EPI>
__device__ __forceinline__ void ph_gemm_store_f(const Params& p, const AT* A, int lda, const AT* W, int K, int N, AT* O, int ldo, int bid, int nb, char* lds) {
  float* stage = (float*)lds;
  const int nct = (N + 127) / 128;
  const int nitems = NRT * nct;
  for (int item = bid; item < nitems; item += nb) {
    int ct = item % nct, rt = item / nct;
    f32x4 acc[4][4]; acc_zero(acc);
    {
      const int r0 = tidx() >> 2, co = glds_chunk_off();
      const AT* a0 = A + (size_t)(rt * 128 + r0) * lda + co;
      const int n0 = min(ct * 128 + r0, N - 1), n1 = min(ct * 128 + r0 + 64, N - 1);
      gemm_core_g(lds, K / 32, a0, a0 + (size_t)64 * lda, W + (size_t)n0 * K + co, W + (size_t)n1 * K + co, acc);
    }
    acc_to_stage(lds, acc);
    const float sc = (EPI == 1 && ct >= 4 && ct < 8) ? 0.08838834764831845f : 1.f;
    if (EPI == 1 && ct < 8 && rt >= 8) {
      EPI_BEGIN
        int tok = rt * 128 + row, t = (tok - NCTX) & 4095;
        float4 cs = *(const float4*)(p.cs1c + t * 64 + (c4 & 63)), sn = *(const float4*)(p.cs1s + t * 64 + (c4 & 63));
        float4 o = *(const float4*)(stage + row * ST_LD + (c4 ^ 64));
        float4 r;
        if (c4 < 64) { r.x = v.x * cs.x - o.x * sn.x; r.y = v.y * cs.y - o.y * sn.y; r.z = v.z * cs.z - o.z * sn.z; r.w = v.w * cs.w - o.w * sn.w; }
        else { r.x = o.x * sn.x + v.x * cs.x; r.y = o.y * sn.y + v.y * cs.y; r.z = o.z * sn.z + v.z * cs.z; r.w = o.w * sn.w + v.w * cs.w; }
        r.x *= sc; r.y *= sc; r.z *= sc; r.w *= sc;
        st4bf(O + (size_t)tok * ldo + ct * 128 + c4, r);
      EPI_END
    } else {
      EPI_BEGIN
        int col = ct * 128 + c4;
        if (col < N) st4bf(O + (size_t)(rt * 128 + row) * ldo + col, make_float4(v.x * sc, v.y * sc, v.z * sc, v.w * sc));
      EPI_END
    }
  }
}
__device__ __forceinline__ void ph_gemm_resid_f(const Params& p, int l, const AT* A, const AT* W, int rt0, int bid, int nb, char* lds) {
  float* stage = (float*)lds;
  const int nitems = (NRT - rt0) * 8;
  for (int item = bid; item < nitems; item += nb) {
    int ct = item & 7, rt = rt0 + (item >> 3);
    f32x4 acc[4][4]; acc_zero(acc);
    {
      const int r0 = tidx() >> 2, co = glds_chunk_off();
      const AT* a0 = A + (size_t)(rt * 128 + r0) * 1024 + co;
      const AT* b0 = W + (size_t)(ct * 128 + r0) * 1024 + co;
      gemm_core_g(lds, 32, a0, a0 + 64 * 1024, b0, b0 + 64 * 1024, acc);
    }
    acc_to_stage(lds, acc);
    int mr = tok_modrow(rt * 128);
    const float* gm = p.mod + ((size_t)l * 5 + mr) * 6144 + 2 * 1024 + ct * 128;
    EPI_BEGIN
      float* xp = p.X + (size_t)(rt * 128 + row) * 1024 + ct * 128 + c4;
      float4 xv = *(float4*)xp;
      float4 g4 = *(const float4*)(gm + c4);
      xv.x += g4.x * v.x; xv.y += g4.y * v.y; xv.z += g4.z * v.z; xv.w += g4.w * v.w;
      *(float4*)xp = xv;
      const float ssq = half_sum(xv.x * xv.x + xv.y * xv.y + xv.z * xv.z + xv.w * xv.w);
      if ((tidx() & 31) == 0) p.SSQ[(size_t)ct * NTOK + rt * 128 + row] = ssq;
    EPI_END
  }
}
__device__ __forceinline__ void ph_E1_f(const Params& p, int l, int bid, int nb, char* lds) {
  float* stage = (float*)lds;
  int* si = (int*)(lds + MISC_OFF);
  moe_setup(p, l, si);
  const int nblk = si[97];
  for (int item = bid; item < nblk * 8; item += nb) {
    int nt = item & 7, bi = item >> 3;
    int e = 0;
    while (e < 31 && si[65 + e + 1] <= bi) ++e;
    int rb = bi - si[65 + e], cnt = si[e], base = si[32 + e];
    const int* lst = p.list + (size_t)e * NTOK + rb * 128;
    int nrow = cnt - rb * 128; if (nrow > 128) nrow = 128;
    const float* wg = p.w_gate + ((size_t)(l * 32 + e) * 1024) * 512 + nt * 64;
    const float* wu = p.w_up + ((size_t)(l * 32 + e) * 1024) * 512 + nt * 64;
    LdRow<false> la; la.init([&](int r) { return p.H + (size_t)(r < nrow ? (__hip_atomic_load(&lst[r], __ATOMIC_RELAXED, __HIP_MEMORY_SCOPE_AGENT) >> 1) : 0) * 1024; });
    LdColF lb; lb.init(wg, 512, 128);
    { int half = tidx() & 1, n4 = (tidx() >> 1) & 31, ch = tidx() >> 6;
      lb.p = (n4 < 16 ? wg : wu) + (size_t)(ch * 8 + half * 4) * 512 + 4 * (n4 & 15); }
    f32x4 acc[4][4]; acc_zero(acc);
    gemm_core(lds, 32, la, lb, acc);
    acc_to_stage(lds, acc);
    for (int e_ = tidx(); e_ < 128 * 16; e_ += 256) {
      int row = e_ >> 4, c4 = (e_ & 15) << 2;
      if (row < nrow) {
        float4 gv = *(const float4*)(stage + row * ST_LD + c4), uv = *(const float4*)(stage + row * ST_LD + 64 + c4);
        float4 o = make_float4(silu_f(gv.x) * uv.x, silu_f(gv.y) * uv.y, silu_f(gv.z) * uv.z, silu_f(gv.w) * uv.w);
        st4bf(p.HB + (size_t)(base + rb * 128 + row) * 512 + nt * 64 + c4, o);
      }
    }
  }
}
__device__ __forceinline__ void ph_E1_g(const Params& p, int l, int bid, int nb, char* lds) {
  float* stage = (float*)lds;
  int* si = (int*)(lds + MISC_OFF);
  moe_setup(p, l, si);
  const int nblk = si[97];
  for (int item = bid; item < nblk * 8; item += nb) {
    int nt = item & 7, bi = item >> 3;
    int e = 0;
    while (e < 31 && si[65 + e + 1] <= bi) ++e;
    int rb = bi - si[65 + e], cnt = si[e], base = si[32 + e];
    const int* lst = p.list + (size_t)e * NTOK + rb * 128;
    int nrow = cnt - rb * 128; if (nrow > 128) nrow = 128;
    const AT* wgT = p.WM + WM_GATE + ((size_t)(l * 32 + e) * 512 + nt * 64) * 1024;
    const AT* wuT = p.WM + WM_UP + ((size_t)(l * 32 + e) * 512 + nt * 64) * 1024;
    AT* dst = p.HB + (size_t)(base + rb * 128) * 512 + nt * 64;
    const int r0 = tidx() >> 2, co = glds_chunk_off();
    const AT* a0 = p.H + (size_t)(r0 < nrow ? (lst[r0] >> 1) : 0) * 1024 + co;
    const AT* a1 = p.H + (size_t)(r0 + 64 < nrow ? (lst[r0 + 64] >> 1) : 0) * 1024 + co;
    f32x4 acc[4][4]; acc_zero(acc);
    gemm_core_g(lds, 32, a0, a1, wgT + (size_t)r0 * 1024 + co, wuT + (size_t)r0 * 1024 + co, acc);
    acc_to_stage(lds, acc);
    for (int e_ = tidx(); e_ < 128 * 16; e_ += 256) {
      const int row = e_ >> 4, c4 = (e_ & 15) << 2;
      if (row < nrow) {
        const float4 gv = *(const float4*)(stage + row * ST_LD + c4), uv = *(const float4*)(stage + row * ST_LD + 64 + c4);
        st4bf(dst + (size_t)row * 512 + c4, make_float4(silu_fast(gv.x) * uv.x, silu_fast(gv.y) * uv.y, silu_fast(gv.z) * uv.z, silu_fast(gv.w) * uv.w));
      }
    }
  }
}
__device__ __forceinline__ void ph_E2_f(const Params& p, int l, int bid, int nb, char* lds) {
  int* si = (int*)(lds + MISC_OFF);
  moe_setup(p, l, si);
  const int nitems = si[97] * 8;
  const int tid = tidx(), lane = tid & 63, wid = tid >> 6, wr = wid >> 1, wc = wid & 1, fr = lane & 15, fq = lane >> 4;
  int* s_a = (int*)(lds + MISC_OFF + 512);
  char* my = lds + tid * 16;
  const int r0 = tid >> 2, co = glds_chunk_off();
  int ao[4], bo[4];
#pragma unroll
  for (int t = 0; t < 4; ++t) { ao[t] = row_off(wr * 64 + t * 16 + fr, fq); bo[t] = row_off(wc * 64 + t * 16 + fr, fq); }
#define E2_DECODE(IT, CT, NROW, A0, A1, B0, B1, NA) { \
    const int ct_ = (IT) & 7, bi_ = (IT) >> 3; int e_ = 0; \
    while (e_ < 31 && si[65 + e_ + 1] <= bi_) ++e_; \
    const int rb_ = bi_ - si[65 + e_], cnt_ = si[e_], base_ = si[32 + e_]; \
    int nr_ = cnt_ - rb_ * 128; if (nr_ > 128) nr_ = 128; \
    const AT* wd_ = p.WM + WM_DOWN + ((size_t)(l * 32 + e_) * 1024 + ct_ * 128) * 512; \
    const AT* hb_ = p.HB + (size_t)(base_ + rb_ * 128) * 512; \
    CT = ct_; NROW = nr_; \
    A0 = hb_ + (size_t)(r0 < nr_ ? r0 : 0) * 512 + co; A1 = hb_ + (size_t)(r0 + 64 < nr_ ? r0 + 64 : 0) * 512 + co; \
    B0 = wd_ + (size_t)r0 * 512 + co; B1 = wd_ + (size_t)(r0 + 64) * 512 + co; \
    NA = (tid < nr_) ? p.list[(size_t)e_ * NTOK + rb_ * 128 + tid] : 0; }
  int item = bid;
  int ct = 0, nrow = 0, na = 0;
  const AT *a0 = nullptr, *a1 = nullptr, *b0 = nullptr, *b1 = nullptr;
  if (item < nitems) E2_DECODE(item, ct, nrow, a0, a1, b0, b1, na)
  bool primed = false;
  while (item < nitems) {
    __syncthreads();
    if (tid < 128) s_a[tid] = na;
    f32x4 acc[4][4]; acc_zero(acc);
    if (!primed) {
      glds16(a0, my); glds16(a1, my + 4096); glds16(b0, my + 8192); glds16(b1, my + 12288);
      glds16(a0 + 32, my + 16384); glds16(a1 + 32, my + 16384 + 4096); glds16(b0 + 32, my + 16384 + 8192); glds16(b1 + 32, my + 16384 + 12288);
    }
    for (int kt = 0; kt < 14; ++kt) {
      { const int kf = (kt + 2) * 32; char* d = my + ((kt + 2) & 3) * 16384;
        glds16(a0 + kf, d); glds16(a1 + kf, d + 4096); glds16(b0 + kf, d + 8192); glds16(b1 + kf, d + 12288); }
      asm volatile("s_waitcnt vmcnt(8)" ::: "memory");
      __builtin_amdgcn_s_barrier();
      asm volatile("" ::: "memory");
      const char* st = lds + (kt & 3) * 16384;
      mma_step(st, st + 8192, ao, bo, acc);
    }
    {
      asm volatile("s_waitcnt vmcnt(4)" ::: "memory");
      __builtin_amdgcn_s_barrier();
      asm volatile("" ::: "memory");
      const char* st = lds + 2 * 16384;
      mma_step(st, st + 8192, ao, bo, acc);
      asm volatile("s_waitcnt vmcnt(0)" ::: "memory");
      __builtin_amdgcn_s_barrier();
      asm volatile("" ::: "memory");
      st = lds + 3 * 16384;
      mma_step(st, st + 8192, ao, bo, acc);
    }
    __syncthreads();
    const int nxt = item + nb;
    int nct = 0, nnrow = 0, nna = 0;
    const AT *na0 = a0, *na1 = a1, *nb0 = b0, *nb1 = b1;
    primed = nxt < nitems;
    if (primed) {
      E2_DECODE(nxt, nct, nnrow, na0, na1, nb0, nb1, nna)
      glds16(na0, my); glds16(na1, my + 4096); glds16(nb0, my + 8192); glds16(nb1, my + 12288);
      glds16(na0 + 32, my + 16384); glds16(na1 + 32, my + 16384 + 4096); glds16(nb0 + 32, my + 16384 + 8192); glds16(nb1 + 32, my + 16384 + 12288);
    }
    {
      __hip_bfloat16* sb = (__hip_bfloat16*)(lds + 32768);
#pragma unroll
      for (int m = 0; m < 4; ++m)
#pragma unroll
        for (int n = 0; n < 4; ++n)
#pragma unroll
          for (int j = 0; j < 4; ++j) sb[(wr * 64 + m * 16 + fq * 4 + j) * 136 + wc * 64 + n * 16 + fr] = __float2bfloat16(acc[m][n][j]);
    }
    __syncthreads();
#pragma unroll
    for (int i = 0; i < 8; ++i) {
      const int e_ = tid + 256 * i, row = e_ >> 4, ch = e_ & 15;
      if (row < nrow) {
        const u32x4 raw = *(const u32x4*)(lds + 32768 + row * 272 + ch * 16);
        const int a = s_a[row];
        const float w = p.rw[a];
        *(u32x4*)(p.Y + (size_t)a * 1024 + ct * 128 + ch * 8) = scale8(raw, w);
      }
    }
    item = nxt; ct = nct; nrow = nnrow; na = nna; a0 = na0; a1 = na1; b0 = nb0; b1 = nb1;
  }
#undef E2_DECODE
}
__device__ __forceinline__ void ph_M2_f(const Params& p, int l, int bid, int nb, char* lds) {
  const int li = l >> 1;
  float* stage = (float*)lds;
  const AT* wq = p.WB + WB_UQ + (size_t)li * 384 * 1536;
  const AT* wkv = p.WB + WB_UKV + (size_t)li * 256 * 2048;
  const int NQ = NRT * 12, NKV = NRT * 16;
  for (int item = bid; item < NQ + NKV; item += nb) {
    if (item < NQ) {
      int ct = item % 12, rt = item / 12;
      f32x4 acc[4][4]; acc_zero(acc);
      {
        const int r0 = tidx() >> 2, co = glds_chunk_off();
        const AT* a0 = p.PROJ + (size_t)(rt * 128 + r0) * P1LD + co;
        const AT* b0 = wq + (size_t)(ct * 128 + r0) * 384 + co;
        gemm_core_g(lds, 12, a0, a0 + 64 * P1LD, b0, b0 + 64 * 384, acc);
      }
      acc_to_stage(lds, acc);
      EPI_BEGIN
        int tok = rt * 128 + row, col = ct * 128 + c4, head = col / 96, d = col % 96;
        const float rq = 1.f;
        AT* dst = p.Ql + (size_t)tok * QLD + head * 96 + d;
        st4bf(dst, make_float4(v.x * rq, v.y * rq, v.z * rq, v.w * rq));
      EPI_END
    } else {
      int it = item - NQ, h = it & 15, rt = it >> 4;
      f32x4 acc[4][4]; acc_zero(acc);
      {
        const int r0 = tidx() >> 2, co = glds_chunk_off();
        const AT* a0 = p.PROJ + (size_t)(rt * 128 + r0) * P1LD + 384 + co;
        const AT* b0 = wkv + (size_t)(h * 128 + r0) * 256 + co;
        gemm_core_g(lds, 8, a0, a0 + 64 * P1LD, b0, b0 + 64 * 256, acc);
      }
      acc_to_stage(lds, acc);
      EPI_BEGIN
        int tok = rt * 128 + row, b, kpos;
        const float rk = 1.f;
        if (tok < NCTX) { b = tok >> 8; kpos = tok & 255; } else { int tt = tok - NCTX; b = tt >> 12; kpos = CTXL + (tt & 4095); }
        float4 o = make_float4(v.x * rk, v.y * rk, v.z * rk, v.w * rk);
        if (c4 < 64) st4bf(p.Kb + ((size_t)(b * 16 + h) * KVL + kpos) * 96 + c4, o);
        else if (c4 < 96) *(u32x2*)(p.Kb + ((size_t)(b * 16 + h) * KVL + kpos) * 96 + c4) = *(const u32x2*)(p.KR + (size_t)tok * 32 + c4 - 64);
      EPI_END
      {
        int tok0 = rt * 128, b, kp0;
        if (tok0 < NCTX) { b = tok0 >> 8; kp0 = tok0 & 255; } else { int tt = tok0 - NCTX; b = tt >> 12; kp0 = CTXL + (tt & 4095); }
        for (int e_ = tidx(); e_ < 64 * 32; e_ += 256) {
          int dv = e_ >> 5, r4 = (e_ & 31) << 2;
          float x0 = stage[(r4 + 0) * ST_LD + 64 + dv];
          float x1 = stage[(r4 + 1) * ST_LD + 64 + dv];
          float x2 = stage[(r4 + 2) * ST_LD + 64 + dv];
          float x3 = stage[(r4 + 3) * ST_LD + 64 + dv];
          st4bf(p.Vt + ((size_t)(b * 16 + h) * 64 + dv) * KVL + kp0 + r4, make_float4(x0, x1, x2, x3));
        }
      }
    }
  }
}

__device__ __forceinline__ void ph_T2_f(const Params& p, int l, int bid, int nb, char* lds) {
  const int tid = tidx(), lane = tid & 63, wid = tid >> 6, fr = lane & 15, fq = lane >> 4;
  float* rs = (float*)lds + wid * 16;
  const float* g = p.norm_g + (l * 2 + 1) * 1024;
  const unsigned short* Whi = p.WR + (size_t)(l * 2 + 0) * 128 * 48 * 8;
  const unsigned short* Wlo = p.WR + (size_t)(l * 2 + 1) * 128 * 48 * 8;
  const int ibeg = (l == 3) ? NCTX / 16 : 0;
  const int nitem = NTOK / 16;
  for (int item0 = ibeg + bid * 2; item0 < nitem; item0 += nb * 2) {
    const int item = min(item0 + (wid >> 1), nitem - 1);
    const bool live = item0 + (wid >> 1) < nitem;
    const int kh = wid & 1;
    const int tok0 = item * 16;
    const int mr = tok_modrow(tok0);
    const float* md = p.mod + ((size_t)l * 5 + mr) * 6144;
    float rstd;
    {
      float ss = 0.f;
#pragma unroll
      for (int ct = 0; ct < 8; ++ct) ss += p.SSQ[(size_t)ct * NTOK + tok0 + fr];
      rstd = rsqrtf(ss * (1.f / 1024.f) + EPSF);
    }
    const float* xr = p.X + (size_t)(tok0 + fr) * 1024 + fq * 8 + kh * 512;
    AT* hr = p.H + (size_t)(tok0 + fr) * 1024 + fq * 8 + kh * 512;
    f32x4 acc[3];
    acc[0] = (f32x4){0.f, 0.f, 0.f, 0.f}; acc[1] = acc[0]; acc[2] = acc[0];
    fx4 xa = *(const fx4*)(xr), xb = *(const fx4*)(xr + 4);
    const size_t wo0 = ((size_t)(kh * 64 + fq) * 48 + fr) * 8;
    bf16x8 wh0 = *(const bf16x8*)(Whi + wo0), wh1 = *(const bf16x8*)(Whi + wo0 + 128), wh2 = *(const bf16x8*)(Whi + wo0 + 256);
    bf16x8 wl0 = *(const bf16x8*)(Wlo + wo0), wl1 = *(const bf16x8*)(Wlo + wo0 + 128), wl2 = *(const bf16x8*)(Wlo + wo0 + 256);
#pragma unroll 2
    for (int s = 0; s < 16; ++s) {
      const int k0 = kh * 512 + s * 32 + fq * 8;
      const int sn = min(s + 1, 15);
      const fx4 xan = *(const fx4*)(xr + sn * 32), xbn = *(const fx4*)(xr + sn * 32 + 4);
      const size_t won = wo0 + (size_t)sn * 4 * 48 * 8;
      const bf16x8 wh0n = *(const bf16x8*)(Whi + won), wh1n = *(const bf16x8*)(Whi + won + 128), wh2n = *(const bf16x8*)(Whi + won + 256);
      const bf16x8 wl0n = *(const bf16x8*)(Wlo + won), wl1n = *(const bf16x8*)(Wlo + won + 128), wl2n = *(const bf16x8*)(Wlo + won + 256);
      const fx4 g0 = *(const fx4*)(g + k0), g1 = *(const fx4*)(g + k0 + 4);
      const fx4 c0 = *(const fx4*)(md + 4 * 1024 + k0), c1 = *(const fx4*)(md + 4 * 1024 + k0 + 4);
      const fx4 s0 = *(const fx4*)(md + 3 * 1024 + k0), s1 = *(const fx4*)(md + 3 * 1024 + k0 + 4);
      float h[8];
      h[0] = xa.x * rstd * g0.x * (1.f + c0.x) + s0.x; h[1] = xa.y * rstd * g0.y * (1.f + c0.y) + s0.y;
      h[2] = xa.z * rstd * g0.z * (1.f + c0.z) + s0.z; h[3] = xa.w * rstd * g0.w * (1.f + c0.w) + s0.w;
      h[4] = xb.x * rstd * g1.x * (1.f + c1.x) + s1.x; h[5] = xb.y * rstd * g1.y * (1.f + c1.y) + s1.y;
      h[6] = xb.z * rstd * g1.z * (1.f + c1.z) + s1.z; h[7] = xb.w * rstd * g1.w * (1.f + c1.w) + s1.w;
      u32x4 hi;
      hi.x = pk2(h[0], h[1]); hi.y = pk2(h[2], h[3]); hi.z = pk2(h[4], h[5]); hi.w = pk2(h[6], h[7]);
      if (live) *(u32x4*)(hr + s * 32) = hi;
      u32x4 lo;
      lo.x = pk2(h[0] - bf_lo(hi.x), h[1] - bf_hi(hi.x)); lo.y = pk2(h[2] - bf_lo(hi.y), h[3] - bf_hi(hi.y));
      lo.z = pk2(h[4] - bf_lo(hi.z), h[5] - bf_hi(hi.z)); lo.w = pk2(h[6] - bf_lo(hi.w), h[7] - bf_hi(hi.w));
      const bf16x8 ahi = *(bf16x8*)&hi, alo = *(bf16x8*)&lo;
      acc[0] = __builtin_amdgcn_mfma_f32_16x16x32_bf16(ahi, wh0, acc[0], 0, 0, 0);
      acc[0] = __builtin_amdgcn_mfma_f32_16x16x32_bf16(alo, wh0, acc[0], 0, 0, 0);
      acc[0] = __builtin_amdgcn_mfma_f32_16x16x32_bf16(ahi, wl0, acc[0], 0, 0, 0);
      acc[1] = __builtin_amdgcn_mfma_f32_16x16x32_bf16(ahi, wh1, acc[1], 0, 0, 0);
      acc[1] = __builtin_amdgcn_mfma_f32_16x16x32_bf16(alo, wh1, acc[1], 0, 0, 0);
      acc[1] = __builtin_amdgcn_mfma_f32_16x16x32_bf16(ahi, wl1, acc[1], 0, 0, 0);
      acc[2] = __builtin_amdgcn_mfma_f32_16x16x32_bf16(ahi, wh2, acc[2], 0, 0, 0);
      acc[2] = __builtin_amdgcn_mfma_f32_16x16x32_bf16(alo, wh2, acc[2], 0, 0, 0);
      acc[2] = __builtin_amdgcn_mfma_f32_16x16x32_bf16(ahi, wl2, acc[2], 0, 0, 0);
      xa = xan; xb = xbn; wh0 = wh0n; wh1 = wh1n; wh2 = wh2n; wl0 = wl0n; wl1 = wl1n; wl2 = wl2n;
    }
    float* lgp = (float*)(lds + 256) + (wid >> 1) * 16 * 48;
    __syncthreads();
    if (kh == 1) {
#pragma unroll
      for (int t = 0; t < 3; ++t)
#pragma unroll
        for (int j = 0; j < 4; ++j) lgp[(4 * fq + j) * 48 + t * 16 + fr] = acc[t][j];
    }
    __syncthreads();
    if (kh == 0) {
#pragma unroll
      for (int t = 0; t < 3; ++t)
#pragma unroll
        for (int j = 0; j < 4; ++j) lgp[(4 * fq + j) * 48 + t * 16 + fr] += acc[t][j];
    }
    float* lg = lgp;
    if (kh == 0 && live && lane < 16) {
      const float* my = lg + lane * 48;
      const int tok = tok0 + lane;
      const float* gb = p.grp_b + l * 4;
      int gs = 0; float gm = my[0] + gb[0];
      for (int j = 1; j < 4; ++j) { float t = my[j] + gb[j]; if (t > gm) { gm = t; gs = j; } }
      float gsum = 0.f;
      for (int j = 0; j < 4; ++j) gsum += expf(my[j] + gb[j] - gm);
      float gtop = 1.f / gsum;
      const float* wlp = my + 4 + gs * 8;
      const float* eb = p.exp_b + l * 32 + gs * 8;
      int i0 = 0; float m0 = wlp[0] + eb[0];
      for (int j = 1; j < 8; ++j) { float t = wlp[j] + eb[j]; if (t > m0) { m0 = t; i0 = j; } }
      int i1 = -1; float m1 = -3.4e38f;
      for (int j = 0; j < 8; ++j) { float t = wlp[j] + eb[j]; if (j != i0 && t > m1) { m1 = t; i1 = j; } }
      float e1 = expf(m1 - m0);
      float p0 = 1.f / (1.f + e1), p1 = e1 / (1.f + e1);
      p.re[tok * 2] = gs * 8 + i0; p.re[tok * 2 + 1] = gs * 8 + i1;
      p.rw[tok * 2] = gtop * p0; p.rw[tok * 2 + 1] = gtop * p1;
    }
  }
}

constexpr int NSEG = 272;
template <class LB>
__device__ __forceinline__ void gemm_core_Alds(char* lds, const char* abuf, int nk, LB& lb, f32x4 (&acc)[4][4]) {
  const int lane = tidx() & 63, wid = tidx() >> 6, wr = wid >> 1, wc = wid & 1, fr = lane & 15, fq = lane >> 4;
  int ao[4], bo[4];
#pragma unroll
  for (int t = 0; t < 4; ++t) { ao[t] = frag_off<false>(wr * 64, t, fr, fq); bo[t] = frag_off<LB::COL>(wc * 64, t, fr, fq); }
  lb.template fetch<0>(0); lb.template fetch<1>(1);
  __syncthreads();
  lb.template commit<0>(lds + FBUF_B0, 0); lb.template commit<1>(lds + FBUF_B0 + 8192, 1);
  __syncthreads();
  for (int kt = 0; kt < nk; kt += 2) {
    const int cur = (kt & 2) << 13;
    const bool more = kt + 2 < nk;
    if (more) { const int k0 = kt + 2; lb.template fetch<0>(k0); lb.template fetch<1>(k0 + 1); }
    mma_step(abuf + kt * 8192, lds + FBUF_B0 + cur, ao, bo, acc);
    mma_step(abuf + (kt + 1) * 8192, lds + FBUF_B0 + cur + 8192, ao, bo, acc);
    if (more) { const int nxt = cur ^ 16384; lb.template commit<0>(lds + FBUF_B0 + nxt, kt + 2); lb.template commit<1>(lds + FBUF_B0 + nxt + 8192, kt + 3); }
    __syncthreads();
  }
}
constexpr float LOG2E = 1.4426950408889634f;

template <bool FIN>
__device__ __forceinline__ void lru_local_f(const Params& p, int li, int b, int c, int kb, char* lds) {
  const int tid = tidx(), lane = tid & 63, wid = tid >> 6, fr = lane & 15, fq = lane >> 4;
  char* Ub = lds;
  char* Wb = lds + 16384;
  const int tok0 = chunk_tok0(b, c);
  const int seqbase = c < 2 ? b * CTXL : NCTX + b * SEQ;
  const int n = c < 2 ? CTXL : SEQ;
  const int t0 = tok0 - seqbase;
  __syncthreads();
#pragma unroll
  for (int i = 0; i < 4; ++i) {
    const int e = tid + 256 * i, pos = e >> 3, c8 = e & 7, ch0 = kb * 64 + c8 * 8, t = t0 + pos;
    float a[8];
    { fx4 b0 = *(const fx4*)(p.conv_b + li * 512 + ch0), b1 = *(const fx4*)(p.conv_b + li * 512 + ch0 + 4);
      a[0] = b0.x; a[1] = b0.y; a[2] = b0.z; a[3] = b0.w; a[4] = b1.x; a[5] = b1.y; a[6] = b1.z; a[7] = b1.w; }
#pragma unroll
    for (int tap = 0; tap < 4; ++tap) {
      const int tt = t + tap - 2;
      if (tt >= 0 && tt < n) {
        const u32x4 x = *(const u32x4*)(p.PROJ + (size_t)(seqbase + tt) * 3072 + 2048 + ch0);
        const float* w = p.conv_w + (li * 4 + tap) * 512 + ch0;
        const fx4 w0 = *(const fx4*)w, w1 = *(const fx4*)(w + 4);
        a[0] = fmaf(w0.x, bf_lo(x.x), a[0]); a[1] = fmaf(w0.y, bf_hi(x.x), a[1]); a[2] = fmaf(w0.z, bf_lo(x.y), a[2]); a[3] = fmaf(w0.w, bf_hi(x.y), a[3]);
        a[4] = fmaf(w1.x, bf_lo(x.z), a[4]); a[5] = fmaf(w1.y, bf_hi(x.z), a[5]); a[6] = fmaf(w1.z, bf_lo(x.w), a[6]); a[7] = fmaf(w1.w, bf_hi(x.w), a[7]);
      }
    }
    u32x4 o; o.x = pk2(a[0], a[1]); o.y = pk2(a[2], a[3]); o.z = pk2(a[4], a[5]); o.w = pk2(a[6], a[7]);
    *(u32x4*)(Ub + (c8 >> 2) * 8192 + row_off(pos, c8 & 3)) = o;
  }
  {
    const int half = tid & 1, n4 = (tid >> 1) & 31, ch = tid >> 6;
#pragma unroll
    for (int kt = 0; kt < 2; ++kt)
#pragma unroll
      for (int nh = 0; nh < 2; ++nh) {
        const int ncol = nh * 128 + 4 * n4, dg = ncol >> 6, j = ncol & 63, d = dg >> 1, g = dg & 1;
        const float* src = p.gate_w + ((size_t)(((li * 2 + d) * 2 + g) * 8 + kb) * 64 + (kt * 32 + ch * 8 + half * 4)) * 64 + j;
        const fx4 w0 = *(const fx4*)src, w1 = *(const fx4*)(src + 64), w2 = *(const fx4*)(src + 128), w3 = *(const fx4*)(src + 192);
        char* base = Wb + kt * 16384 + (ch * 256 + nh * 128) * 16 + half * 8;
        const int pe = col_perm(4 * n4) * 16;
        u32x2 tv;
        tv.x = pk2(w0.x, w1.x); tv.y = pk2(w2.x, w3.x); *(u32x2*)(base + pe) = tv;
        tv.x = pk2(w0.y, w1.y); tv.y = pk2(w2.y, w3.y); *(u32x2*)(base + (pe ^ 64) + 256) = tv;
        tv.x = pk2(w0.z, w1.z); tv.y = pk2(w2.z, w3.z); *(u32x2*)(base + pe + 128) = tv;
        tv.x = pk2(w0.w, w1.w); tv.y = pk2(w2.w, w3.w); *(u32x2*)(base + (pe ^ 64) + 384) = tv;
      }
  }
  __syncthreads();
  const int sbase = (c < 2 ? c * 8 : 16 + (c - 2) * 8) + wid * 2;
  __hip_bfloat16* ot = (__hip_bfloat16*)(lds + 49152);
#pragma unroll 1
  for (int d = 0; d < 2; ++d) {
    f32x4 acc[2][8];
#pragma unroll
    for (int m = 0; m < 2; ++m)
#pragma unroll
      for (int nn = 0; nn < 8; ++nn) acc[m][nn] = (f32x4){0.f, 0.f, 0.f, 0.f};
#pragma unroll
    for (int kt = 0; kt < 2; ++kt) {
      bf16x8 af0 = *(const bf16x8*)(Ub + kt * 8192 + row_off(wid * 32 + fr, fq));
      bf16x8 af1 = *(const bf16x8*)(Ub + kt * 8192 + row_off(wid * 32 + 16 + fr, fq));
#pragma unroll
      for (int nn = 0; nn < 8; ++nn) {
        bf16x8 bfv = *(const bf16x8*)(Wb + kt * 16384 + (fq * 256 + d * 128 + col_perm(nn * 16 + fr)) * 16);
        acc[0][nn] = __builtin_amdgcn_mfma_f32_16x16x32_bf16(af0, bfv, acc[0][nn], 0, 0, 0);
        acc[1][nn] = __builtin_amdgcn_mfma_f32_16x16x32_bf16(af1, bfv, acc[1][nn], 0, 0, 0);
      }
    }
#pragma unroll
    for (int q4 = 0; q4 < 4; ++q4) {
      const int chl = q4 * 16 + fr, ch = kb * 64 + chl;
      const float sp = softplus_f(-p.lam[(li * 2 + d) * 512 + ch]);
      const float br = p.gate_b[((li * 2 + d) * 2 + 0) * 512 + ch], bi = p.gate_b[((li * 2 + d) * 2 + 1) * 512 + ch];
#pragma unroll
      for (int mt = 0; mt < 2; ++mt) {
        float hv[4], Av[4], av[4], bv[4];
        float h = 0.f, A = 1.f;
#pragma unroll
        for (int s4 = 0; s4 < 4; ++s4) {
          const int jj = d ? 3 - s4 : s4;
          const int pos = wid * 32 + mt * 16 + fq * 4 + jj;
          const float r = __builtin_amdgcn_rcpf(1.f + __builtin_amdgcn_exp2f(-LOG2E * ((d ? acc[mt][q4][3 - s4] : acc[mt][q4][s4]) + br)));
          const float ig = __builtin_amdgcn_rcpf(1.f + __builtin_amdgcn_exp2f(-LOG2E * ((d ? acc[mt][4 + q4][3 - s4] : acc[mt][4 + q4][s4]) + bi)));
          const float uval = __bfloat162float(*(const __hip_bfloat16*)(Ub + (chl >> 5) * 8192 + row_off(pos, (chl & 31) >> 3) + (chl & 7) * 2));
          const float a = __builtin_amdgcn_exp2f(-8.f * LOG2E * r * sp);
          const float bt = __builtin_amdgcn_sqrtf(fmaxf(1.f - a * a, 0.f)) * (ig * uval);
          h = fmaf(a, h, bt); A *= a;
          if (d) { hv[3 - s4] = h; Av[3 - s4] = A; av[3 - s4] = a; bv[3 - s4] = bt; } else { hv[s4] = h; Av[s4] = A; av[s4] = a; bv[s4] = bt; }
        }
        float Ai = A, Hi = h;
#pragma unroll
        for (int st = 16; st <= 32; st <<= 1) {
          float Ao = d ? __shfl_down(Ai, st) : __shfl_up(Ai, st);
          float Ho = d ? __shfl_down(Hi, st) : __shfl_up(Hi, st);
          const bool has = d ? (fq + (st >> 4) <= 3) : (fq >= (st >> 4));
          if (has) { Hi = fmaf(Ai, Ho, Hi); Ai = Ai * Ao; }
        }
        float Ae = d ? __shfl_down(Ai, 16) : __shfl_up(Ai, 16);
        float He = d ? __shfl_down(Hi, 16) : __shfl_up(Hi, 16);
        const bool first = d ? (fq == 3) : (fq == 0);
        if (first) { Ae = 1.f; He = 0.f; }
        if (!FIN) {
          const bool last = d ? (fq == 0) : (fq == 3);
          if (last) {
            const size_t so = ((size_t)(d * 4 + b) * NSEG + sbase + mt) * 512 + ch;
            p.CHA[so] = Ai; p.CHH[so] = Hi;
          }
        } else {
          const float cin = p.CAR[((size_t)(d * 4 + b) * NSEG + sbase + mt) * 512 + ch];
          float hst = fmaf(Ae, cin, He);
#pragma unroll
          for (int s4 = 0; s4 < 4; ++s4) {
            hst = d ? fmaf(av[3 - s4], hst, bv[3 - s4]) : fmaf(av[s4], hst, bv[s4]);
            const int jj = d ? 3 - s4 : s4;
            const int pos = wid * 32 + mt * 16 + fq * 4 + jj;
            if (d == 0) ot[pos * 64 + chl] = __float2bfloat16(hst);
            else ot[pos * 64 + chl] = __float2bfloat16(__bfloat162float(ot[pos * 64 + chl]) + hst);
          }
        }
        (void)hv; (void)Av;
        __builtin_amdgcn_sched_barrier(0);
      }
    }
  }
  if (FIN) {
    __syncthreads();
    {
      const int row = tid >> 1, half = tid & 1;
      const u32x4* srcv = (const u32x4*)(ot + row * 64 + half * 32);
      const u32x4* yv = (const u32x4*)(p.PROJ + (size_t)(tok0 + row) * 3072 + 2560 + kb * 64 + half * 32);
      u32x4* dstv = (u32x4*)(p.MIX + (size_t)(tok0 + row) * 1024 + 512 + kb * 64 + half * 32);
#pragma unroll
      for (int q = 0; q < 4; ++q) {
        const u32x4 hh = srcv[q], yy = yv[q];
        u32x4 o;
        o.x = pk2(bf_lo(hh.x) * gelu_tanh_fast(bf_lo(yy.x)), bf_hi(hh.x) * gelu_tanh_fast(bf_hi(yy.x)));
        o.y = pk2(bf_lo(hh.y) * gelu_tanh_fast(bf_lo(yy.y)), bf_hi(hh.y) * gelu_tanh_fast(bf_hi(yy.y)));
        o.z = pk2(bf_lo(hh.z) * gelu_tanh_fast(bf_lo(yy.z)), bf_hi(hh.z) * gelu_tanh_fast(bf_hi(yy.z)));
        o.w = pk2(bf_lo(hh.w) * gelu_tanh_fast(bf_lo(yy.w)), bf_hi(hh.w) * gelu_tanh_fast(bf_hi(yy.w)));
        dstv[q] = o;
      }
    }
  }
}

__device__ __forceinline__ void ph_R1_f(const Params& p, int l, int bid, int nb, char* lds) {
  const int li = l >> 1;
  float* stage = (float*)lds;
  const int NRET = NBAT * 4 * NCH;
  const int NLRU = NBAT * NCH * 8;
  for (int item = bid; item < NRET + NLRU; item += nb) {
    if (item < NRET) {
      int c = item % NCH, bh = item / NCH, h = bh & 3, b = bh >> 2;
      const AT* base = p.PROJ + (size_t)chunk_tok0(b, c) * 3072 + h * 128;
#pragma unroll
      for (int d = 0; d < 2; ++d) {
        const float lg2 = -softplus_f(-p.ret_decay[(li * 2 + d) * 4 + h]) * LOG2E;
        f32x4 acc[4][4]; acc_zero(acc);
        LdColH<0> la; la.init(base + 1024, 3072, 0.f);
        if (d == 0) { LdColH<1> lb; lb.init(base + 512, 3072, lg2); gemm_core<LdColH<0>, LdColH<1>, 0, false>(lds, 4, la, lb, acc); }
        else        { LdColH<2> lb; lb.init(base + 512, 3072, lg2); gemm_core<LdColH<0>, LdColH<2>, 0, false>(lds, 4, la, lb, acc); }
        acc_to_stage(lds, acc);
        float* U = p.U + ((size_t)((b * 4 + h) * 2 + d) * NCH + c) * 16384;
        EPI_BEGIN
          *(float4*)(U + row * 128 + c4) = v;
        EPI_END
      }
    } else {
      int it = item - NRET;
      int kb = it & 7, c = (it >> 3) % NCH, b = it / (8 * NCH);
      lru_local_f<false>(p, li, b, c, kb, lds);
    }
  }
}
__device__ __forceinline__ void ph_R2_f(const Params& p, int l, int bid, int nb) {
  const int li = l >> 1;
  const bool lru_blk = bid >= nb - 16;
  int gtid = (lru_blk ? bid - (nb - 16) : bid) * 256 + tidx(), gsz = (lru_blk ? 16 : nb - 16) * 256;
  if (lru_blk)
  for (int i = gtid; i < 2 * 4 * 512; i += gsz) {
    int ch = i & 511, db = i >> 9, d = db >> 2;
    float carry = 0.f;
    const size_t base = (size_t)db * NSEG * 512 + ch;
#pragma unroll 16
    for (int idx = 0; idx < NSEG; ++idx) {
      int sg = d == 0 ? idx : (idx < 16 ? 15 - idx : NSEG + 15 - idx);
      size_t o = base + (size_t)sg * 512;
      p.CAR[o] = carry;
      carry = fmaf(p.CHA[o], carry, p.CHH[o]);
    }
  }
  if (!lru_blk)
  for (int i = gtid; i < 32 * 16384; i += gsz) {
    int el = i & 16383, bhd = i >> 14, d = bhd & 1, h = (bhd >> 1) & 3;
    float lg = -softplus_f(-p.ret_decay[(li * 2 + d) * 4 + h]);
    float dec = expf(lg * 128.f);
    const float* base = p.U + (size_t)bhd * NCH * 16384 + el;
    AT* sb = p.SB + (size_t)bhd * NCH * 16384 + el;
    float S = 0.f;
#pragma unroll 17
    for (int idx = 0; idx < NCH; ++idx) {
      int c = d == 0 ? idx : (idx < 2 ? 1 - idx : 35 - idx);
      float u = base[(size_t)c * 16384];
      sb[(size_t)c * 16384] = __float2bfloat16(S);
      S = fmaf(dec, S, u);
    }
  }
}
__device__ __forceinline__ void ph_R3_f(const Params& p, int l, int bid, int nb, char* lds) {
  const int li = l >> 1;
  float* stage = (float*)lds;
  const int lane = tidx() & 63, wid = tidx() >> 6, wr = wid >> 1, wc = wid & 1, fr = lane & 15, fq = lane >> 4;
  const int NRET = NBAT * 4 * NCH;
  char* Pb = lds;
  for (int item = bid; item < NRET + NBAT * NCH * 8; item += nb) {
    if (item < NRET) {
      int c = item % NCH, bh = item / NCH, h = bh & 3, b = bh >> 2;
      const int tok0 = chunk_tok0(b, c);
      const AT* base = p.PROJ + (size_t)tok0 * 3072 + h * 128;
      const float l0 = -softplus_f(-p.ret_decay[(li * 2 + 0) * 4 + h]) * LOG2E;
      const float l1 = -softplus_f(-p.ret_decay[(li * 2 + 1) * 4 + h]) * LOG2E;
      f32x4 acc[4][4]; acc_zero(acc);
      const int r0 = tidx() >> 2, co = glds_chunk_off();
      {
        const AT* k0 = base + 512 + (size_t)r0 * 3072 + co;
        const AT* q0 = base + (size_t)r0 * 3072 + co;
        gemm_core_g(lds, 4, k0, k0 + (size_t)64 * 3072, q0, q0 + (size_t)64 * 3072, acc);
      }
      float l0o = l0, l1o = l1;
      asm volatile("" : "+v"(l0o), "+v"(l1o));
#pragma unroll
      for (int mt = 0; mt < 4; ++mt)
#pragma unroll
        for (int nt = 0; nt < 4; ++nt) {
          const int m0 = wr * 64 + mt * 16 + fq * 4, j = wc * 64 + nt * 16 + fr;
          float pv[4];
#pragma unroll
          for (int q = 0; q < 4; ++q) {
            const int m = m0 + q;
            const int dd = j - m; const float ee = __builtin_amdgcn_exp2f((dd > 0 ? l0o : l1o) * (float)(dd > 0 ? dd : -dd)); const float M = dd == 0 ? 2.f : ee;
            pv[q] = acc[mt][nt][q] * M;
          }
          u32x2 o; o.x = pk2(pv[0], pv[1]); o.y = pk2(pv[2], pv[3]);
          *(u32x2*)(Pb + (m0 >> 5) * 8192 + row_off(j, (m0 & 31) >> 3) + (m0 & 7) * 2) = o;
        }
      acc_zero(acc);
      { LdColH<0> lb; lb.init(base + 1024, 3072, 0.f); gemm_core_Alds(lds, Pb, 4, lb, acc); }
#pragma unroll 1
      for (int d = 0; d < 2; ++d) {
        const float lx = d ? l1 : l0;
#pragma unroll
        for (int i = 0; i < 8; ++i) {
          const int idx = tidx() + 256 * i, row = idx >> 4, c16 = idx & 15;
          const u32x4 qv = *(const u32x4*)(base + (size_t)row * 3072 + c16 * 8);
          const float xi = __builtin_amdgcn_exp2f(lx * (float)(d ? 128 - row : row + 1));
          *(u32x4*)(Pb + (c16 >> 2) * 8192 + row_off(row, c16 & 3)) = scale8(qv, xi);
        }
        const AT* sb = p.SB + ((size_t)((b * 4 + h) * 2 + d) * NCH + c) * 16384;
        LdRow<false> lb; lb.init([&](int r) { return sb + (size_t)r * 128; });
        gemm_core_Alds(lds, Pb, 4, lb, acc);
      }
      acc_to_stage(lds, acc);
      EPI_BEGIN
        float ss = v.x * v.x + v.y * v.y + v.z * v.z + v.w * v.w;
        ss = half_sum(ss);
        float rs = rsqrtf(ss * (1.f / 128.f) + EPSF);
        int tok = tok0 + row;
        const u32x2 gg = *(const u32x2*)(p.PROJ + (size_t)tok * 3072 + 1536 + h * 128 + c4);
        float4 o = make_float4(v.x * rs * silu_fast(bf_lo(gg.x)), v.y * rs * silu_fast(bf_hi(gg.x)), v.z * rs * silu_fast(bf_lo(gg.y)), v.w * rs * silu_fast(bf_hi(gg.y)));
        st4bf(p.MIX + (size_t)tok * 1024 + h * 128 + c4, o);
      EPI_END
    } else {
      int it = item - NRET;
      int kb = it & 7, c = (it >> 3) % NCH, b = it / (8 * NCH);
      lru_local_f<true>(p, li, b, c, kb, lds);
    }
  }
}

constexpr int KROW = 240;
constexpr int VROW = 144;
constexpr int KT_BYTES = 64 * KROW;
constexpr int VT_BYTES = 64 * VROW;
__device__ __forceinline__ void ph_ATT_f(const Params& p, int l, int bid, int nb, char* lds) {
  const int tid = tidx(), lane = tid & 63, wid = tid >> 6, fr = lane & 15, fq = lane >> 4;
  char* Kl = lds;
  char* Vl = lds + 2 * KT_BYTES;
  int ko0, ko1, ko2, vo0, vo1, vg0, vg1;
  { int e = tid;       ko0 = (e / 12) * KROW + (e % 12) * 16; vo0 = (e >> 3) * VROW + (e & 7) * 16; vg0 = (e >> 3) * KVL + (e & 7) * 8;
    e = tid + 256;     ko1 = (e / 12) * KROW + (e % 12) * 16; vo1 = (e >> 3) * VROW + (e & 7) * 16; vg1 = (e >> 3) * KVL + (e & 7) * 8;
    e = tid + 512;     ko2 = (e / 12) * KROW + (e % 12) * 16; }
  const float qscale = 0.10206207261596577f * 1.4426950408889634f;
  const int NLAT = NBAT * 16 * 32, NCT = (l == 1) ? NBAT * 16 * 2 : 0;
  for (int item = bid; item < NLAT + NCT; item += nb) {
    const bool lat = item < NLAT;
    int qb, bh, ntile;
    if (lat) { qb = item & 31; bh = item >> 5; ntile = KVL / 64; } else { int it = item - NLAT; qb = it & 1; bh = it >> 1; ntile = CTXL / 64; }
    const int b = bh >> 4, h = bh & 15;
    const int q0 = qb * 128 + wid * 32;
    const AT* Qbase = p.Ql + (size_t)(lat ? NCTX + b * SEQ + q0 : b * CTXL + q0) * QLD + h * 96;
    bf16x8 qf[2][3];
#pragma unroll
    for (int qt = 0; qt < 2; ++qt)
#pragma unroll
      for (int s = 0; s < 3; ++s) {
        u32x4 raw = *(const u32x4*)(Qbase + (size_t)(qt * 16 + fr) * QLD + s * 32 + fq * 8);
        float f[8] = {bf_lo(raw.x), bf_hi(raw.x), bf_lo(raw.y), bf_hi(raw.y), bf_lo(raw.z), bf_hi(raw.z), bf_lo(raw.w), bf_hi(raw.w)};
        if (s == 2) {
          u32x4 oth;
          oth.x = __shfl_xor(raw.x, 32); oth.y = __shfl_xor(raw.y, 32); oth.z = __shfl_xor(raw.z, 32); oth.w = __shfl_xor(raw.w, 32);
          if (lat) {
            float g[8] = {bf_lo(oth.x), bf_hi(oth.x), bf_lo(oth.y), bf_hi(oth.y), bf_lo(oth.z), bf_hi(oth.z), bf_lo(oth.w), bf_hi(oth.w)};
            int fro = lane;
            asm volatile("" : "+v"(fro));
            const int t = (q0 + qt * 16 + (fro & 15)) * 16 + 8 * ((fro >> 4) & 1);
            const float* cp = p.cs2c + t;
            const float* sp = p.cs2s + t;
#pragma unroll
            for (int j = 0; j < 8; ++j) {
              float cs = cp[j], sn = sp[j];
              f[j] = (fq < 2) ? (f[j] * cs - g[j] * sn) : (g[j] * sn + f[j] * cs);
            }
          }
        }
        u32x4 o;
        o.x = pk2(f[0] * qscale, f[1] * qscale); o.y = pk2(f[2] * qscale, f[3] * qscale);
        o.z = pk2(f[4] * qscale, f[5] * qscale); o.w = pk2(f[6] * qscale, f[7] * qscale);
        qf[qt][s] = *(bf16x8*)&o;
      }
    float mrun[2] = {0.f, 0.f};
    f32x4 al[2] = {(f32x4){0.f, 0.f, 0.f, 0.f}, (f32x4){0.f, 0.f, 0.f, 0.f}};
    f32x4 ao[4][2];
#pragma unroll
    for (int dt = 0; dt < 4; ++dt) { ao[dt][0] = (f32x4){0.f, 0.f, 0.f, 0.f}; ao[dt][1] = (f32x4){0.f, 0.f, 0.f, 0.f}; }
    const char* Kg = (const char*)(p.Kb + (size_t)bh * KVL * 96);
    const AT* Vg = p.Vt + (size_t)bh * 64 * KVL;
    u32x4 kr0, kr1, kr2, vr0, vr1;
    kr0 = *(const u32x4*)(Kg + tid * 16); kr1 = *(const u32x4*)(Kg + (tid + 256) * 16); kr2 = *(const u32x4*)(Kg + (tid + 512) * 16);
    vr0 = *(const u32x4*)(Vg + vg0); vr1 = *(const u32x4*)(Vg + vg1);
    __syncthreads();
    *(u32x4*)(Kl + ko0) = kr0; *(u32x4*)(Kl + ko1) = kr1; *(u32x4*)(Kl + ko2) = kr2;
    *(u32x4*)(Vl + vo0) = vr0; *(u32x4*)(Vl + vo1) = vr1;
    __syncthreads();
    {
      const int t1 = min(1, ntile - 1);
      const char* kg = Kg + (size_t)t1 * 12288;
      kr0 = *(const u32x4*)(kg + tid * 16); kr1 = *(const u32x4*)(kg + (tid + 256) * 16); kr2 = *(const u32x4*)(kg + (tid + 512) * 16);
      vr0 = *(const u32x4*)(Vg + vg0 + t1 * 64); vr1 = *(const u32x4*)(Vg + vg1 + t1 * 64);
    }
    bf16x8 kf[2][4];
    {
      const char* kb = Kl + fr * KROW + fq * 16;
#pragma unroll
      for (int s = 0; s < 2; ++s)
#pragma unroll
        for (int k4 = 0; k4 < 4; ++k4) kf[s][k4] = *(const bf16x8*)(kb + k4 * 16 * KROW + s * 64);
    }
    auto tile_iter = [&](const int t, u32x4& xk0, u32x4& xk1, u32x4& xk2, u32x4& xv0, u32x4& xv1) __attribute__((always_inline)) {
      const int cur = t & 1;
      f32x4 as[4][2];
      {
        const f32x4 n0 = {-mrun[0], -mrun[0], -mrun[0], -mrun[0]}, n1 = {-mrun[1], -mrun[1], -mrun[1], -mrun[1]};
        const char* kb2 = Kl + cur * KT_BYTES + fr * KROW + fq * 16 + 128;
#pragma unroll
        for (int k4 = 0; k4 < 4; ++k4) {
          as[k4][0] = __builtin_amdgcn_mfma_f32_16x16x32_bf16(kf[0][k4], qf[0][0], n0, 0, 0, 0);
          as[k4][1] = __builtin_amdgcn_mfma_f32_16x16x32_bf16(kf[0][k4], qf[1][0], n1, 0, 0, 0);
        }
        __builtin_amdgcn_sched_barrier(0);
#pragma unroll
        for (int k4 = 0; k4 < 4; ++k4) kf[0][k4] = *(const bf16x8*)(kb2 + k4 * 16 * KROW);
        __builtin_amdgcn_sched_barrier(0);
#pragma unroll
        for (int k4 = 0; k4 < 4; ++k4) {
          as[k4][0] = __builtin_amdgcn_mfma_f32_16x16x32_bf16(kf[1][k4], qf[0][1], as[k4][0], 0, 0, 0);
          as[k4][1] = __builtin_amdgcn_mfma_f32_16x16x32_bf16(kf[1][k4], qf[1][1], as[k4][1], 0, 0, 0);
        }
#pragma unroll
        for (int k4 = 0; k4 < 4; ++k4) {
          as[k4][0] = __builtin_amdgcn_mfma_f32_16x16x32_bf16(kf[0][k4], qf[0][2], as[k4][0], 0, 0, 0);
          as[k4][1] = __builtin_amdgcn_mfma_f32_16x16x32_bf16(kf[0][k4], qf[1][2], as[k4][1], 0, 0, 0);
        }
      }
      __builtin_amdgcn_sched_barrier(0);
      bf16x8 vf[2][4];
      {
        const char* vb = Vl + cur * VT_BYTES + fr * VROW + fq * 8;
#pragma unroll
        for (int ks = 0; ks < 2; ++ks)
#pragma unroll
          for (int dt = 0; dt < 4; ++dt) {
            if (ks == 1 && dt >= 2) continue;
            u32x2 lo = *(const u32x2*)(vb + dt * 16 * VROW + ks * 64);
            u32x2 hi = *(const u32x2*)(vb + dt * 16 * VROW + ks * 64 + 32);
            u32x4 a4 = {lo.x, lo.y, hi.x, hi.y};
            vf[ks][dt] = *(bf16x8*)&a4;
          }
      }
      __builtin_amdgcn_sched_barrier(0);
      bf16x8 pf[2][2];
#pragma unroll
      for (int qt = 0; qt < 2; ++qt) {
        float mx = as[0][qt][0];
#pragma unroll
        for (int k4 = 0; k4 < 4; ++k4)
#pragma unroll
          for (int j = 0; j < 4; ++j) mx = fmaxf(mx, as[k4][qt][j]);
        if (t == 0 || __builtin_amdgcn_ballot_w64(mx > 8.f) != 0ull) {
          mx = fmaxf(mx, __shfl_xor(mx, 16));
          mx = fmaxf(mx, __shfl_xor(mx, 32));
          const float dl = (t == 0) ? mx : fmaxf(mx, 0.f);
          const float alpha = (t == 0) ? 1.f : __builtin_amdgcn_exp2f(-dl);
          mrun[qt] += dl;
          al[qt][0] *= alpha; al[qt][1] *= alpha; al[qt][2] *= alpha; al[qt][3] *= alpha;
#pragma unroll
          for (int dt = 0; dt < 4; ++dt) { ao[dt][qt][0] *= alpha; ao[dt][qt][1] *= alpha; ao[dt][qt][2] *= alpha; ao[dt][qt][3] *= alpha; }
#pragma unroll
          for (int k4 = 0; k4 < 4; ++k4) { as[k4][qt][0] -= dl; as[k4][qt][1] -= dl; as[k4][qt][2] -= dl; as[k4][qt][3] -= dl; }
        }
        float pv[4][4];
#pragma unroll
        for (int k4 = 0; k4 < 4; ++k4)
#pragma unroll
          for (int j = 0; j < 4; ++j) pv[k4][j] = __builtin_amdgcn_exp2f(as[k4][qt][j]);
#pragma unroll
        for (int ks = 0; ks < 2; ++ks) {
          u32x4 o;
          o.x = pk2(pv[2 * ks][0], pv[2 * ks][1]); o.y = pk2(pv[2 * ks][2], pv[2 * ks][3]);
          o.z = pk2(pv[2 * ks + 1][0], pv[2 * ks + 1][1]); o.w = pk2(pv[2 * ks + 1][2], pv[2 * ks + 1][3]);
          pf[qt][ks] = *(bf16x8*)&o;
        }
      }
      __builtin_amdgcn_sched_barrier(0);
      {
        const char* vb = Vl + cur * VT_BYTES + fr * VROW + fq * 8;
#pragma unroll
        for (int dt = 2; dt < 4; ++dt) {
          u32x2 lo = *(const u32x2*)(vb + dt * 16 * VROW + 64);
          u32x2 hi = *(const u32x2*)(vb + dt * 16 * VROW + 64 + 32);
          u32x4 a4 = {lo.x, lo.y, hi.x, hi.y};
          vf[1][dt] = *(bf16x8*)&a4;
        }
      }
      {
        char* kd = Kl + (cur ^ 1) * KT_BYTES; char* vd = Vl + (cur ^ 1) * VT_BYTES;
        *(u32x4*)(kd + ko0) = xk0; *(u32x4*)(kd + ko1) = xk1; *(u32x4*)(kd + ko2) = xk2;
        *(u32x4*)(vd + vo0) = xv0; *(u32x4*)(vd + vo1) = xv1;
        const int t3 = min(t + 2, ntile - 1);
        const char* kg = Kg + (size_t)t3 * 12288;
        xk0 = *(const u32x4*)(kg + tid * 16); xk1 = *(const u32x4*)(kg + (tid + 256) * 16); xk2 = *(const u32x4*)(kg + (tid + 512) * 16);
        xv0 = *(const u32x4*)(Vg + vg0 + t3 * 64); xv1 = *(const u32x4*)(Vg + vg1 + t3 * 64);
      }
      const u32x4 o4 = {0x3f803f80u, 0x3f803f80u, 0x3f803f80u, 0x3f803f80u};
      const bf16x8 ones = *(const bf16x8*)&o4;
#pragma unroll
      for (int dt = 0; dt < 4; ++dt) {
        ao[dt][0] = __builtin_amdgcn_mfma_f32_16x16x32_bf16(vf[0][dt], pf[0][0], ao[dt][0], 0, 0, 0);
        ao[dt][1] = __builtin_amdgcn_mfma_f32_16x16x32_bf16(vf[0][dt], pf[1][0], ao[dt][1], 0, 0, 0);
      }
      al[0] = __builtin_amdgcn_mfma_f32_16x16x32_bf16(ones, pf[0][0], al[0], 0, 0, 0);
      al[1] = __builtin_amdgcn_mfma_f32_16x16x32_bf16(ones, pf[1][0], al[1], 0, 0, 0);
      __builtin_amdgcn_sched_barrier(0);
      __syncthreads();
      {
        const char* kb = Kl + (cur ^ 1) * KT_BYTES + fr * KROW + fq * 16;
#pragma unroll
        for (int s = 0; s < 2; ++s)
#pragma unroll
          for (int k4 = 0; k4 < 4; ++k4) kf[s][k4] = *(const bf16x8*)(kb + k4 * 16 * KROW + s * 64);
      }
      __builtin_amdgcn_sched_barrier(0);
#pragma unroll
      for (int dt = 0; dt < 4; ++dt) {
        ao[dt][0] = __builtin_amdgcn_mfma_f32_16x16x32_bf16(vf[1][dt], pf[0][1], ao[dt][0], 0, 0, 0);
        ao[dt][1] = __builtin_amdgcn_mfma_f32_16x16x32_bf16(vf[1][dt], pf[1][1], ao[dt][1], 0, 0, 0);
      }
      al[0] = __builtin_amdgcn_mfma_f32_16x16x32_bf16(ones, pf[0][1], al[0], 0, 0, 0);
      al[1] = __builtin_amdgcn_mfma_f32_16x16x32_bf16(ones, pf[1][1], al[1], 0, 0, 0);
    };
    for (int t = 0; t < ntile; t += 2) {
      tile_iter(t, kr0, kr1, kr2, vr0, vr1);
      tile_iter(t + 1, kr0, kr1, kr2, vr0, vr1);
    }
#pragma unroll
    for (int qt = 0; qt < 2; ++qt) {
      const float inv = 1.f / al[qt][0];
      const int r = q0 + qt * 16 + fr;
      const int tok = lat ? NCTX + b * SEQ + r : b * CTXL + r;
      AT* dst = p.MIX + (size_t)tok * 1024 + h * 64 + 4 * fq;
#pragma unroll
      for (int dt = 0; dt < 4; ++dt) {
        u32x2 o; o.x = pk2(ao[dt][qt][0] * inv, ao[dt][qt][1] * inv); o.y = pk2(ao[dt][qt][2] * inv, ao[dt][qt][3] * inv);
        *(u32x2*)(dst + dt * 16) = o;
      }
    }
  }
}
#endif

enum { PH_ADA1 = 0, PH_ADA2, PH_T1, PH_G1E, PH_R1, PH_R2, PH_R3, PH_G2E, PH_T2, PH_E1, PH_E2, PH_M1, PH_MN, PH_M2, PH_ATT, PH_M4, PH_FINAL, PH_RB };

#if EXACT
#define T1_CALL ph_T1(p, l, bid, nb);
#define FINAL_CALL ph_final(p, bid, nb);
#define T2_CALL ph_T2(p, l, bid, nb, lds);
#define R1_CALL ph_R1(p, l, bid, nb, lds);
#define R2_CALL ph_R2(p, l, bid, nb);
#define R3_CALL ph_R3(p, l, bid, nb, lds);
#define ATT_CALL ph_ATT(p, l, bid, nb, lds);
#define G1E_CALL ph_gemm_store(p, p.H, 1024, p.ab_w_in + (size_t)li * 1024 * 3072, 1024, 3072, p.PROJ, 3072, 0, bid, nb, lds);
#define G2E_CALL ph_gemm_resid(p, l, p.MIX, p.ab_w_out + (size_t)li * 1024 * 1024, 0, bid, nb, lds);
#define E1_CALL ph_E1(p, l, bid, nb, lds);
#define E2_CALL ph_E2(p, l, bid, nb, lds);
#define M1_CALL ph_gemm_store(p, p.H, 1024, p.mla_w_in + (size_t)li * 1024 * 672, 1024, 672, p.PROJ, P1LD, 0, bid, nb, lds);
#define M2_CALL ph_M2(p, l, bid, nb, lds);
#define M4_CALL ph_gemm_resid(p, l, p.MIX, p.mla_w_out + (size_t)li * 1024 * 1024, (l == 3) ? 8 : 0, bid, nb, lds);
#else
#define T1_CALL ph_T1_f(p, l, bid, nb);
#define FINAL_CALL ph_final_f(p, bid, nb);
#define T2_CALL ph_T2_f(p, l, bid, nb, lds);
#define R1_CALL ph_R1_f(p, l, bid, nb, lds);
#define R2_CALL ph_R2_f(p, l, bid, nb);
#define R3_CALL ph_R3_f(p, l, bid, nb, lds);
#define ATT_CALL ph_ATT_f(p, l, bid, nb, lds);
#define G1E_CALL ph_gemm_store_f<1>(p, p.H, 1024, p.WB + WB_ABIN + (size_t)li * 1024 * 3072, 1024, 3072, p.PROJ, 3072, bid, nb, lds);
#define G2E_CALL ph_gemm_resid_f(p, l, p.MIX, p.WB + WB_ABOUT + (size_t)li * 1024 * 1024, 0, bid, nb, lds);
#if E1_FAST == 2
#define E1_CALL ph_E1_g(p, l, bid, nb, lds);
#elif E1_FAST
#define E1_CALL ph_E1_f(p, l, bid, nb, lds);
#else
#define E1_CALL ph_E1(p, l, bid, nb, lds);
#endif
#define E2_CALL ph_E2_f(p, l, bid, nb, lds);
#define M1_CALL ph_gemm_store_f<0>(p, p.H, 1024, p.WB + WB_MIN + (size_t)li * 1024 * 672, 1024, 672, p.PROJ, P1LD, bid, nb, lds);
#define M2_CALL ph_M2_f(p, l, bid, nb, lds);
#define M4_CALL ph_gemm_resid_f(p, l, p.MIX, p.WB + WB_MOUT + (size_t)li * 1024 * 1024, (l == 3) ? 8 : 0, bid, nb, lds);
#endif
__device__ __forceinline__ void run_phase(const Params& p, int ph, int l, int bid, int nb, char* lds) {
  const int li = l >> 1;
  switch (ph) {
    case PH_ADA1: if constexpr (((PHMASK) >> PH_ADA1) & 1) { ph_ada1(p, bid, nb, lds);
#if !EXACT
      conv_dense_weights(p, bid, nb, lds);
      conv_moe_weights(p, bid, nb, lds);
#endif
    } break;
    case PH_ADA2: if constexpr (((PHMASK) >> PH_ADA2) & 1) { ph_ada2(p, bid, nb); } break;
    case PH_T1: if constexpr (((PHMASK) >> PH_T1) & 1) { T1_CALL } break;
    case PH_G1E: if constexpr (((PHMASK) >> PH_G1E) & 1) { G1E_CALL } break;
    case PH_R1: if constexpr (((PHMASK) >> PH_R1) & 1) { R1_CALL } break;
    case PH_R2: if constexpr (((PHMASK) >> PH_R2) & 1) { R2_CALL } break;
    case PH_R3: if constexpr (((PHMASK) >> PH_R3) & 1) { R3_CALL } break;
    case PH_G2E: if constexpr (((PHMASK) >> PH_G2E) & 1) { G2E_CALL } break;
    case PH_T2: if constexpr (((PHMASK) >> PH_T2) & 1) { T2_CALL } break;
    case PH_E1: if constexpr (((PHMASK) >> PH_E1) & 1) { E1_CALL } break;
    case PH_E2: if constexpr (((PHMASK) >> PH_E2) & 1) { E2_CALL } break;
    case PH_M1: if constexpr (((PHMASK) >> PH_M1) & 1) { M1_CALL } break;
    case PH_MN: if constexpr (((PHMASK) >> PH_MN) & 1) { ph_MN(p, l, bid, nb); } break;
    case PH_M2: if constexpr (((PHMASK) >> PH_M2) & 1) { M2_CALL } break;
    case PH_ATT: if constexpr (((PHMASK) >> PH_ATT) & 1) { ATT_CALL } break;
    case PH_M4: if constexpr (((PHMASK) >> PH_M4) & 1) { M4_CALL } break;
    case PH_FINAL: if constexpr (((PHMASK) >> PH_FINAL) & 1) { FINAL_CALL } break;
    case PH_RB: if constexpr (((PHMASK) >> PH_RB) & 1) { ph_RB(p, l, bid, nb, lds); } break;
  }
}

constexpr int NPHASE = 43;
__host__ __device__ __forceinline__ void decode_phase(int i, int& ph, int& l) {
  if (i == 0) { ph = PH_ADA1; l = 0; return; }
  if (i == 1) { ph = PH_ADA2; l = 0; return; }
  if (i == NPHASE - 1) { ph = PH_FINAL; l = 0; return; }
  int j = i - 2; l = j / 10; int s = j % 10;
  bool even = (l & 1) == 0;
  if (s == 0) ph = PH_T1;
  else if (s == 1) ph = even ? PH_G1E : PH_M1;
  else if (s == 2) ph = even ? PH_R1 : PH_MN;
  else if (s == 3) ph = even ? PH_R2 : PH_M2;
  else if (s == 4) ph = even ? PH_R3 : PH_ATT;
  else if (s == 5) ph = even ? PH_G2E : PH_M4;
  else if (s == 6) ph = PH_T2;
  else if (s == 7) ph = PH_RB;
  else if (s == 8) ph = PH_E1;
  else ph = PH_E2;
}

#if !MEGA
__global__ void __launch_bounds__(256 LB2) k_phase(Params p, int ph, int l) {
  __shared__ __attribute__((aligned(16))) char smem[LDS_BYTES];
  run_phase(p, ph, l, blockIdx.x, gridDim.x, smem);
}
#else
__global__ void __launch_bounds__(256 LB2) k_mega(Params p) {
  __shared__ __attribute__((aligned(16))) char smem[LDS_BYTES];
  volatile LAS unsigned* st = (volatile LAS unsigned*)(smem + MISC_OFF + 496);
  if (tidx() == 0) { st[0] = 0u; st[1] = 0u; st[2] = 0u; st[3] = 0u; }
  __syncthreads();
  XcdBarrier xb = xcd_barrier_post(p.bar, st);
  const int nb = gridDim.x;
  const int bid = blockIdx.x;
  const int vbid = (nb & 7) == 0 ? (int)(blockIdx.x & 7) * (nb >> 3) + (int)(blockIdx.x >> 3) : (int)blockIdx.x;
#ifndef XCDMASK
#define XCDMASK (1<<PH_ATT)
#endif
#ifndef HALFMASK
#define HALFMASK 0
#endif
#ifndef DUPMASK
#define DUPMASK 0
#endif
#define RUNP(PH, L) { run_phase(p, PH, L, (((XCDMASK) >> (PH)) & 1) ? vbid : bid, nb, smem); xcd_barrier(xb); if (((DUPMASK) >> (PH)) & 1) { run_phase(p, PH, L, bid, nb, smem); xcd_barrier(xb); } }
  RUNP(PH_ADA1, 0) RUNP(PH_ADA2, 0)
#pragma unroll 1
  for (int l = 0; l < 4; ++l) {
    RUNP(PH_T1, l)
    if ((l & 1) == 0) { RUNP(PH_G1E, l) RUNP(PH_R1, l) RUNP(PH_R2, l) RUNP(PH_R3, l) RUNP(PH_G2E, l) }
    else { RUNP(PH_M1, l) RUNP(PH_MN, l) RUNP(PH_M2, l) RUNP(PH_ATT, l) RUNP(PH_M4, l) }
    RUNP(PH_T2, l) RUNP(PH_RB, l) RUNP(PH_E1, l) RUNP(PH_E2, l)
  }
  run_phase(p, PH_FINAL, 0, bid, nb, smem);
}

#endif
static inline size_t al256(size_t x) { return (x + 255) & ~(size_t)255; }

extern "C" void kernel_launch(void* const* d_in, const int* in_sizes, int n_in, void* d_out, int out_size, void* d_ws, size_t ws_size, hipStream_t stream) {
  (void)in_sizes; (void)n_in; (void)out_size;
  Params p; memset(&p, 0, sizeof(p));
  const float** ins = (const float**)&p;
  for (int i = 0; i < 29; ++i) ins[i] = (const float*)d_in[i];
  p.out = (float*)d_out;
  char* w = (char*)d_ws; size_t off = 0;
  auto take = [&](size_t bytes) { char* r = w + off; off = al256(off + bytes); return r; };
  const size_t ZERO_BYTES = 16384;
  p.bar = (unsigned*)take(16384); p.cnt = (int*)take(4 * 32 * 32 * 4);
  p.mod = (float*)take((size_t)4 * 5 * 6144 * 4);
  p.modp = (float*)take((size_t)4 * 8 * 5 * 6144 * 4);
  p.cs1c = (float*)take(4096 * 64 * 4); p.cs1s = (float*)take(4096 * 64 * 4);
  p.cs2c = (float*)take(4096 * 16 * 4); p.cs2s = (float*)take(4096 * 16 * 4);
  p.re = (int*)take((size_t)NTOK * 2 * 4); p.rw = (float*)take((size_t)NTOK * 2 * 4);
  p.list = (int*)take((size_t)32 * NTOK * 4);
  p.RQ = (float*)take((size_t)NTOK * 4); p.RKV = (float*)take((size_t)NTOK * 4);
  p.KR = (AT*)take((size_t)NTOK * 32 * sizeof(AT));
  p.WB = (AT*)take(WB_TOTAL * sizeof(AT));
#if !EXACT
  p.WM = (AT*)take((size_t)3 * 128 * 1024 * 512 * sizeof(AT));
#endif
  p.SSQ = (float*)take((size_t)8 * NTOK * 4);
  p.WR = (unsigned short*)take((size_t)4 * 2 * 128 * 48 * 8 * 2);
  p.CHA = (float*)take((size_t)2 * 4 * 272 * 512 * 4); p.CHH = (float*)take((size_t)2 * 4 * 272 * 512 * 4); p.CAR = (float*)take((size_t)2 * 4 * 272 * 512 * 4);
  p.X = (float*)take((size_t)NTOK * 1024 * 4);
  p.H = (AT*)take((size_t)NTOK * 1024 * sizeof(AT));
  p.PROJ = (AT*)take((size_t)NTOK * 3072 * sizeof(AT));
  p.MIX = (AT*)take((size_t)NTOK * 1024 * sizeof(AT));
  p.Y = (AT*)take((size_t)NTOK * 2 * 1024 * sizeof(AT));
  size_t reg0 = off;
  p.U = (float*)take((size_t)32 * NCH * 16384 * 4);
  p.HL = (float*)take((size_t)2 * NTOK * 512 * 4);
  p.SB = (AT*)p.HL;
  p.AC = (float*)take((size_t)2 * NTOK * 512 * 4);
#if EXACT
  p.SCR = (float*)take((size_t)1024 * 16384 * 4);
#endif
  size_t hb_off = off;
  p.HB = (AT*)take((size_t)(NTOK * 2) * 512 * sizeof(AT));
#if EXACT
  p.HU = (AT*)take((size_t)(NTOK * 2) * 512 * sizeof(AT));
#endif
  size_t reg_end = off;
  off = reg0;
  p.Ql = (AT*)take((size_t)NTOK * QLD * sizeof(AT));
  p.Qc = p.Ql;
  p.Kb = (AT*)take((size_t)NBAT * 16 * KVL * 96 * sizeof(AT));
  p.Vb = (AT*)take((size_t)NBAT * 16 * KVL * 64 * sizeof(AT));
  p.Vt = p.Vb;
  if (off > reg_end) reg_end = off;
  (void)hb_off;
  if (reg_end > ws_size) { fprintf(stderr, "workspace too small: need %zu have %zu\n", reg_end, ws_size); return; }

  (void)hipMemsetAsync(d_ws, 0, ZERO_BYTES, stream);
#if MEGA
  static int grid_blocks = 0;
  if (!grid_blocks) {
    int dev = 0, cus = 0, per_cu = 0;
    hipGetDevice(&dev);
    hipDeviceGetAttribute(&cus, hipDeviceAttributeMultiprocessorCount, dev);
    hipOccupancyMaxActiveBlocksPerMultiprocessor(&per_cu, k_mega, 256, 0);
    if (per_cu > 2) per_cu = 2;
    if (per_cu < 1) per_cu = 1;
    grid_blocks = cus * per_cu;
  }
  void* args[] = {&p};
  hipError_t e = hipLaunchCooperativeKernel((void*)k_mega, dim3(grid_blocks), dim3(256), args, 0, stream);
  if (e != hipSuccess) fprintf(stderr, "cooperative launch failed: %s (grid %d)\n", hipGetErrorString(e), grid_blocks);
#else
  for (int i = 0; i < NPHASE; ++i) { int ph, l; decode_phase(i, ph, l); k_phase<<<1024, 256, 0, stream>>>(p, ph, l); }
#endif
}
```

```cpp
#include <hip/hip_runtime.h>
#include <hip/hip_bf16.h>
#include <stdint.h>
#include <stdio.h>
#include <string.h>

#ifndef EXACT
#define EXACT 0
#endif
#ifndef ENGINE
#define ENGINE 1
#endif
#ifndef PHMASK
#define PHMASK 0x3ffff
#endif
#ifndef E1_FAST
#define E1_FAST 2
#endif
#ifndef MEGA
#define MEGA 1
#endif

constexpr int DM = 1024, NBAT = 4, SEQ = 4096, CTXL = 256, NLAY = 4;
constexpr int NCTX = NBAT * CTXL;
constexpr int NTOK = NCTX + NBAT * SEQ;
constexpr int NRT = NTOK / 128;
constexpr int NCH = 34;
constexpr int KVL = CTXL + SEQ;
constexpr float EPSF = 1e-6f;
constexpr int ST_LD = 132;
constexpr int P1LD = 768;
constexpr int QLD = 1536;
constexpr size_t WB_ABIN = 0, WB_ABOUT = WB_ABIN + 2ull * 1024 * 3072, WB_MIN = WB_ABOUT + 2ull * 1024 * 1024, WB_UQ = WB_MIN + 2ull * 1024 * 672,
                 WB_UKV = WB_UQ + 2ull * 384 * 1536, WB_MOUT = WB_UKV + 2ull * 256 * 2048, WB_TOTAL = WB_MOUT + 2ull * 1024 * 1024;
#if EXACT
#define KSCALE 0.08838834764831845f
#else
#define KSCALE 1.0f
#endif

#if EXACT
typedef float AT;
__device__ __forceinline__ float ldA(const AT* p) { return *p; }
__device__ __forceinline__ void stA(AT* p, float v) { *p = v; }
#else
typedef __hip_bfloat16 AT;
__device__ __forceinline__ float ldA(const AT* p) { return __bfloat162float(*p); }
__device__ __forceinline__ void stA(AT* p, float v) { *p = __float2bfloat16(v); }
#endif

struct Params {
  const float *x, *c, *ctx, *c_ctx, *ada_w, *ada_b, *norm_g, *ab_w_in, *ab_w_out, *ret_decay,
      *conv_w, *conv_b, *gate_w, *gate_b, *lam, *mla_w_in, *q_g, *kv_g, *w_uq, *w_ukv, *mla_w_out,
      *grp_w, *grp_b, *exp_w, *exp_b, *w_gate, *w_up, *w_down, *final_g;
  float* out;
  unsigned* bar; int* cnt;
  float *mod, *modp, *cs1c, *cs1s, *cs2c, *cs2s, *X;
  AT *H, *PROJ, *MIX;
  float *U, *HL, *AC, *CHA, *CHH, *CAR, *SCR;
  int* re; float* rw; int* list;
  AT *HB, *Y, *HU;
  float *RQ, *RKV;
  AT *Ql, *Qc, *Kb, *Vb, *Vt, *KR;
  AT* WB;
  AT* WM;
  AT* SB;
  float* SSQ;
  unsigned short* WR;
};

__device__ __forceinline__ int tidx() { int t = __builtin_amdgcn_workitem_id_x(); asm volatile("" : "+v"(t)); return t; }
__device__ __forceinline__ float silu_f(float x) { return x / (1.f + expf(-x)); }
__device__ __forceinline__ float sigmoid_f(float x) { return 1.f / (1.f + expf(-x)); }
__device__ __forceinline__ float gelu_tanh(float x) {
  float u = 0.7978845608028654f * (x + 0.044715f * x * x * x);
  return 0.5f * x * (1.f + tanhf(u));
}
__device__ __forceinline__ float silu_fast(float x) { return x * __builtin_amdgcn_rcpf(1.f + __builtin_amdgcn_exp2f(-1.4426950408889634f * x)); }
__device__ __forceinline__ float gelu_tanh_fast(float x) {
  float u = 0.7978845608028654f * (x + 0.044715f * x * x * x);
  return x * __builtin_amdgcn_rcpf(1.f + __builtin_amdgcn_exp2f(-2.f * 1.4426950408889634f * u));
}
__device__ __forceinline__ float softplus_f(float x) { return x > 20.f ? x : log1pf(expf(x)); }
__device__ __forceinline__ float wave_sum(float v) {
#pragma unroll
  for (int o = 32; o > 0; o >>= 1) v += __shfl_xor(v, o);
  return v;
}
__device__ __forceinline__ float wave_max(float v) {
#pragma unroll
  for (int o = 32; o > 0; o >>= 1) v = fmaxf(v, __shfl_xor(v, o));
  return v;
}
__device__ __forceinline__ float half_sum(float v) {
#pragma unroll
  for (int o = 16; o > 0; o >>= 1) v += __shfl_xor(v, o);
  return v;
}
__device__ __forceinline__ int tok_modrow(int tok) { return tok < NCTX ? 4 : ((tok - NCTX) >> 12); }
__device__ __forceinline__ int chunk_tok0(int b, int c) { return c < 2 ? b * CTXL + c * 128 : NCTX + b * SEQ + (c - 2) * 128; }
__device__ __forceinline__ void rt_to_bc(int rt, int& b, int& c) {
  if (rt < 8) { b = rt >> 1; c = rt & 1; } else { int r = rt - 8; b = r >> 5; c = 2 + (r & 31); }
}
__device__ __forceinline__ void sincos_acc(float ang, float& s, float& c) {
  double a = (double)ang;
  double q = rint(a * 0.6366197723675814);
  double r = a - q * 1.5707963267948966 - q * 6.123233995736766e-17;
  int qi = ((int)q) & 3;
  double r2 = r * r;
  double sn = r * (1.0 + r2 * (-1.0 / 6 + r2 * (1.0 / 120 + r2 * (-1.0 / 5040 + r2 * (1.0 / 362880 + r2 * (-1.0 / 39916800 + r2 * (1.0 / 6227020800.0)))))));
  double cn = 1.0 + r2 * (-0.5 + r2 * (1.0 / 24 + r2 * (-1.0 / 720 + r2 * (1.0 / 40320 + r2 * (-1.0 / 3628800 + r2 * (1.0 / 479001600 + r2 * (-1.0 / 87178291200.0)))))));
  double ss, cc;
  if (qi == 0) { ss = sn; cc = cn; } else if (qi == 1) { ss = cn; cc = -sn; } else if (qi == 2) { ss = -sn; cc = -cn; } else { ss = -cn; cc = sn; }
  s = (float)ss; c = (float)cc;
}

#define XB_TMO      128
#define XB_XCNT(j)  (256  + 64 * (j))
#define XB_XSUB(j)  (1280 + 64 * (j))
#define XB_XGEN(j)  (2304 + 64 * (j))
#define XB_TOP      3328
#define XB_TOPGEN   3392
#define XCD_BAR_WORDS 3456
#define XB_SPIN_CAP (1u << 22)
#define LAS __attribute__((address_space(3)))
__device__ __forceinline__ unsigned xb_ld(unsigned* p) { return __hip_atomic_load(p, __ATOMIC_RELAXED, __HIP_MEMORY_SCOPE_AGENT); }
__device__ __forceinline__ unsigned xb_add(unsigned* p, unsigned v) { return __hip_atomic_fetch_add(p, v, __ATOMIC_RELAXED, __HIP_MEMORY_SCOPE_AGENT); }
__device__ __forceinline__ unsigned xb_xcc_id() { return (unsigned)__builtin_amdgcn_s_getreg((3 << 11) | 20) & 0xFu; }
#define XB_SPIN(cond, bar) do { unsigned _sp = 0; while (cond) { __builtin_amdgcn_s_sleep(1); \
    if ((++_sp & 255u) == 0u) { if (xb_ld(&(bar)[XB_TMO])) break; if (_sp > XB_SPIN_CAP) { atomicAdd(&(bar)[XB_TMO], 1u); break; } } } } while (0)
struct XcdBarrier { unsigned* bar; unsigned x; volatile LAS unsigned* st; };
__device__ __forceinline__ XcdBarrier xcd_barrier_post(unsigned* bar, volatile LAS unsigned* st) {
  XcdBarrier b; b.bar = bar; b.x = xb_xcc_id(); b.st = st;
  if (tidx() == 0) (void)xb_add(&bar[XB_XCNT(b.x)], 1u);
  return b;
}
__device__ __forceinline__ void xcd_barrier_complete(unsigned* bar, unsigned x, unsigned& nloc, unsigned& nx) {
  const unsigned G = gridDim.x * gridDim.y * gridDim.z;
  unsigned sum, cnt, mine, sp = 0u;
  for (;;) {
    sum = 0u; cnt = 0u; mine = 0u;
#pragma unroll
    for (unsigned j = 0; j < 16; ++j) { const unsigned c = xb_ld(&bar[XB_XCNT(j)]); sum += c; cnt += (c > 0u) ? 1u : 0u; mine = (j == x) ? c : mine; }
    if (sum == G) break;
    __builtin_amdgcn_s_sleep(1);
    if ((++sp & 255u) == 0u) { if (xb_ld(&bar[XB_TMO])) break; if (sp > XB_SPIN_CAP) { atomicAdd(&bar[XB_TMO], 1u); break; } }
  }
  nloc = mine > 0u ? mine : 1u; nx = cnt > 0u ? cnt : 1u;
}
__device__ __forceinline__ void xcd_barrier(const XcdBarrier& b) {
  asm volatile("s_waitcnt vmcnt(0)" ::: "memory");
  __syncthreads();
  if (tidx() == 0) {
    unsigned* bar = b.bar;
    unsigned bx = b.x;
    asm volatile("" : "+s"(bar), "+s"(bx));
    __builtin_amdgcn_s_waitcnt(0);
    unsigned nloc = b.st[0], nx = b.st[1];
    if (nloc == 0u) { xcd_barrier_complete(bar, bx, nloc, nx); b.st[0] = nloc; b.st[1] = nx; }
    const unsigned old = xb_add(&bar[XB_XSUB(bx)], 1u);
    const unsigned gen = old / nloc;
    if (old + 1u == (gen + 1u) * nloc) {
      __builtin_amdgcn_fence(__ATOMIC_RELEASE, "agent");
      asm volatile("s_waitcnt vmcnt(0)" ::: "memory");
      const unsigned og = xb_add(&bar[XB_TOP], 1u);
      const unsigned tg = og / nx;
      if (og + 1u == (tg + 1u) * nx) xb_add(&bar[XB_TOPGEN], 1u);
      else XB_SPIN(xb_ld(&bar[XB_TOPGEN]) == tg, bar);
      __builtin_amdgcn_fence(__ATOMIC_ACQUIRE, "agent");
      xb_add(&bar[XB_XGEN(bx)], 1u);
      asm volatile("s_waitcnt vmcnt(0)" ::: "memory");
    } else {
      XB_SPIN(xb_ld(&bar[XB_XGEN(bx)]) == gen, bar);
      __builtin_amdgcn_fence(__ATOMIC_ACQUIRE, "agent");
      asm volatile("s_waitcnt vmcnt(0)" ::: "memory");
    }
  }
  __syncthreads();
}

constexpr int STAGE_BYTES = 128 * ST_LD * 4;
#if ENGINE == 0
constexpr int OPS_OFF = STAGE_BYTES;
#else
constexpr int OPS_OFF = 0;
#endif
#if EXACT
constexpr int MISC_OFF = STAGE_BYTES + 2 * 32 * ST_LD * 4;
#define LB2
#else
constexpr int MISC_OFF = STAGE_BYTES;
#define LB2 , 2
#endif
constexpr int LDS_BYTES = MISC_OFF + 512 + 1024;

#if ENGINE == 0
template <class FA, class FB>
__device__ __forceinline__ void engine(char* lds, int K, FA fa, FB fb) {
  float* stage = (float*)lds;
  float* As = (float*)(lds + OPS_OFF);
  float* Bs = As + 32 * ST_LD;
  const int tid = tidx(), ty = tid >> 4, tx = tid & 15;
  float acc[8][8];
#pragma unroll
  for (int i = 0; i < 8; ++i)
#pragma unroll
    for (int j = 0; j < 8; ++j) acc[i][j] = 0.f;
  __syncthreads();
  for (int k0 = 0; k0 < K; k0 += 32) {
    for (int e = tid; e < 4096; e += 256) { int r = e >> 5, kk = e & 31; As[kk * ST_LD + r] = fa(r, k0 + kk); }
    for (int e = tid; e < 4096; e += 256) { int kk = e >> 7, c = e & 127; Bs[kk * ST_LD + c] = fb(k0 + kk, c); }
    __syncthreads();
#pragma unroll 4
    for (int kk = 0; kk < 32; ++kk) {
      float4 a0 = *(const float4*)(As + kk * ST_LD + ty * 4), a1 = *(const float4*)(As + kk * ST_LD + 64 + ty * 4);
      float4 b0 = *(const float4*)(Bs + kk * ST_LD + tx * 4), b1 = *(const float4*)(Bs + kk * ST_LD + 64 + tx * 4);
      float a[8] = {a0.x, a0.y, a0.z, a0.w, a1.x, a1.y, a1.z, a1.w};
      float b[8] = {b0.x, b0.y, b0.z, b0.w, b1.x, b1.y, b1.z, b1.w};
#pragma unroll
      for (int i = 0; i < 8; ++i)
#pragma unroll
        for (int j = 0; j < 8; ++j) acc[i][j] = fmaf(a[i], b[j], acc[i][j]);
    }
    __syncthreads();
  }
#pragma unroll
  for (int i = 0; i < 8; ++i) {
    int row = (i < 4) ? ty * 4 + i : 64 + ty * 4 + (i - 4);
    *(float4*)(stage + row * ST_LD + tx * 4) = make_float4(acc[i][0], acc[i][1], acc[i][2], acc[i][3]);
    *(float4*)(stage + row * ST_LD + 64 + tx * 4) = make_float4(acc[i][4], acc[i][5], acc[i][6], acc[i][7]);
  }
  __syncthreads();
}
#else
using bf16x8 = __attribute__((ext_vector_type(8))) short;
using f32x4 = __attribute__((ext_vector_type(4))) float;
__device__ __forceinline__ int lrow_off(int row, int k) {
  return row * 32 + ((((k >> 3) ^ ((-(row >> 2)) & 3))) << 3) + (k & 7);
}
template <class FA, class FB>
__device__ __forceinline__ void engine(char* lds, int K, FA fa, FB fb) {
  float* stage = (float*)lds;
  __hip_bfloat16* Ab = (__hip_bfloat16*)(lds + OPS_OFF);
  __hip_bfloat16* Bb = Ab + 128 * 32;
  const int tid = tidx(), lane = tid & 63, wid = tid >> 6, wr = wid >> 1, wc = wid & 1, fr = lane & 15, fq = lane >> 4;
  f32x4 acc[4][4];
#pragma unroll
  for (int m = 0; m < 4; ++m)
#pragma unroll
    for (int n = 0; n < 4; ++n) acc[m][n] = (f32x4){0.f, 0.f, 0.f, 0.f};
  __syncthreads();
  for (int k0 = 0; k0 < K; k0 += 32) {
    for (int e = tid; e < 4096; e += 256) { int r = e >> 5, kk = e & 31; Ab[lrow_off(r, kk)] = __float2bfloat16(fa(r, k0 + kk)); }
    for (int e = tid; e < 4096; e += 256) { int kk = e >> 7, c = e & 127; Bb[lrow_off(c, kk)] = __float2bfloat16(fb(k0 + kk, c)); }
    __syncthreads();
    bf16x8 af[4], bfr[4];
#pragma unroll
    for (int m = 0; m < 4; ++m) af[m] = *(const bf16x8*)(Ab + lrow_off(wr * 64 + m * 16 + fr, fq * 8));
#pragma unroll
    for (int n = 0; n < 4; ++n) bfr[n] = *(const bf16x8*)(Bb + lrow_off(wc * 64 + n * 16 + fr, fq * 8));
#pragma unroll
    for (int m = 0; m < 4; ++m)
#pragma unroll
      for (int n = 0; n < 4; ++n) acc[m][n] = __builtin_amdgcn_mfma_f32_16x16x32_bf16(af[m], bfr[n], acc[m][n], 0, 0, 0);
    __syncthreads();
  }
#pragma unroll
  for (int m = 0; m < 4; ++m)
#pragma unroll
    for (int n = 0; n < 4; ++n)
#pragma unroll
      for (int j = 0; j < 4; ++j) stage[(wr * 64 + m * 16 + fq * 4 + j) * ST_LD + wc * 64 + n * 16 + fr] = acc[m][n][j];
  __syncthreads();
}
#endif


#if !EXACT
typedef __attribute__((ext_vector_type(2))) __bf16 bf2_t;
typedef __attribute__((ext_vector_type(2))) float f2_t;
__device__ __forceinline__ unsigned pk2(float a, float b) { f2_t f = {a, b}; bf2_t r = __builtin_convertvector(f, bf2_t); return *(unsigned*)&r; }
__device__ __forceinline__ float bf_lo(unsigned u) { return __uint_as_float(u << 16); }
__device__ __forceinline__ float bf_hi(unsigned u) { return __uint_as_float(u & 0xffff0000u); }
__device__ __forceinline__ int row_off(int r, int c) { return r * 64 + ((c ^ ((-(r >> 2)) & 3)) << 4); }
__device__ __forceinline__ int col_perm(int n) { return (n & ~31) | ((n >> 2) & 3) | ((((n >> 4) ^ n) & 1) << 2) | (((n >> 1) & 1) << 3) | ((n & 1) << 4); }
__device__ __forceinline__ int col_off(int n, int c) { return (c * 128 + col_perm(n)) * 16; }

typedef unsigned u32x4 __attribute__((ext_vector_type(4)));
typedef unsigned u32x2 __attribute__((ext_vector_type(2)));
typedef float fx4 __attribute__((ext_vector_type(4)));
template <bool CHK>
struct LdRow {
  static constexpr bool COL = false;
  const __hip_bfloat16 *p0, *p1; u32x4 v0[2], v1[2]; int o0;
  template <class RP> __device__ __forceinline__ void init(RP rp) {
    int ch = tidx() & 3, r0 = tidx() >> 2;
    const __hip_bfloat16* a = rp(r0); const __hip_bfloat16* b = rp(r0 + 64);
    p0 = a ? a + ch * 8 : nullptr; p1 = b ? b + ch * 8 : nullptr;
    o0 = row_off(r0, ch);
  }
  template <int S> __device__ __forceinline__ void fetch(int kt) {
    const u32x4 z = {0u, 0u, 0u, 0u};
    if (CHK) {
      v0[S] = z; v1[S] = z;
      if (p0) v0[S] = *(const u32x4*)(p0 + kt * 32);
      if (p1) v1[S] = *(const u32x4*)(p1 + kt * 32);
    } else { v0[S] = *(const u32x4*)(p0 + kt * 32); v1[S] = *(const u32x4*)(p1 + kt * 32); }
  }
  template <int S> __device__ __forceinline__ void commit(char* buf, int) { *(u32x4*)(buf + o0) = v0[S]; *(u32x4*)(buf + o0 + 4096) = v1[S]; }
};
__device__ __forceinline__ u32x4 scale8(u32x4 v, float s) {
  u32x4 r;
  r.x = pk2(bf_lo(v.x) * s, bf_hi(v.x) * s); r.y = pk2(bf_lo(v.y) * s, bf_hi(v.y) * s);
  r.z = pk2(bf_lo(v.z) * s, bf_hi(v.z) * s); r.w = pk2(bf_lo(v.w) * s, bf_hi(v.w) * s);
  return r;
}
struct LdRowS {
  static constexpr bool COL = false;
  const __hip_bfloat16 *p0, *p1; u32x4 v0[2], v1[2]; int o0; float s0, s1;
  template <class RP, class SC> __device__ __forceinline__ void init(RP rp, SC sc) {
    int ch = tidx() & 3, r0 = tidx() >> 2;
    p0 = rp(r0) + ch * 8; p1 = rp(r0 + 64) + ch * 8; s0 = sc(r0); s1 = sc(r0 + 64);
    o0 = row_off(r0, ch);
  }
  template <int S> __device__ __forceinline__ void fetch(int kt) { v0[S] = *(const u32x4*)(p0 + kt * 32); v1[S] = *(const u32x4*)(p1 + kt * 32); }
  template <int S> __device__ __forceinline__ void commit(char* buf, int) { *(u32x4*)(buf + o0) = scale8(v0[S], s0); *(u32x4*)(buf + o0 + 4096) = scale8(v1[S], s1); }
};
__device__ __forceinline__ unsigned silu_mul2(unsigned g, unsigned u) {
  float g0 = bf_lo(g), g1 = bf_hi(g), u0 = bf_lo(u), u1 = bf_hi(u);
  return pk2(g0 / (1.f + __expf(-g0)) * u0, g1 / (1.f + __expf(-g1)) * u1);
}
struct LdRowGU {
  static constexpr bool COL = false;
  const __hip_bfloat16 *p0, *p1; u32x4 g0[2], g1[2], u0[2], u1[2]; int o0; ptrdiff_t du;
  template <class RP> __device__ __forceinline__ void init(RP rp, ptrdiff_t du_) {
    int ch = tidx() & 3, r0 = tidx() >> 2;
    const __hip_bfloat16* a = rp(r0); const __hip_bfloat16* b = rp(r0 + 64);
    p0 = a ? a + ch * 8 : nullptr; p1 = b ? b + ch * 8 : nullptr; du = du_;
    o0 = row_off(r0, ch);
  }
  template <int S> __device__ __forceinline__ void fetch(int kt) {
    const u32x4 z = {0u, 0u, 0u, 0u};
    g0[S] = z; g1[S] = z; u0[S] = z; u1[S] = z;
    if (p0) { g0[S] = *(const u32x4*)(p0 + kt * 32); u0[S] = *(const u32x4*)(p0 + du + kt * 32); }
    if (p1) { g1[S] = *(const u32x4*)(p1 + kt * 32); u1[S] = *(const u32x4*)(p1 + du + kt * 32); }
  }
  template <int S> __device__ __forceinline__ void commit(char* buf, int) {
    u32x4 a, b;
    a.x = silu_mul2(g0[S].x, u0[S].x); a.y = silu_mul2(g0[S].y, u0[S].y); a.z = silu_mul2(g0[S].z, u0[S].z); a.w = silu_mul2(g0[S].w, u0[S].w);
    b.x = silu_mul2(g1[S].x, u1[S].x); b.y = silu_mul2(g1[S].y, u1[S].y); b.z = silu_mul2(g1[S].z, u1[S].z); b.w = silu_mul2(g1[S].w, u1[S].w);
    *(u32x4*)(buf + o0) = a; *(u32x4*)(buf + o0 + 4096) = b;
  }
};
struct LdColF {
  static constexpr bool COL = true;
  const float* p; size_t ld; fx4 w0[2], w1[2], w2[2], w3[2]; int ob; bool ok;
  __device__ __forceinline__ void init(const float* W, size_t ld_, int nvalid) {
    int half = tidx() & 1, n4 = (tidx() >> 1) & 31, ch = tidx() >> 6;
    ld = ld_; ok = 4 * n4 < nvalid;
    p = W + (size_t)(ch * 8 + half * 4) * ld + 4 * n4;
    ob = col_off(4 * n4, ch) + half * 8;
  }
  template <int S> __device__ __forceinline__ void fetch(int kt) {
    const fx4 z = {0.f, 0.f, 0.f, 0.f};
    w0[S] = z; w1[S] = z; w2[S] = z; w3[S] = z;
    if (ok) {
      const float* q = p + (size_t)(kt * 32) * ld;
      w0[S] = *(const fx4*)q; w1[S] = *(const fx4*)(q + ld); w2[S] = *(const fx4*)(q + 2 * ld); w3[S] = *(const fx4*)(q + 3 * ld);
    }
  }
  template <int S> __device__ __forceinline__ void commit(char* buf, int) {
    const int x1 = ob ^ 64;
    u32x2 t;
    t.x = pk2(w0[S].x, w1[S].x); t.y = pk2(w2[S].x, w3[S].x); *(u32x2*)(buf + ob) = t;
    t.x = pk2(w0[S].y, w1[S].y); t.y = pk2(w2[S].y, w3[S].y); *(u32x2*)(buf + x1 + 256) = t;
    t.x = pk2(w0[S].z, w1[S].z); t.y = pk2(w2[S].z, w3[S].z); *(u32x2*)(buf + ob + 128) = t;
    t.x = pk2(w0[S].w, w1[S].w); t.y = pk2(w2[S].w, w3[S].w); *(u32x2*)(buf + x1 + 384) = t;
  }
};
template <int SMODE>
struct LdColH {
  static constexpr bool COL = true;
  const __hip_bfloat16* p; size_t ld; u32x2 h0[2], h1[2], h2[2], h3[2]; int ob; float sl; int kb; bool ok;
  __device__ __forceinline__ void init(const __hip_bfloat16* W, size_t ld_, float sl_, int nvalid = 128) {
    int half = tidx() & 1, n4 = (tidx() >> 1) & 31, ch = tidx() >> 6;
    ld = ld_; sl = sl_; kb = ch * 8 + half * 4; ok = 4 * n4 < nvalid;
    p = W + (size_t)kb * ld + 4 * n4;
    ob = col_off(4 * n4, ch) + half * 8;
  }
  template <int S> __device__ __forceinline__ void fetch(int kt) {
    const __hip_bfloat16* q = p + (size_t)(kt * 32) * ld;
    const u32x2 z = {0u, 0u};
    h0[S] = z; h1[S] = z; h2[S] = z; h3[S] = z;
    if (ok) { h0[S] = *(const u32x2*)q; h1[S] = *(const u32x2*)(q + ld); h2[S] = *(const u32x2*)(q + 2 * ld); h3[S] = *(const u32x2*)(q + 3 * ld); }
  }
  template <int S> __device__ __forceinline__ void commit(char* buf, int kt) {
    const int x1 = ob ^ 64;
    const u32x2 a0 = h0[S], a1 = h1[S], a2 = h2[S], a3 = h3[S];
    u32x2 t;
    if (SMODE == 0) {
      t.x = (a0.x & 0xffffu) | (a1.x << 16); t.y = (a2.x & 0xffffu) | (a3.x << 16); *(u32x2*)(buf + ob) = t;
      t.x = (a0.x >> 16) | (a1.x & 0xffff0000u); t.y = (a2.x >> 16) | (a3.x & 0xffff0000u); *(u32x2*)(buf + x1 + 256) = t;
      t.x = (a0.y & 0xffffu) | (a1.y << 16); t.y = (a2.y & 0xffffu) | (a3.y << 16); *(u32x2*)(buf + ob + 128) = t;
      t.x = (a0.y >> 16) | (a1.y & 0xffff0000u); t.y = (a2.y >> 16) | (a3.y & 0xffff0000u); *(u32x2*)(buf + x1 + 384) = t;
    } else {
      const int k = kt * 32 + kb;
      const float z0 = __builtin_amdgcn_exp2f(sl * (float)(SMODE == 1 ? 127 - k : k)), z1 = __builtin_amdgcn_exp2f(sl * (float)(SMODE == 1 ? 126 - k : k + 1)),
                  z2 = __builtin_amdgcn_exp2f(sl * (float)(SMODE == 1 ? 125 - k : k + 2)), z3 = __builtin_amdgcn_exp2f(sl * (float)(SMODE == 1 ? 124 - k : k + 3));
      t.x = pk2(bf_lo(a0.x) * z0, bf_lo(a1.x) * z1); t.y = pk2(bf_lo(a2.x) * z2, bf_lo(a3.x) * z3); *(u32x2*)(buf + ob) = t;
      t.x = pk2(bf_hi(a0.x) * z0, bf_hi(a1.x) * z1); t.y = pk2(bf_hi(a2.x) * z2, bf_hi(a3.x) * z3); *(u32x2*)(buf + x1 + 256) = t;
      t.x = pk2(bf_lo(a0.y) * z0, bf_lo(a1.y) * z1); t.y = pk2(bf_lo(a2.y) * z2, bf_lo(a3.y) * z3); *(u32x2*)(buf + ob + 128) = t;
      t.x = pk2(bf_hi(a0.y) * z0, bf_hi(a1.y) * z1); t.y = pk2(bf_hi(a2.y) * z2, bf_hi(a3.y) * z3); *(u32x2*)(buf + x1 + 384) = t;
    }
  }
};
template <bool COL> __device__ __forceinline__ int frag_off(int base, int t, int fr, int fq) {
  return COL ? col_off(base + t * 16 + fr, fq) : row_off(base + t * 16 + fr, fq);
}
constexpr int FBUF_A0 = 0, FBUF_B0 = 32768;

__device__ __forceinline__ void mma_step(const char* bA, const char* bB, const int (&ao)[4], const int (&bo)[4], f32x4 (&acc)[4][4]) {
  bf16x8 af[4], bfr[4];
#pragma unroll
  for (int t = 0; t < 4; ++t) { af[t] = *(const bf16x8*)(bA + ao[t]); bfr[t] = *(const bf16x8*)(bB + bo[t]); }
#pragma unroll
  for (int m = 0; m < 4; ++m)
#pragma unroll
    for (int n = 0; n < 4; ++n) acc[m][n] = __builtin_amdgcn_mfma_f32_16x16x32_bf16(af[m], bfr[n], acc[m][n], 0, 0, 0);
}
template <class LA, class LB, int VAR = 0, bool PIN = true>
__device__ __forceinline__ void gemm_core(char* lds, int nk, LA& la, LB& lb, f32x4 (&acc)[4][4]) {
  const int lane = tidx() & 63, wid = tidx() >> 6, wr = wid >> 1, wc = wid & 1, fr = lane & 15, fq = lane >> 4;
  int ao[4], bo[4];
#pragma unroll
  for (int t = 0; t < 4; ++t) { ao[t] = frag_off<LA::COL>(wr * 64, t, fr, fq); bo[t] = frag_off<LB::COL>(wc * 64, t, fr, fq); }
  la.template fetch<0>(0); lb.template fetch<0>(0);
  la.template fetch<1>(1); lb.template fetch<1>(1);
  __syncthreads();
  la.template commit<0>(lds + FBUF_A0, 0); lb.template commit<0>(lds + FBUF_B0, 0);
  la.template commit<1>(lds + FBUF_A0 + 8192, 1); lb.template commit<1>(lds + FBUF_B0 + 8192, 1);
  __syncthreads();
  for (int kt = 0; kt < nk; kt += 2) {
    const int cur = (kt & 2) << 13;
    const bool more = kt + 2 < nk;
    if (VAR != 1 && more) {
      const int k0 = kt + 2;
      la.template fetch<0>(k0); lb.template fetch<0>(k0);
      la.template fetch<1>(k0 + 1); lb.template fetch<1>(k0 + 1);
    }
    if (PIN) __builtin_amdgcn_sched_barrier(0);
    if (VAR != 2) {
      mma_step(lds + FBUF_A0 + cur, lds + FBUF_B0 + cur, ao, bo, acc);
      mma_step(lds + FBUF_A0 + cur + 8192, lds + FBUF_B0 + cur + 8192, ao, bo, acc);
    }
    if (PIN) __builtin_amdgcn_sched_barrier(0);
    if (VAR != 3 && more) {
      const int nxt = cur ^ 16384;
      la.template commit<0>(lds + FBUF_A0 + nxt, kt + 2); lb.template commit<0>(lds + FBUF_B0 + nxt, kt + 2);
      la.template commit<1>(lds + FBUF_A0 + nxt + 8192, kt + 3); lb.template commit<1>(lds + FBUF_B0 + nxt + 8192, kt + 3);
    }
    __syncthreads();
  }
}
__device__ __forceinline__ void glds16(const void* g, char* l) {
  __builtin_amdgcn_global_load_lds((const void*)g, (LAS void*)l, 16, 0, 0);
}
__device__ __forceinline__ int glds_chunk_off() {
  const int r0 = tidx() >> 2, cp = tidx() & 3;
  return ((cp ^ ((-(r0 >> 2)) & 3)) << 3);
}
__device__ __forceinline__ void gemm_core_g(char* lds, int nk, const __hip_bfloat16* a0, const __hip_bfloat16* a1,
                                            const __hip_bfloat16* b0, const __hip_bfloat16* b1, f32x4 (&acc)[4][4]) {
  const int tid = tidx(), lane = tid & 63, wid = tid >> 6, wr = wid >> 1, wc = wid & 1, fr = lane & 15, fq = lane >> 4;
  int ao[4], bo[4];
#pragma unroll
  for (int t = 0; t < 4; ++t) { ao[t] = row_off(wr * 64 + t * 16 + fr, fq); bo[t] = row_off(wc * 64 + t * 16 + fr, fq); }
  char* my = lds + tid * 16;
  __syncthreads();
  glds16(a0, my); glds16(a1, my + 4096); glds16(b0, my + 8192); glds16(b1, my + 12288);
  glds16(a0 + 32, my + 16384); glds16(a1 + 32, my + 16384 + 4096); glds16(b0 + 32, my + 16384 + 8192); glds16(b1 + 32, my + 16384 + 12288);
  for (int kt = 0; kt < nk - 2; ++kt) {
    { const int kf = (kt + 2) * 32; char* d = my + ((kt + 2) & 3) * 16384;
      glds16(a0 + kf, d); glds16(a1 + kf, d + 4096); glds16(b0 + kf, d + 8192); glds16(b1 + kf, d + 12288); }
    asm volatile("s_waitcnt vmcnt(8)" ::: "memory");
    __builtin_amdgcn_s_barrier();
    asm volatile("" ::: "memory");
    const char* st = lds + (kt & 3) * 16384;
    mma_step(st, st + 8192, ao, bo, acc);
  }
  {
    asm volatile("s_waitcnt vmcnt(4)" ::: "memory");
    __builtin_amdgcn_s_barrier();
    asm volatile("" ::: "memory");
    const char* st = lds + ((nk - 2) & 3) * 16384;
    mma_step(st, st + 8192, ao, bo, acc);
    asm volatile("s_waitcnt vmcnt(0)" ::: "memory");
    __builtin_amdgcn_s_barrier();
    asm volatile("" ::: "memory");
    st = lds + ((nk - 1) & 3) * 16384;
    mma_step(st, st + 8192, ao, bo, acc);
  }
  __syncthreads();
}
__device__ __forceinline__ void acc_zero(f32x4 (&acc)[4][4]) {
#pragma unroll
  for (int m = 0; m < 4; ++m)
#pragma unroll
    for (int n = 0; n < 4; ++n) acc[m][n] = (f32x4){0.f, 0.f, 0.f, 0.f};
}
__device__ __forceinline__ void acc_to_stage(char* lds, f32x4 (&acc)[4][4]) {
  float* stage = (float*)lds;
  const int lane = tidx() & 63, wid = tidx() >> 6, wr = wid >> 1, wc = wid & 1, fr = lane & 15, fq = lane >> 4;
#pragma unroll
  for (int m = 0; m < 4; ++m)
#pragma unroll
    for (int n = 0; n < 4; ++n)
#pragma unroll
      for (int j = 0; j < 4; ++j) stage[(wr * 64 + m * 16 + fq * 4 + j) * ST_LD + wc * 64 + n * 16 + fr] = acc[m][n][j];
  __syncthreads();
}
__device__ __forceinline__ void st4bf(__hip_bfloat16* p, float4 v) { *(uint2*)p = make_uint2(pk2(v.x, v.y), pk2(v.z, v.w)); }
#endif

__device__ __forceinline__ void stA4(AT* p, float4 v) { stA(p, v.x); stA(p + 1, v.y); stA(p + 2, v.z); stA(p + 3, v.w); }

__device__ __forceinline__ void ph_ada1(const Params& p, int bid, int nb, char* lds) {
  float* s = (float*)lds;
  for (int item = bid; item < 4 * 24 * 8; item += nb) {
    int ks = item & 7, cb = (item >> 3) % 24, l = item / 192;
    __syncthreads();
    for (int e = tidx(); e < 5 * 128; e += 256) {
      int r = e >> 7, k = (e & 127) + ks * 128;
      float cv = r < 4 ? p.c[r * 1024 + k] : p.c_ctx[k];
      s[e] = silu_f(cv);
    }
    __syncthreads();
    int col = cb * 256 + tidx();
    float a0 = 0.f, a1 = 0.f, a2 = 0.f, a3 = 0.f, a4 = 0.f;
    const float* w = p.ada_w + ((size_t)l * 1024 + ks * 128) * 6144 + col;
    for (int k = 0; k < 128; ++k) {
      float wv = w[(size_t)k * 6144];
      a0 = fmaf(s[k], wv, a0); a1 = fmaf(s[128 + k], wv, a1); a2 = fmaf(s[256 + k], wv, a2); a3 = fmaf(s[384 + k], wv, a3); a4 = fmaf(s[512 + k], wv, a4);
    }
    float* mp = p.modp + ((size_t)(l * 8 + ks) * 5) * 6144 + col;
    mp[0] = a0; mp[6144] = a1; mp[2 * 6144] = a2; mp[3 * 6144] = a3; mp[4 * 6144] = a4;
  }
}
#if !EXACT
__device__ __forceinline__ void conv_dense_weights(const Params& p, int bid, int nb, char* lds) {
  float* tile = (float*)lds;
  const int tid = tidx(), tx = tid & 31, ty = tid >> 5;
  const int tiles_abin = 16 * 96, tiles_about = 16 * 32, tiles_min = 16 * 21, tiles_uq = 6 * 48, tiles_ukv = 4 * 64, tiles_mout = 16 * 32;
  const int per_layer = tiles_abin + tiles_about + tiles_min + tiles_uq + tiles_ukv + tiles_mout;
  for (int item = bid; item < 2 * per_layer; item += nb) {
    const int li = item / per_layer; int t = item % per_layer;
    const float* src; AT* dst; int K, N;
    if (t < tiles_abin) { src = p.ab_w_in + (size_t)li * 1024 * 3072; dst = p.WB + WB_ABIN + (size_t)li * 1024 * 3072; K = 1024; N = 3072; }
    else if ((t -= tiles_abin) < tiles_about) { src = p.ab_w_out + (size_t)li * 1024 * 1024; dst = p.WB + WB_ABOUT + (size_t)li * 1024 * 1024; K = 1024; N = 1024; }
    else if ((t -= tiles_about) < tiles_min) { src = p.mla_w_in + (size_t)li * 1024 * 672; dst = p.WB + WB_MIN + (size_t)li * 1024 * 672; K = 1024; N = 672; }
    else if ((t -= tiles_min) < tiles_uq) { src = p.w_uq + (size_t)li * 384 * 1536; dst = p.WB + WB_UQ + (size_t)li * 384 * 1536; K = 384; N = 1536; }
    else if ((t -= tiles_uq) < tiles_ukv) { src = p.w_ukv + (size_t)li * 256 * 2048; dst = p.WB + WB_UKV + (size_t)li * 256 * 2048; K = 256; N = 2048; }
    else { t -= tiles_ukv; src = p.mla_w_out + (size_t)li * 1024 * 1024; dst = p.WB + WB_MOUT + (size_t)li * 1024 * 1024; K = 1024; N = 1024; }
    const int ntn = N / 32, kt = t / ntn, nt = t % ntn;
    __syncthreads();
#pragma unroll
    for (int i = 0; i < 8; ++i) tile[(ty + 8 * i) * 33 + tx] = src[(size_t)(kt * 64 + ty + 8 * i) * N + nt * 32 + tx];
    __syncthreads();
    {
      const int n = tid >> 3, k8 = (tid & 7) * 8;
      const float* c = tile + k8 * 33 + n;
      u32x4 o;
      o.x = pk2(c[0], c[33]); o.y = pk2(c[2 * 33], c[3 * 33]); o.z = pk2(c[4 * 33], c[5 * 33]); o.w = pk2(c[6 * 33], c[7 * 33]);
      *(u32x4*)(dst + (size_t)(nt * 32 + n) * K + kt * 64 + k8) = o;
    }
  }
}
#endif

#if !EXACT
constexpr size_t WM_GATE = 0, WM_UP = (size_t)128 * 1024 * 512, WM_DOWN = (size_t)2 * 128 * 1024 * 512;
__device__ __forceinline__ void conv_moe_weights(const Params& p, int bid, int nb, char* lds) {
  float* tile = (float*)lds;
  const int tid = tidx();
  const int rk = tid >> 5, rn4 = (tid & 31) * 4;
  const int wn = tid >> 1, wk = (tid & 1) * 64;
  const int NT = 3 * 128 * 32;
  for (int item = bid; item < NT; item += nb) {
    const int tns = item / (128 * 32), rem = item % (128 * 32), mat = rem >> 5, t = rem & 31;
    const float* src; AT* dst; int K, N;
    if (tns == 0) { src = p.w_gate + (size_t)mat * 1024 * 512; dst = p.WM + WM_GATE + (size_t)mat * 1024 * 512; K = 1024; N = 512; }
    else if (tns == 1) { src = p.w_up + (size_t)mat * 1024 * 512; dst = p.WM + WM_UP + (size_t)mat * 1024 * 512; K = 1024; N = 512; }
    else { src = p.w_down + (size_t)mat * 512 * 1024; dst = p.WM + WM_DOWN + (size_t)mat * 512 * 1024; K = 512; N = 1024; }
    const int ntn = N >> 7, kt = t / ntn, nt = t % ntn;
    fx4 v[16];
    const float* q = src + (size_t)(kt * 128 + rk) * N + nt * 128 + rn4;
#pragma unroll
    for (int i = 0; i < 16; ++i) v[i] = *(const fx4*)(q + (size_t)(8 * i) * N);
    __syncthreads();
#pragma unroll
    for (int i = 0; i < 16; ++i) {
      float* t0 = tile + (rk + 8 * i) * 129 + rn4;
      t0[0] = v[i].x; t0[1] = v[i].y; t0[2] = v[i].z; t0[3] = v[i].w;
    }
    __syncthreads();
    AT* d = dst + (size_t)(nt * 128 + wn) * K + kt * 128 + wk;
    const float* c = tile + wk * 129 + wn;
#pragma unroll
    for (int g = 0; g < 8; ++g) {
      u32x4 o;
      o.x = pk2(c[(8 * g + 0) * 129], c[(8 * g + 1) * 129]); o.y = pk2(c[(8 * g + 2) * 129], c[(8 * g + 3) * 129]);
      o.z = pk2(c[(8 * g + 4) * 129], c[(8 * g + 5) * 129]); o.w = pk2(c[(8 * g + 6) * 129], c[(8 * g + 7) * 129]);
      *(u32x4*)(d + 8 * g) = o;
    }
  }
}
#endif
__device__ __forceinline__ void ph_ada2(const Params& p, int bid, int nb) {
  int gtid = bid * 256 + tidx(), gsz = nb * 256;
  for (int i = gtid; i < 4 * 5 * 6144; i += gsz) {
    int l = i / 30720, rem = i % 30720, r = rem / 6144, col = rem % 6144;
    float v = p.ada_b[l * 6144 + col];
    for (int ks = 0; ks < 8; ++ks) v += p.modp[((size_t)(l * 8 + ks) * 5 + r) * 6144 + col];
    p.mod[i] = v;
  }
  for (int i = gtid; i < 4096 * 64; i += gsz) {
    int t = i >> 6, k = i & 63;
    float inv = (float)exp(-(double)(2 * k) / 128.0 * 9.210340371976184);
    float ang = (float)t * inv, sn, cs;
    sincos_acc(ang, sn, cs);
    p.cs1c[i] = cs; p.cs1s[i] = sn;
  }
#if !EXACT
  for (int i = gtid; i < 4 * 128 * 48 * 8; i += gsz) {
    int j = i & 7, n = (i >> 3) % 48, c = (i / 384) & 127, l = i / (384 * 128), k = c * 8 + j;
    float w = n < 4 ? p.grp_w[((size_t)l * 1024 + k) * 4 + n] : (n < 36 ? p.exp_w[((size_t)l * 1024 + k) * 32 + n - 4] : 0.f);
    __hip_bfloat16 hi = __float2bfloat16(w);
    __hip_bfloat16 lo = __float2bfloat16(w - __bfloat162float(hi));
    size_t o = (((size_t)(l * 2 + 0) * 128 + c) * 48 + n) * 8 + j;
    p.WR[o] = *(unsigned short*)&hi;
    p.WR[o + (size_t)128 * 48 * 8] = *(unsigned short*)&lo;
  }
#endif
  for (int i = gtid; i < 4096 * 16; i += gsz) {
    int t = i >> 4, a = i & 15, j = a & 7;
    float inv = (float)exp(-(double)(2 * j) / 16.0 * 9.210340371976184);
    float pos = a < 8 ? (float)(t >> 6) : (float)(t & 63);
    float ang = pos * inv, sn, cs;
    sincos_acc(ang, sn, cs);
    p.cs2c[i] = cs; p.cs2s[i] = sn;
  }
}

__device__ __forceinline__ void ph_T1(const Params& p, int l, int bid, int nb) {
  int wave = tidx() >> 6, lane = tidx() & 63;
  const float* g = p.norm_g + (l * 2 + 0) * 1024;
  for (int tok = bid * 4 + wave; tok < NTOK; tok += nb * 4) {
    int mr = tok_modrow(tok);
    const float* src = (l == 0) ? (tok < NCTX ? p.ctx + (size_t)tok * 1024 : p.x + (size_t)(tok - NCTX) * 1024) : p.X + (size_t)tok * 1024;
    float v[16];
#pragma unroll
    for (int i = 0; i < 4; ++i) { float4 t4 = *(const float4*)(src + i * 256 + lane * 4); v[i * 4] = t4.x; v[i * 4 + 1] = t4.y; v[i * 4 + 2] = t4.z; v[i * 4 + 3] = t4.w; }
    if (l > 0) {
      const float* gm = p.mod + ((size_t)(l - 1) * 5 + mr) * 6144 + 5 * 1024;
      const AT* y0 = p.Y + (size_t)(tok * 2) * 1024; const AT* y1 = y0 + 1024;
#pragma unroll
      for (int i = 0; i < 4; ++i)
#pragma unroll
        for (int cc = 0; cc < 4; ++cc) { int col = i * 256 + lane * 4 + cc; v[i * 4 + cc] += gm[col] * (ldA(y0 + col) + ldA(y1 + col)); }
    }
    float ss = 0.f;
#pragma unroll
    for (int i = 0; i < 16; ++i) ss += v[i] * v[i];
    ss = wave_sum(ss);
    float rstd = rsqrtf(ss * (1.f / 1024.f) + EPSF);
    const float* md = p.mod + ((size_t)l * 5 + mr) * 6144;
#pragma unroll
    for (int i = 0; i < 4; ++i) {
      int col = i * 256 + lane * 4;
      *(float4*)(p.X + (size_t)tok * 1024 + col) = make_float4(v[i * 4], v[i * 4 + 1], v[i * 4 + 2], v[i * 4 + 3]);
#pragma unroll
      for (int cc = 0; cc < 4; ++cc) {
        float h = v[i * 4 + cc] * rstd * g[col + cc] * (1.f + md[1024 + col + cc]) + md[col + cc];
        stA(p.H + (size_t)tok * 1024 + col + cc, h);
      }
    }
  }
}
__device__ __forceinline__ void ph_final(const Params& p, int bid, int nb) {
  int wave = tidx() >> 6, lane = tidx() & 63;
  for (int tok = NCTX + bid * 4 + wave; tok < NTOK; tok += nb * 4) {
    int mr = tok_modrow(tok);
    const float* src = p.X + (size_t)tok * 1024;
    const float* gm = p.mod + ((size_t)3 * 5 + mr) * 6144 + 5 * 1024;
    const AT* y0 = p.Y + (size_t)(tok * 2) * 1024; const AT* y1 = y0 + 1024;
    float v[16];
    float ss = 0.f;
#pragma unroll
    for (int i = 0; i < 4; ++i)
#pragma unroll
      for (int cc = 0; cc < 4; ++cc) { int col = i * 256 + lane * 4 + cc; float t = src[col] + gm[col] * (ldA(y0 + col) + ldA(y1 + col)); v[i * 4 + cc] = t; ss += t * t; }
    ss = wave_sum(ss);
    float rstd = rsqrtf(ss * (1.f / 1024.f) + EPSF);
#pragma unroll
    for (int i = 0; i < 4; ++i) {
      int col = i * 256 + lane * 4;
      *(float4*)(p.out + (size_t)(tok - NCTX) * 1024 + col) = make_float4(v[i * 4] * rstd * p.final_g[col], v[i * 4 + 1] * rstd * p.final_g[col + 1],
                                                                           v[i * 4 + 2] * rstd * p.final_g[col + 2], v[i * 4 + 3] * rstd * p.final_g[col + 3]);
    }
  }
}

#define EPI_BEGIN for (int e_ = tidx(); e_ < 128 * 32; e_ += 256) { const int row = e_ >> 5, c4 = (e_ & 31) << 2; float4 v = *(const float4*)(stage + row * ST_LD + c4);
#define EPI_END }

__device__ __forceinline__ void ph_gemm_store(const Params& p, const AT* A, int lda, const float* W, int K, int N, AT* O, int ldo, int rt0, int bid, int nb, char* lds) {
  float* stage = (float*)lds;
  const int nct = (N + 127) / 128;
  const int nitems = (NRT - rt0) * nct;
  for (int item = bid; item < nitems; item += nb) {
    int ct = item % nct, rt = rt0 + item / nct;
    engine(lds, K,
           [&](int r, int k) { return ldA(A + (size_t)(rt * 128 + r) * lda + k); },
           [&](int k, int c) { int col = ct * 128 + c; return col < N ? W[(size_t)k * N + col] : 0.f; });
    EPI_BEGIN
      int col = ct * 128 + c4;
      if (col < N) stA4(O + (size_t)(rt * 128 + row) * ldo + col, v);
    EPI_END
  }
}
__device__ __forceinline__ void ph_gemm_resid(const Params& p, int l, const AT* A, const float* W, int rt0, int bid, int nb, char* lds) {
  float* stage = (float*)lds;
  const int nitems = (NRT - rt0) * 8;
  for (int item = bid; item < nitems; item += nb) {
    int ct = item & 7, rt = rt0 + (item >> 3);
    engine(lds, 1024,
           [&](int r, int k) { return ldA(A + (size_t)(rt * 128 + r) * 1024 + k); },
           [&](int k, int c) { return W[(size_t)k * 1024 + ct * 128 + c]; });
    int mr = tok_modrow(rt * 128);
    const float* gm = p.mod + ((size_t)l * 5 + mr) * 6144 + 2 * 1024 + ct * 128;
    EPI_BEGIN
      float* xp = p.X + (size_t)(rt * 128 + row) * 1024 + ct * 128 + c4;
      float4 xv = *(float4*)xp;
      xv.x += gm[c4] * v.x; xv.y += gm[c4 + 1] * v.y; xv.z += gm[c4 + 2] * v.z; xv.w += gm[c4 + 3] * v.w;
      *(float4*)xp = xv;
    EPI_END
  }
}

struct RetCtx { const AT* proj; const float* cc; const float* ss; int tok0; int t0; bool lat; int h; };
__device__ __forceinline__ float ret_rot(const RetCtx& r, int off, int j, int d) {
  const AT* base = r.proj + (size_t)(r.tok0 + j) * 3072 + off + r.h * 128;
#if !EXACT
  return ldA(base + d);
#endif
  if (!r.lat) return ldA(base + d);
  int i = d & 63;
  float x1 = ldA(base + i), x2 = ldA(base + 64 + i);
  float cs = r.cc[(r.t0 + j) * 64 + i], sn = r.ss[(r.t0 + j) * 64 + i];
  return d < 64 ? x1 * cs - x2 * sn : x1 * sn + x2 * cs;
}
__device__ __forceinline__ float ret_v(const RetCtx& r, int m, int e) { return ldA(r.proj + (size_t)(r.tok0 + m) * 3072 + 1024 + r.h * 128 + e); }

__device__ __forceinline__ void ph_R1(const Params& p, int l, int bid, int nb, char* lds) {
  const int li = l >> 1;
  float* stage = (float*)lds;
  const int NRET = NBAT * 4 * NCH;
  const int NLRU = NBAT * NCH * 8;
  for (int item = bid; item < NRET + NLRU; item += nb) {
    if (item < NRET) {
      int c = item % NCH, bh = item / NCH, h = bh & 3, b = bh >> 2;
      RetCtx rc{p.PROJ, p.cs1c, p.cs1s, chunk_tok0(b, c), (c - 2) * 128, c >= 2, h};
      for (int d = 0; d < 2; ++d) {
        float lg = -softplus_f(-p.ret_decay[(li * 2 + d) * 4 + h]);
        engine(lds, 128,
               [&](int r, int k) { float z = d == 0 ? expf(lg * (float)(127 - k)) : expf(lg * (float)k); return ret_rot(rc, 512, k, r) * KSCALE * z; },
               [&](int k, int cc) { return ret_v(rc, k, cc); });
        float* U = p.U + ((size_t)((b * 4 + h) * 2 + d) * NCH + c) * 16384;
        EPI_BEGIN
          *(float4*)(U + row * 128 + c4) = v;
        EPI_END
      }
    } else {
      int it = item - NRET;
      int kb = it & 7, c = (it >> 3) % NCH, b = it / (8 * NCH);
      float* us = (float*)lds;
      float* Wl = us + 128 * 64;
      int tok0 = chunk_tok0(b, c);
      int seqbase = c < 2 ? b * CTXL : NCTX + b * SEQ;
      int n = c < 2 ? CTXL : SEQ;
      int t0 = tok0 - seqbase;
      __syncthreads();
      for (int e = tidx(); e < 128 * 64; e += 256) {
        int pos = e >> 6, i = e & 63, ch = kb * 64 + i, t = t0 + pos;
        float acc = p.conv_b[li * 512 + ch];
#pragma unroll
        for (int tap = 0; tap < 4; ++tap) {
          int tt = t + tap - 2;
          if (tt >= 0 && tt < n) acc += p.conv_w[(li * 4 + tap) * 512 + ch] * ldA(p.PROJ + (size_t)(seqbase + tt) * 3072 + 2048 + ch);
        }
        us[e] = acc;
      }
      for (int e = tidx(); e < 4 * 4096; e += 256) {
        int dg = e >> 12, i = (e >> 6) & 63, j = e & 63, d = dg >> 1, g = dg & 1;
        Wl[e] = p.gate_w[((size_t)(((li * 2 + d) * 2 + g) * 8 + kb) * 64 + i) * 64 + j];
      }
      __syncthreads();
      if (tidx() < 128) {
        int d = tidx() >> 6, j = tidx() & 63, ch = kb * 64 + j;
        float sp = softplus_f(-p.lam[(li * 2 + d) * 512 + ch]);
        float br = p.gate_b[((li * 2 + d) * 2 + 0) * 512 + ch], bi = p.gate_b[((li * 2 + d) * 2 + 1) * 512 + ch];
        float h = 0.f, A = 1.f;
        const float* Wr = Wl + (d * 2 + 0) * 4096 + j;
        const float* Wi = Wl + (d * 2 + 1) * 4096 + j;
        for (int s = 0; s < 128; ++s) {
          int pos = d ? 127 - s : s;
          float r = br, ig = bi;
          const float* up = us + pos * 64;
#pragma unroll 8
          for (int i = 0; i < 64; ++i) { float uv = up[i]; r = fmaf(uv, Wr[i * 64], r); ig = fmaf(uv, Wi[i * 64], ig); }
          r = sigmoid_f(r); ig = sigmoid_f(ig);
          float la = -8.f * r * sp;
          float a = expf(la);
          float bt = sqrtf(-expm1f(2.f * la)) * (ig * up[j]);
          h = fmaf(a, h, bt); A *= a;
          size_t o = ((size_t)d * NTOK + tok0 + pos) * 512 + ch;
          p.HL[o] = h; p.AC[o] = A;
        }
        p.CHA[((d * 4 + b) * NCH + c) * 512 + ch] = A;
        p.CHH[((d * 4 + b) * NCH + c) * 512 + ch] = h;
      }
      __syncthreads();
    }
  }
}
__device__ __forceinline__ void ph_R2(const Params& p, int l, int bid, int nb) {
  const int li = l >> 1;
  int gtid = bid * 256 + tidx(), gsz = nb * 256;
  for (int i = gtid; i < 32 * 16384; i += gsz) {
    int el = i & 16383, bhd = i >> 14, d = bhd & 1, h = (bhd >> 1) & 3;
    float lg = -softplus_f(-p.ret_decay[(li * 2 + d) * 4 + h]);
    float dec = expf(lg * 128.f);
    float* base = p.U + (size_t)bhd * NCH * 16384 + el;
    float S = 0.f;
    for (int idx = 0; idx < NCH; ++idx) {
      int c = d == 0 ? idx : (idx < 2 ? 1 - idx : 35 - idx);
      float u = base[(size_t)c * 16384];
      base[(size_t)c * 16384] = S;
      S = fmaf(dec, S, u);
    }
  }
  for (int i = gtid; i < 2 * 4 * 512; i += gsz) {
    int ch = i & 511, db = i >> 9, d = db >> 2;
    float carry = 0.f;
    for (int idx = 0; idx < NCH; ++idx) {
      int c = d == 0 ? idx : (idx < 2 ? 1 - idx : 35 - idx);
      size_t o = ((size_t)db * NCH + c) * 512 + ch;
      p.CAR[o] = carry;
      carry = fmaf(p.CHA[o], carry, p.CHH[o]);
    }
  }
}
__device__ __forceinline__ void ph_R3(const Params& p, int l, int bid, int nb, char* lds) {
  const int li = l >> 1;
  float* stage = (float*)lds;
  const int NRET = NBAT * 4 * NCH;
  float* scr = p.SCR + (size_t)bid * 16384;
  for (int item = bid; item < NRET + NRT; item += nb) {
    if (item < NRET) {
      int c = item % NCH, bh = item / NCH, h = bh & 3, b = bh >> 2;
      RetCtx rc{p.PROJ, p.cs1c, p.cs1s, chunk_tok0(b, c), (c - 2) * 128, c >= 2, h};
      float lg0 = -softplus_f(-p.ret_decay[(li * 2 + 0) * 4 + h]);
      float lg1 = -softplus_f(-p.ret_decay[(li * 2 + 1) * 4 + h]);
      engine(lds, 128,
             [&](int r, int k) { return ret_rot(rc, 0, r, k); },
             [&](int k, int cc) { return ret_rot(rc, 512, cc, k) * KSCALE; });
      EPI_BEGIN
        float o4[4] = {v.x, v.y, v.z, v.w};
#pragma unroll
        for (int q = 0; q < 4; ++q) {
          int m = c4 + q;
          float M = row > m ? expf(lg0 * (float)(row - m)) : (row < m ? expf(lg1 * (float)(m - row)) : 2.f);
          scr[row * 128 + m] = o4[q] * M;
        }
      EPI_END
      __syncthreads();
      const float* S0 = p.U + ((size_t)((b * 4 + h) * 2 + 0) * NCH + c) * 16384;
      const float* S1 = p.U + ((size_t)((b * 4 + h) * 2 + 1) * NCH + c) * 16384;
      engine(lds, 384,
             [&](int r, int k) {
               if (k < 128) return scr[r * 128 + k];
               if (k < 256) return ret_rot(rc, 0, r, k - 128) * expf(lg0 * (float)(r + 1));
               return ret_rot(rc, 0, r, k - 256) * expf(lg1 * (float)(128 - r));
             },
             [&](int k, int cc) {
               if (k < 128) return ret_v(rc, k, cc);
               if (k < 256) return S0[(k - 128) * 128 + cc];
               return S1[(k - 256) * 128 + cc];
             });
      EPI_BEGIN
        float ss = v.x * v.x + v.y * v.y + v.z * v.z + v.w * v.w;
        ss = half_sum(ss);
        float rs = rsqrtf(ss * (1.f / 128.f) + EPSF);
        int tok = rc.tok0 + row;
        const AT* gp = p.PROJ + (size_t)tok * 3072 + 1536 + h * 128 + c4;
        float4 o = make_float4(v.x * rs * silu_f(ldA(gp)), v.y * rs * silu_f(ldA(gp + 1)), v.z * rs * silu_f(ldA(gp + 2)), v.w * rs * silu_f(ldA(gp + 3)));
        stA4(p.MIX + (size_t)tok * 1024 + h * 128 + c4, o);
      EPI_END
      __syncthreads();
    } else {
      int rt = item - NRET, b, c;
      rt_to_bc(rt, b, c);
      for (int e = tidx(); e < 128 * 512; e += 256) {
        int pos = e >> 9, ch = e & 511, tok = rt * 128 + pos;
        size_t o0 = ((size_t)0 * NTOK + tok) * 512 + ch, o1 = ((size_t)1 * NTOK + tok) * 512 + ch;
        float hf = p.HL[o0] + p.AC[o0] * p.CAR[((0 * 4 + b) * NCH + c) * 512 + ch];
        float hb = p.HL[o1] + p.AC[o1] * p.CAR[((1 * 4 + b) * NCH + c) * 512 + ch];
        float y = ldA(p.PROJ + (size_t)tok * 3072 + 2560 + ch);
        stA(p.MIX + (size_t)tok * 1024 + 512 + ch, (hf + hb) * gelu_tanh(y));
      }
    }
  }
}

__device__ __forceinline__ void ph_T2(const Params& p, int l, int bid, int nb, char* lds) {
  int wave = tidx() >> 6, lane = tidx() & 63;
  float* lg = (float*)(lds) + wave * 64;
  const float* g = p.norm_g + (l * 2 + 1) * 1024;
  const float* gw = p.grp_w + (size_t)l * 1024 * 4;
  const float* ew = p.exp_w + (size_t)l * 1024 * 32;
  const int gbeg = (l == 3) ? NCTX / 16 : 0;
  for (int grp = gbeg + bid; grp < NTOK / 16; grp += nb)
  for (int k4 = 0; k4 < 4; ++k4) {
    const int tok = grp * 16 + wave * 4 + k4;
    int mr = tok_modrow(tok);
    const float* src = p.X + (size_t)tok * 1024;
    const float* md = p.mod + ((size_t)l * 5 + mr) * 6144;
    float ss = 0.f;
#pragma unroll
    for (int i = 0; i < 4; ++i) { float4 t4 = *(const float4*)(src + i * 256 + lane * 4); ss += t4.x * t4.x + t4.y * t4.y + t4.z * t4.z + t4.w * t4.w; }
    ss = wave_sum(ss);
    float rstd = rsqrtf(ss * (1.f / 1024.f) + EPSF);
    float part[36];
#pragma unroll
    for (int j = 0; j < 36; ++j) part[j] = 0.f;
#pragma unroll 1
    for (int q = 0; q < 16; ++q) {
      int col = (q >> 2) * 256 + lane * 4 + (q & 3);
      float h = src[col] * rstd * g[col] * (1.f + md[4 * 1024 + col]) + md[3 * 1024 + col];
      stA(p.H + (size_t)tok * 1024 + col, h);
      float4 gv = *(const float4*)(gw + col * 4);
      part[0] = fmaf(h, gv.x, part[0]); part[1] = fmaf(h, gv.y, part[1]); part[2] = fmaf(h, gv.z, part[2]); part[3] = fmaf(h, gv.w, part[3]);
      const float4* ep = (const float4*)(ew + col * 32);
#pragma unroll
      for (int qq = 0; qq < 8; ++qq) { float4 e4 = ep[qq]; part[4 + qq * 4] = fmaf(h, e4.x, part[4 + qq * 4]); part[5 + qq * 4] = fmaf(h, e4.y, part[5 + qq * 4]); part[6 + qq * 4] = fmaf(h, e4.z, part[6 + qq * 4]); part[7 + qq * 4] = fmaf(h, e4.w, part[7 + qq * 4]); }
    }
#pragma unroll
    for (int j = 0; j < 36; ++j) { float t = wave_sum(part[j]); if (lane == 0) lg[j] = t; }
    if (lane == 0) {
      const float* gb = p.grp_b + l * 4;
      int gs = 0; float gm = lg[0] + gb[0];
      for (int j = 1; j < 4; ++j) { float t = lg[j] + gb[j]; if (t > gm) { gm = t; gs = j; } }
      float gsum = 0.f;
      for (int j = 0; j < 4; ++j) gsum += expf(lg[j] + gb[j] - gm);
      float gtop = 1.f / gsum;
      const float* wlp = lg + 4 + gs * 8;
      const float* eb = p.exp_b + l * 32 + gs * 8;
      int i0 = 0; float m0 = wlp[0] + eb[0];
      for (int j = 1; j < 8; ++j) { float t = wlp[j] + eb[j]; if (t > m0) { m0 = t; i0 = j; } }
      int i1 = -1; float m1 = -3.4e38f;
      for (int j = 0; j < 8; ++j) { float t = wlp[j] + eb[j]; if (j != i0 && t > m1) { m1 = t; i1 = j; } }
      float e1 = expf(m1 - m0);
      float p0 = 1.f / (1.f + e1), p1 = e1 / (1.f + e1);
      int ex0 = gs * 8 + i0, ex1 = gs * 8 + i1;
      p.re[tok * 2] = ex0; p.re[tok * 2 + 1] = ex1;
      p.rw[tok * 2] = gtop * p0; p.rw[tok * 2 + 1] = gtop * p1;

    }
  }
}

__device__ __forceinline__ void ph_RB(const Params& p, int l, int bid, int nb, char* lds) {
  int* sc = (int*)lds;
  const int tid = tidx(), lane = tid & 63, wid = tid >> 6;
  const int abeg = (l == 3) ? 2 * NCTX : 0;
  constexpr int PER = 136;
  for (int e = bid; e < 32; e += nb) {
    const int a0 = tid * PER;
    const int4* src = (const int4*)(p.re + a0);
    int c = 0;
    if (a0 + PER > abeg) {
#pragma unroll 34
      for (int i = 0; i < PER / 4; ++i) {
        const int4 q = src[i]; const int a = a0 + 4 * i;
        c += (q.x == e && a >= abeg) + (q.y == e && a + 1 >= abeg) + (q.z == e && a + 2 >= abeg) + (q.w == e && a + 3 >= abeg);
      }
    }
    int inc = c;
#pragma unroll
    for (int o = 1; o < 64; o <<= 1) { int t = __shfl_up(inc, o); if (lane >= o) inc += t; }
    __syncthreads();
    if (lane == 63) sc[wid] = inc;
    __syncthreads();
    int woff = 0;
    for (int w = 0; w < wid; ++w) woff += sc[w];
    const int total = sc[0] + sc[1] + sc[2] + sc[3];
    int o = woff + inc - c;
    int* lst = p.list + (size_t)e * NTOK;
    if (c > 0) {
#pragma unroll 17
      for (int i = 0; i < PER / 4; ++i) {
        const int4 q = src[i]; const int a = a0 + 4 * i;
        if (q.x == e && a >= abeg) lst[o++] = a;
        if (q.y == e && a + 1 >= abeg) lst[o++] = a + 1;
        if (q.z == e && a + 2 >= abeg) lst[o++] = a + 2;
        if (q.w == e && a + 3 >= abeg) lst[o++] = a + 3;
      }
    }
    if (tid == 0) p.cnt[(l * 32 + e) * 32] = total;
  }
}
__device__ __forceinline__ void moe_setup(const Params& p, int l, int* si) {
  __syncthreads();
  if (tidx() < 32) si[tidx()] = p.cnt[(l * 32 + tidx()) * 32];
  __syncthreads();
  if (tidx() == 0) {
    int b = 0, k = 0;
    for (int e = 0; e < 32; ++e) { si[32 + e] = b; si[65 + e] = k; b += si[e]; k += (si[e] + 127) >> 7; }
    si[64] = b; si[97] = k;
  }
  __syncthreads();
}
__device__ __forceinline__ void ph_E1(const Params& p, int l, int bid, int nb, char* lds) {
  float* stage = (float*)lds;
  int* si = (int*)(lds + MISC_OFF);
  moe_setup(p, l, si);
  const int nblk = si[97];
  for (int item = bid; item < nblk * 8; item += nb) {
    int nt = item & 7, bi = item >> 3;
    int e = 0;
    while (e < 31 && si[65 + e + 1] <= bi) ++e;
    int rb = bi - si[65 + e], cnt = si[e], base = si[32 + e];
    const int* lst = p.list + (size_t)e * NTOK + rb * 128;
    int nrow = cnt - rb * 128; if (nrow > 128) nrow = 128;
    const float* wg = p.w_gate + ((size_t)(l * 32 + e) * 1024) * 512 + nt * 64;
    const float* wu = p.w_up + ((size_t)(l * 32 + e) * 1024) * 512 + nt * 64;
    engine(lds, 1024,
           [&](int r, int k) { return r < nrow ? ldA(p.H + (size_t)(lst[r] >> 1) * 1024 + k) : 0.f; },
           [&](int k, int c) { return c < 64 ? wg[(size_t)k * 512 + c] : wu[(size_t)k * 512 + c - 64]; });
    for (int e_ = tidx(); e_ < 128 * 16; e_ += 256) {
      int row = e_ >> 4, c4 = (e_ & 15) << 2;
      if (row < nrow) {
        float4 gv = *(const float4*)(stage + row * ST_LD + c4), uv = *(const float4*)(stage + row * ST_LD + 64 + c4);
        float4 o = make_float4(silu_f(gv.x) * uv.x, silu_f(gv.y) * uv.y, silu_f(gv.z) * uv.z, silu_f(gv.w) * uv.w);
        stA4(p.HB + (size_t)(base + rb * 128 + row) * 512 + nt * 64 + c4, o);
      }
    }
  }
}
__device__ __forceinline__ void ph_E2(const Params& p, int l, int bid, int nb, char* lds) {
  float* stage = (float*)lds;
  int* si = (int*)(lds + MISC_OFF);
  moe_setup(p, l, si);
  const int nblk = si[97];
  for (int item = bid; item < nblk * 8; item += nb) {
    int ct = item & 7, bi = item >> 3;
    int e = 0;
    while (e < 31 && si[65 + e + 1] <= bi) ++e;
    int rb = bi - si[65 + e], cnt = si[e], base = si[32 + e];
    const int* lst = p.list + (size_t)e * NTOK + rb * 128;
    int nrow = cnt - rb * 128; if (nrow > 128) nrow = 128;
    const float* wd = p.w_down + ((size_t)(l * 32 + e) * 512) * 1024 + ct * 128;
    const AT* hb = p.HB + (size_t)(base + rb * 128) * 512;
    engine(lds, 512,
           [&](int r, int k) { return r < nrow ? ldA(hb + (size_t)r * 512 + k) : 0.f; },
           [&](int k, int c) { return wd[(size_t)k * 1024 + c]; });
    EPI_BEGIN
      if (row < nrow) {
        int a = lst[row];
        float w = p.rw[a];
        stA4(p.Y + (size_t)a * 1024 + ct * 128 + c4, make_float4(v.x * w, v.y * w, v.z * w, v.w * w));
      }
    EPI_END
  }
}

__device__ __forceinline__ void ph_MN(const Params& p, int l, int bid, int nb) {
  int wave = tidx() >> 6, lane = tidx() & 63;
  for (int grp = bid; grp < NTOK / 32; grp += nb)
#pragma unroll 4
  for (int k8 = 0; k8 < 8; ++k8) {
    const int tok = grp * 32 + wave * 8 + k8;
    const AT* pr = p.PROJ + (size_t)tok * P1LD;
    float sq = 0.f, skv = 0.f;
#pragma unroll
    for (int i = 0; i < 6; ++i) { float t = ldA(pr + i * 64 + lane); sq += t * t; }
#pragma unroll
    for (int i = 0; i < 4; ++i) { float t = ldA(pr + 384 + i * 64 + lane); skv += t * t; }
    sq = wave_sum(sq); skv = wave_sum(skv);
#if EXACT
    if (lane == 0) { p.RQ[tok] = rsqrtf(sq * (1.f / 384.f) + EPSF); p.RKV[tok] = rsqrtf(skv * (1.f / 256.f) + EPSF); }
#else
    {
      const float rq = rsqrtf(sq * (1.f / 384.f) + EPSF), rkv = rsqrtf(skv * (1.f / 256.f) + EPSF);
      const float* qg = p.q_g + (l >> 1) * 384; const float* kvg = p.kv_g + (l >> 1) * 256;
      AT* pw = p.PROJ + (size_t)tok * P1LD;
#pragma unroll
      for (int i = 0; i < 6; ++i) { int k = i * 64 + lane; stA(pw + k, ldA(pr + k) * rq * qg[k]); }
#pragma unroll
      for (int i = 0; i < 4; ++i) { int k = i * 64 + lane; stA(pw + 384 + k, ldA(pr + 384 + k) * rkv * kvg[k]); }
    }
#endif
    float kr = lane < 32 ? ldA(pr + 640 + lane) : 0.f;
    float other = __shfl_xor(kr, 16);
    int b, kpos; float outv = kr;
    if (tok < NCTX) { b = tok >> 8; kpos = tok & 255; }
    else {
      int t = (tok - NCTX) & 4095; b = (tok - NCTX) >> 12; kpos = CTXL + t;
      int i = lane & 15;
      float cs = p.cs2c[t * 16 + i], sn = p.cs2s[t * 16 + i];
      outv = (lane & 16) ? (other * sn + kr * cs) : (kr * cs - other * sn);
    }
#if EXACT
    if (lane < 32) {
      for (int h = 0; h < 16; ++h) stA(p.Kb + ((size_t)(b * 16 + h) * KVL + kpos) * 96 + 64 + lane, outv);
    }
#else
    if (lane < 32) stA(p.KR + (size_t)tok * 32 + lane, outv);
#endif
    (void)b; (void)kpos;
  }
}
__device__ __forceinline__ void ph_M2(const Params& p, int l, int bid, int nb, char* lds) {
  const int li = l >> 1;
  float* stage = (float*)lds;
  const float* wq = p.w_uq + (size_t)li * 384 * 1536;
  const float* wkv = p.w_ukv + (size_t)li * 256 * 2048;
  const float* qg = p.q_g + li * 384;
  const float* kvg = p.kv_g + li * 256;
  const int NQ = NRT * 12, NKV = NRT * 16;
  for (int item = bid; item < NQ + NKV; item += nb) {
    if (item < NQ) {
      int ct = item % 12, rt = item / 12;
      engine(lds, 384,
             [&](int r, int k) { int tok = rt * 128 + r; return ldA(p.PROJ + (size_t)tok * P1LD + k) * p.RQ[tok] * qg[k]; },
             [&](int k, int c) { return wq[(size_t)k * 1536 + ct * 128 + c]; });
      EPI_BEGIN
        int tok = rt * 128 + row, col = ct * 128 + c4, head = col / 96, d = col % 96;
        AT* dst = p.Ql + (size_t)tok * QLD + head * 96 + d;
        stA4(dst, v);
      EPI_END
    } else {
      int it = item - NQ, h = it & 15, rt = it >> 4;
      engine(lds, 256,
             [&](int r, int k) { int tok = rt * 128 + r; return ldA(p.PROJ + (size_t)tok * P1LD + 384 + k) * p.RKV[tok] * kvg[k]; },
             [&](int k, int c) { return wkv[(size_t)k * 2048 + h * 128 + c]; });
      EPI_BEGIN
        int tok = rt * 128 + row, b, kpos;
        if (tok < NCTX) { b = tok >> 8; kpos = tok & 255; } else { int tt = tok - NCTX; b = tt >> 12; kpos = CTXL + (tt & 4095); }
        if (c4 < 64) stA4(p.Kb + ((size_t)(b * 16 + h) * KVL + kpos) * 96 + c4, v);
        else stA4(p.Vb + ((size_t)(b * 16 + h) * KVL + kpos) * 64 + c4 - 64, v);
      EPI_END
    }
  }
}
__device__ __forceinline__ void ph_ATT(const Params& p, int l, int bid, int nb, char* lds) {
  float* Ks = (float*)lds;
  float* Vs = Ks + 64 * 97;
  float* Qs = Vs + 64 * 64;
  const int wave = tidx() >> 6, lane = tidx() & 63;
  const int NLAT = NBAT * 16 * 64, NCT = (l == 1) ? NBAT * 16 * 4 : 0;
  const float scale = 0.10206207261596577f;
  for (int item = bid; item < NLAT + NCT; item += nb) {
    bool lat = item < NLAT;
    int qb, bh, nkeys;
    if (lat) { qb = item & 63; bh = item >> 6; nkeys = KVL; } else { int it = item - NLAT; qb = it & 3; bh = it >> 2; nkeys = CTXL; }
    int b = bh >> 4, h = bh & 15;
    const AT* Q = p.Ql + (size_t)(lat ? NCTX + b * SEQ + qb * 64 : b * CTXL + qb * 64) * QLD + h * 96;
    __syncthreads();
    for (int e = tidx(); e < 64 * 96; e += 256) {
      int r = e / 96, d = e % 96;
      float val;
      if (lat && d >= 64) {
        int t = qb * 64 + r, i = (d - 64) & 15;
        float x1 = ldA(Q + (size_t)r * QLD + 64 + i), x2 = ldA(Q + (size_t)r * QLD + 80 + i);
        float cs = p.cs2c[t * 16 + i], sn = p.cs2s[t * 16 + i];
        val = d < 80 ? x1 * cs - x2 * sn : x1 * sn + x2 * cs;
      } else val = ldA(Q + (size_t)r * QLD + d);
      Qs[e] = val * scale;
    }
    float* Os = Qs + 64 * 96;
    float* Ms = Os + 64 * 64;
    float* Ls = Ms + 64;
    for (int e = tidx(); e < 64 * 64; e += 256) Os[e] = 0.f;
    if (tidx() < 64) { Ms[tidx()] = -3.0e38f; Ls[tidx()] = 0.f; }
    const AT* Kg = p.Kb + (size_t)bh * KVL * 96;
    const AT* Vg = p.Vb + (size_t)bh * KVL * 64;
    for (int kt = 0; kt < nkeys; kt += 64) {
      __syncthreads();
      for (int e = tidx(); e < 64 * 96; e += 256) { int r = e / 96, d = e % 96; Ks[r * 97 + d] = ldA(Kg + (size_t)(kt + r) * 96 + d); }
      for (int e = tidx(); e < 64 * 64; e += 256) Vs[e] = ldA(Vg + (size_t)kt * 64 + e);
      __syncthreads();
#pragma unroll 1
      for (int g = 0; g < 4; ++g) {
        float s0 = 0.f, s1 = 0.f, s2 = 0.f, s3 = 0.f;
        const int q0 = wave * 16 + g * 4;
        const float* qp = Qs + q0 * 96;
        for (int d = 0; d < 96; ++d) {
          float kv = Ks[lane * 97 + d];
          s0 = fmaf(qp[d], kv, s0); s1 = fmaf(qp[96 + d], kv, s1); s2 = fmaf(qp[192 + d], kv, s2); s3 = fmaf(qp[288 + d], kv, s3);
        }
        float p0, p1, p2, p3, o0, o1, o2, o3;
#define ATT_ROW(SI, PI, OI, I) { float mold = Ms[q0 + I]; float mx = wave_max(SI); float mn = fmaxf(mold, mx); float alpha = expf(mold - mn); \
          PI = expf(SI - mn); float sm = wave_sum(PI); OI = Os[(q0 + I) * 64 + lane] * alpha; if (lane == 0) { Ls[q0 + I] = Ls[q0 + I] * alpha + sm; Ms[q0 + I] = mn; } }
        ATT_ROW(s0, p0, o0, 0) ATT_ROW(s1, p1, o1, 1) ATT_ROW(s2, p2, o2, 2) ATT_ROW(s3, p3, o3, 3)
        for (int j = 0; j < 64; ++j) {
          float vv = Vs[j * 64 + lane];
          o0 = fmaf(__int_as_float(__builtin_amdgcn_readlane(__float_as_int(p0), j)), vv, o0);
          o1 = fmaf(__int_as_float(__builtin_amdgcn_readlane(__float_as_int(p1), j)), vv, o1);
          o2 = fmaf(__int_as_float(__builtin_amdgcn_readlane(__float_as_int(p2), j)), vv, o2);
          o3 = fmaf(__int_as_float(__builtin_amdgcn_readlane(__float_as_int(p3), j)), vv, o3);
        }
        Os[(q0 + 0) * 64 + lane] = o0; Os[(q0 + 1) * 64 + lane] = o1; Os[(q0 + 2) * 64 + lane] = o2; Os[(q0 + 3) * 64 + lane] = o3;
      }
    }
    __syncthreads();
    for (int qi = 0; qi < 16; ++qi) {
      int r = qb * 64 + wave * 16 + qi;
      int tok = lat ? NCTX + b * SEQ + r : b * CTXL + r;
      stA(p.MIX + (size_t)tok * 1024 + h * 64 + lane, Os[(wave * 16 + qi) * 64 + lane] / Ls[wave * 16 + qi]);
    }
  }
}


#if !EXACT
__device__ __forceinline__ void ph_T1_f(const Params& p, int l, int bid, int nb) {
  const int wave = tidx() >> 6, lane = tidx() & 63;
  const float* g = p.norm_g + (l * 2 + 0) * 1024;
  for (int pair = bid * 4 + wave; pair < NTOK / 2; pair += nb * 4) {
    float v[2][16];
    int mrs[2];
#pragma unroll
    for (int u = 0; u < 2; ++u) {
      const int tok = pair * 2 + u;
      const int mr = tok_modrow(tok); mrs[u] = mr;
      const float* src = (l == 0) ? (tok < NCTX ? p.ctx + (size_t)tok * 1024 : p.x + (size_t)(tok - NCTX) * 1024) : p.X + (size_t)tok * 1024;
#pragma unroll
      for (int i = 0; i < 4; ++i) { const fx4 t4 = *(const fx4*)(src + i * 256 + lane * 4); v[u][i * 4] = t4.x; v[u][i * 4 + 1] = t4.y; v[u][i * 4 + 2] = t4.z; v[u][i * 4 + 3] = t4.w; }
      if (l > 0) {
        const float* gm = p.mod + ((size_t)(l - 1) * 5 + mr) * 6144 + 5 * 1024;
        const AT* y0 = p.Y + (size_t)(tok * 2) * 1024;
#pragma unroll
        for (int i = 0; i < 4; ++i) {
          const int col = i * 256 + lane * 4;
          const u32x2 a = *(const u32x2*)(y0 + col), b = *(const u32x2*)(y0 + 1024 + col);
          const fx4 gg = *(const fx4*)(gm + col);
          v[u][i * 4 + 0] += gg.x * (bf_lo(a.x) + bf_lo(b.x)); v[u][i * 4 + 1] += gg.y * (bf_hi(a.x) + bf_hi(b.x));
          v[u][i * 4 + 2] += gg.z * (bf_lo(a.y) + bf_lo(b.y)); v[u][i * 4 + 3] += gg.w * (bf_hi(a.y) + bf_hi(b.y));
        }
      }
    }
#pragma unroll
    for (int u = 0; u < 2; ++u) {
      const int tok = pair * 2 + u;
      float ss = 0.f;
#pragma unroll
      for (int i = 0; i < 16; ++i) ss += v[u][i] * v[u][i];
      ss = wave_sum(ss);
      const float rstd = rsqrtf(ss * (1.f / 1024.f) + EPSF);
      const float* md = p.mod + ((size_t)l * 5 + mrs[u]) * 6144;
#pragma unroll
      for (int i = 0; i < 4; ++i) {
        const int col = i * 256 + lane * 4;
        fx4 xo = {v[u][i * 4], v[u][i * 4 + 1], v[u][i * 4 + 2], v[u][i * 4 + 3]};
        *(fx4*)(p.X + (size_t)tok * 1024 + col) = xo;
        const fx4 gg = *(const fx4*)(g + col), sc = *(const fx4*)(md + 1024 + col), sh = *(const fx4*)(md + col);
        u32x2 o;
        o.x = pk2(xo.x * rstd * gg.x * (1.f + sc.x) + sh.x, xo.y * rstd * gg.y * (1.f + sc.y) + sh.y);
        o.y = pk2(xo.z * rstd * gg.z * (1.f + sc.z) + sh.z, xo.w * rstd * gg.w * (1.f + sc.w) + sh.w);
        *(u32x2*)(p.H + (size_t)tok * 1024 + col) = o;
      }
    }
  }
}
__device__ __forceinline__ void ph_final_f(const Params& p, int bid, int nb) {
  const int wave = tidx() >> 6, lane = tidx() & 63;
  for (int pair = NCTX / 2 + bid * 4 + wave; pair < NTOK / 2; pair += nb * 4) {
    float v[2][16];
#pragma unroll
    for (int u = 0; u < 2; ++u) {
      const int tok = pair * 2 + u;
      const int mr = tok_modrow(tok);
      const float* src = p.X + (size_t)tok * 1024;
      const float* gm = p.mod + ((size_t)3 * 5 + mr) * 6144 + 5 * 1024;
      const AT* y0 = p.Y + (size_t)(tok * 2) * 1024;
#pragma unroll
      for (int i = 0; i < 4; ++i) {
        const int col = i * 256 + lane * 4;
        const fx4 t4 = *(const fx4*)(src + col);
        const u32x2 a = *(const u32x2*)(y0 + col), b = *(const u32x2*)(y0 + 1024 + col);
        const fx4 gg = *(const fx4*)(gm + col);
        v[u][i * 4 + 0] = t4.x + gg.x * (bf_lo(a.x) + bf_lo(b.x)); v[u][i * 4 + 1] = t4.y + gg.y * (bf_hi(a.x) + bf_hi(b.x));
        v[u][i * 4 + 2] = t4.z + gg.z * (bf_lo(a.y) + bf_lo(b.y)); v[u][i * 4 + 3] = t4.w + gg.w * (bf_hi(a.y) + bf_hi(b.y));
      }
    }
#pragma unroll
    for (int u = 0; u < 2; ++u) {
      const int tok = pair * 2 + u;
      float ss = 0.f;
#pragma unroll
      for (int i = 0; i < 16; ++i) ss += v[u][i] * v[u][i];
      ss = wave_sum(ss);
      const float rstd = rsqrtf(ss * (1.f / 1024.f) + EPSF);
#pragma unroll
      for (int i = 0; i < 4; ++i) {
        const int col = i * 256 + lane * 4;
        const fx4 fg = *(const fx4*)(p.final_g + col);
        fx4 o = {v[u][i * 4] * rstd * fg.x, v[u][i * 4 + 1] * rstd * fg.y, v[u][i * 4 + 2] * rstd * fg.z, v[u][i * 4 + 3] * rstd * fg.w};
        *(fx4*)(p.out + (size_t)(tok - NCTX) * 1024 + col) = o;
      }
    }
  }
}
#endif
#if !EXACT
template <int EPI>
__device__ __forceinline__ void ph_gemm_store_f(const Params& p, const AT* A, int lda, const AT* W, int K, int N, AT* O, int ldo, int bid, int nb, char* lds) {
  float* stage = (float*)lds;
  const int nct = (N + 127) / 128;
  const int nitems = NRT * nct;
  for (int item = bid; item < nitems; item += nb) {
    int ct = item % nct, rt = item / nct;
    f32x4 acc[4][4]; acc_zero(acc);
    {
      const int r0 = tidx() >> 2, co = glds_chunk_off();
      const AT* a0 = A + (size_t)(rt * 128 + r0) * lda + co;
      const int n0 = min(ct * 128 + r0, N - 1), n1 = min(ct * 128 + r0 + 64, N - 1);
      gemm_core_g(lds, K / 32, a0, a0 + (size_t)64 * lda, W + (size_t)n0 * K + co, W + (size_t)n1 * K + co, acc);
    }
    acc_to_stage(lds, acc);
    const float sc = (EPI == 1 && ct >= 4 && ct < 8) ? 0.08838834764831845f : 1.f;
    if (EPI == 1 && ct < 8 && rt >= 8) {
      EPI_BEGIN
        int tok = rt * 128 + row, t = (tok - NCTX) & 4095;
        float4 cs = *(const float4*)(p.cs1c + t * 64 + (c4 & 63)), sn = *(const float4*)(p.cs1s + t * 64 + (c4 & 63));
        float4 o = *(const float4*)(stage + row * ST_LD + (c4 ^ 64));
        float4 r;
        if (c4 < 64) { r.x = v.x * cs.x - o.x * sn.x; r.y = v.y * cs.y - o.y * sn.y; r.z = v.z * cs.z - o.z * sn.z; r.w = v.w * cs.w - o.w * sn.w; }
        else { r.x = o.x * sn.x + v.x * cs.x; r.y = o.y * sn.y + v.y * cs.y; r.z = o.z * sn.z + v.z * cs.z; r.w = o.w * sn.w + v.w * cs.w; }
        r.x *= sc; r.y *= sc; r.z *= sc; r.w *= sc;
        st4bf(O + (size_t)tok * ldo + ct * 128 + c4, r);
      EPI_END
    } else {
      EPI_BEGIN
        int col = ct * 128 + c4;
        if (col < N) st4bf(O + (size_t)(rt * 128 + row) * ldo + col, make_float4(v.x * sc, v.y * sc, v.z * sc, v.w * sc));
      EPI_END
    }
  }
}
__device__ __forceinline__ void ph_gemm_resid_f(const Params& p, int l, const AT* A, const AT* W, int rt0, int bid, int nb, char* lds) {
  float* stage = (float*)lds;
  const int nitems = (NRT - rt0) * 8;
  for (int item = bid; item < nitems; item += nb) {
    int ct = item & 7, rt = rt0 + (item >> 3);
    f32x4 acc[4][4]; acc_zero(acc);
    {
      const int r0 = tidx() >> 2, co = glds_chunk_off();
      const AT* a0 = A + (size_t)(rt * 128 + r0) * 1024 + co;
      const AT* b0 = W + (size_t)(ct * 128 + r0) * 1024 + co;
      gemm_core_g(lds, 32, a0, a0 + 64 * 1024, b0, b0 + 64 * 1024, acc);
    }
    acc_to_stage(lds, acc);
    int mr = tok_modrow(rt * 128);
    const float* gm = p.mod + ((size_t)l * 5 + mr) * 6144 + 2 * 1024 + ct * 128;
    EPI_BEGIN
      float* xp = p.X + (size_t)(rt * 128 + row) * 1024 + ct * 128 + c4;
      float4 xv = *(float4*)xp;
      float4 g4 = *(const float4*)(gm + c4);
      xv.x += g4.x * v.x; xv.y += g4.y * v.y; xv.z += g4.z * v.z; xv.w += g4.w * v.w;
      *(float4*)xp = xv;
      const float ssq = half_sum(xv.x * xv.x + xv.y * xv.y + xv.z * xv.z + xv.w * xv.w);
      if ((tidx() & 31) == 0) p.SSQ[(size_t)ct * NTOK + rt * 128 + row] = ssq;
    EPI_END
  }
}
__device__ __forceinline__ void ph_E1_f(const Params& p, int l, int bid, int nb, char* lds) {
  float* stage = (float*)lds;
  int* si = (int*)(lds + MISC_OFF);
  moe_setup(p, l, si);
  const int nblk = si[97];
  for (int item = bid; item < nblk * 8; item += nb) {
    int nt = item & 7, bi = item >> 3;
    int e = 0;
    while (e < 31 && si[65 + e + 1] <= bi) ++e;
    int rb = bi - si[65 + e], cnt = si[e], base = si[32 + e];
    const int* lst = p.list + (size_t)e * NTOK + rb * 128;
    int nrow = cnt - rb * 128; if (nrow > 128) nrow = 128;
    const float* wg = p.w_gate + ((size_t)(l * 32 + e) * 1024) * 512 + nt * 64;
    const float* wu = p.w_up + ((size_t)(l * 32 + e) * 1024) * 512 + nt * 64;
    LdRow<false> la; la.init([&](int r) { return p.H + (size_t)(r < nrow ? (__hip_atomic_load(&lst[r], __ATOMIC_RELAXED, __HIP_MEMORY_SCOPE_AGENT) >> 1) : 0) * 1024; });
    LdColF lb; lb.init(wg, 512, 128);
    { int half = tidx() & 1, n4 = (tidx() >> 1) & 31, ch = tidx() >> 6;
      lb.p = (n4 < 16 ? wg : wu) + (size_t)(ch * 8 + half * 4) * 512 + 4 * (n4 & 15); }
    f32x4 acc[4][4]; acc_zero(acc);
    gemm_core(lds, 32, la, lb, acc);
    acc_to_stage(lds, acc);
    for (int e_ = tidx(); e_ < 128 * 16; e_ += 256) {
      int row = e_ >> 4, c4 = (e_ & 15) << 2;
      if (row < nrow) {
        float4 gv = *(const float4*)(stage + row * ST_LD + c4), uv = *(const float4*)(stage + row * ST_LD + 64 + c4);
        float4 o = make_float4(silu_f(gv.x) * uv.x, silu_f(gv.y) * uv.y, silu_f(gv.z) * uv.z, silu_f(gv.w) * uv.w);
        st4bf(p.HB + (size_t)(base + rb * 128 + row) * 512 + nt * 64 + c4, o);
      }
    }
  }
}
__device__ __forceinline__ void ph_E1_g(const Params& p, int l, int bid, int nb, char* lds) {
  float* stage = (float*)lds;
  int* si = (int*)(lds + MISC_OFF);
  moe_setup(p, l, si);
  const int nblk = si[97];
  for (int item = bid; item < nblk * 8; item += nb) {
    int nt = item & 7, bi = item >> 3;
    int e = 0;
    while (e < 31 && si[65 + e + 1] <= bi) ++e;
    int rb = bi - si[65 + e], cnt = si[e], base = si[32 + e];
    const int* lst = p.list + (size_t)e * NTOK + rb * 128;
    int nrow = cnt - rb * 128; if (nrow > 128) nrow = 128;
    const AT* wgT = p.WM + WM_GATE + ((size_t)(l * 32 + e) * 512 + nt * 64) * 1024;
    const AT* wuT = p.WM + WM_UP + ((size_t)(l * 32 + e) * 512 + nt * 64) * 1024;
    AT* dst = p.HB + (size_t)(base + rb * 128) * 512 + nt * 64;
    const int r0 = tidx() >> 2, co = glds_chunk_off();
    const AT* a0 = p.H + (size_t)(r0 < nrow ? (lst[r0] >> 1) : 0) * 1024 + co;
    const AT* a1 = p.H + (size_t)(r0 + 64 < nrow ? (lst[r0 + 64] >> 1) : 0) * 1024 + co;
    f32x4 acc[4][4]; acc_zero(acc);
    gemm_core_g(lds, 32, a0, a1, wgT + (size_t)r0 * 1024 + co, wuT + (size_t)r0 * 1024 + co, acc);
    acc_to_stage(lds, acc);
    for (int e_ = tidx(); e_ < 128 * 16; e_ += 256) {
      const int row = e_ >> 4, c4 = (e_ & 15) << 2;
      if (row < nrow) {
        const float4 gv = *(const float4*)(stage + row * ST_LD + c4), uv = *(const float4*)(stage + row * ST_LD + 64 + c4);
        st4bf(dst + (size_t)row * 512 + c4, make_float4(silu_fast(gv.x) * uv.x, silu_fast(gv.y) * uv.y, silu_fast(gv.z) * uv.z, silu_fast(gv.w) * uv.w));
      }
    }
  }
}
__device__ __forceinline__ void ph_E2_f(const Params& p, int l, int bid, int nb, char* lds) {
  int* si = (int*)(lds + MISC_OFF);
  moe_setup(p, l, si);
  const int nitems = si[97] * 8;
  const int tid = tidx(), lane = tid & 63, wid = tid >> 6, wr = wid >> 1, wc = wid & 1, fr = lane & 15, fq = lane >> 4;
  int* s_a = (int*)(lds + MISC_OFF + 512);
  char* my = lds + tid * 16;
  const int r0 = tid >> 2, co = glds_chunk_off();
  int ao[4], bo[4];
#pragma unroll
  for (int t = 0; t < 4; ++t) { ao[t] = row_off(wr * 64 + t * 16 + fr, fq); bo[t] = row_off(wc * 64 + t * 16 + fr, fq); }
#define E2_DECODE(IT, CT, NROW, A0, A1, B0, B1, NA) { \
    const int ct_ = (IT) & 7, bi_ = (IT) >> 3; int e_ = 0; \
    while (e_ < 31 && si[65 + e_ + 1] <= bi_) ++e_; \
    const int rb_ = bi_ - si[65 + e_], cnt_ = si[e_], base_ = si[32 + e_]; \
    int nr_ = cnt_ - rb_ * 128; if (nr_ > 128) nr_ = 128; \
    const AT* wd_ = p.WM + WM_DOWN + ((size_t)(l * 32 + e_) * 1024 + ct_ * 128) * 512; \
    const AT* hb_ = p.HB + (size_t)(base_ + rb_ * 128) * 512; \
    CT = ct_; NROW = nr_; \
    A0 = hb_ + (size_t)(r0 < nr_ ? r0 : 0) * 512 + co; A1 = hb_ + (size_t)(r0 + 64 < nr_ ? r0 + 64 : 0) * 512 + co; \
    B0 = wd_ + (size_t)r0 * 512 + co; B1 = wd_ + (size_t)(r0 + 64) * 512 + co; \
    NA = (tid < nr_) ? p.list[(size_t)e_ * NTOK + rb_ * 128 + tid] : 0; }
  int item = bid;
  int ct = 0, nrow = 0, na = 0;
  const AT *a0 = nullptr, *a1 = nullptr, *b0 = nullptr, *b1 = nullptr;
  if (item < nitems) E2_DECODE(item, ct, nrow, a0, a1, b0, b1, na)
  bool primed = false;
  while (item < nitems) {
    __syncthreads();
    if (tid < 128) s_a[tid] = na;
    f32x4 acc[4][4]; acc_zero(acc);
    if (!primed) {
      glds16(a0, my); glds16(a1, my + 4096); glds16(b0, my + 8192); glds16(b1, my + 12288);
      glds16(a0 + 32, my + 16384); glds16(a1 + 32, my + 16384 + 4096); glds16(b0 + 32, my + 16384 + 8192); glds16(b1 + 32, my + 16384 + 12288);
    }
    for (int kt = 0; kt < 14; ++kt) {
      { const int kf = (kt + 2) * 32; char* d = my + ((kt + 2) & 3) * 16384;
        glds16(a0 + kf, d); glds16(a1 + kf, d + 4096); glds16(b0 + kf, d + 8192); glds16(b1 + kf, d + 12288); }
      asm volatile("s_waitcnt vmcnt(8)" ::: "memory");
      __builtin_amdgcn_s_barrier();
      asm volatile("" ::: "memory");
      const char* st = lds + (kt & 3) * 16384;
      mma_step(st, st + 8192, ao, bo, acc);
    }
    {
      asm volatile("s_waitcnt vmcnt(4)" ::: "memory");
      __builtin_amdgcn_s_barrier();
      asm volatile("" ::: "memory");
      const char* st = lds + 2 * 16384;
      mma_step(st, st + 8192, ao, bo, acc);
      asm volatile("s_waitcnt vmcnt(0)" ::: "memory");
      __builtin_amdgcn_s_barrier();
      asm volatile("" ::: "memory");
      st = lds + 3 * 16384;
      mma_step(st, st + 8192, ao, bo, acc);
    }
    __syncthreads();
    const int nxt = item + nb;
    int nct = 0, nnrow = 0, nna = 0;
    const AT *na0 = a0, *na1 = a1, *nb0 = b0, *nb1 = b1;
    primed = nxt < nitems;
    if (primed) {
      E2_DECODE(nxt, nct, nnrow, na0, na1, nb0, nb1, nna)
      glds16(na0, my); glds16(na1, my + 4096); glds16(nb0, my + 8192); glds16(nb1, my + 12288);
      glds16(na0 + 32, my + 16384); glds16(na1 + 32, my + 16384 + 4096); glds16(nb0 + 32, my + 16384 + 8192); glds16(nb1 + 32, my + 16384 + 12288);
    }
    {
      __hip_bfloat16* sb = (__hip_bfloat16*)(lds + 32768);
#pragma unroll
      for (int m = 0; m < 4; ++m)
#pragma unroll
        for (int n = 0; n < 4; ++n)
#pragma unroll
          for (int j = 0; j < 4; ++j) sb[(wr * 64 + m * 16 + fq * 4 + j) * 136 + wc * 64 + n * 16 + fr] = __float2bfloat16(acc[m][n][j]);
    }
    __syncthreads();
#pragma unroll
    for (int i = 0; i < 8; ++i) {
      const int e_ = tid + 256 * i, row = e_ >> 4, ch = e_ & 15;
      if (row < nrow) {
        const u32x4 raw = *(const u32x4*)(lds + 32768 + row * 272 + ch * 16);
        const int a = s_a[row];
        const float w = p.rw[a];
        *(u32x4*)(p.Y + (size_t)a * 1024 + ct * 128 + ch * 8) = scale8(raw, w);
      }
    }
    item = nxt; ct = nct; nrow = nnrow; na = nna; a0 = na0; a1 = na1; b0 = nb0; b1 = nb1;
  }
#undef E2_DECODE
}
__device__ __forceinline__ void ph_M2_f(const Params& p, int l, int bid, int nb, char* lds) {
  const int li = l >> 1;
  float* stage = (float*)lds;
  const AT* wq = p.WB + WB_UQ + (size_t)li * 384 * 1536;
  const AT* wkv = p.WB + WB_UKV + (size_t)li * 256 * 2048;
  const int NQ = NRT * 12, NKV = NRT * 16;
  for (int item = bid; item < NQ + NKV; item += nb) {
    if (item < NQ) {
      int ct = item % 12, rt = item / 12;
      f32x4 acc[4][4]; acc_zero(acc);
      {
        const int r0 = tidx() >> 2, co = glds_chunk_off();
        const AT* a0 = p.PROJ + (size_t)(rt * 128 + r0) * P1LD + co;
        const AT* b0 = wq + (size_t)(ct * 128 + r0) * 384 + co;
        gemm_core_g(lds, 12, a0, a0 + 64 * P1LD, b0, b0 + 64 * 384, acc);
      }
      acc_to_stage(lds, acc);
      EPI_BEGIN
        int tok = rt * 128 + row, col = ct * 128 + c4, head = col / 96, d = col % 96;
        const float rq = 1.f;
        AT* dst = p.Ql + (size_t)tok * QLD + head * 96 + d;
        st4bf(dst, make_float4(v.x * rq, v.y * rq, v.z * rq, v.w * rq));
      EPI_END
    } else {
      int it = item - NQ, h = it & 15, rt = it >> 4;
      f32x4 acc[4][4]; acc_zero(acc);
      {
        const int r0 = tidx() >> 2, co = glds_chunk_off();
        const AT* a0 = p.PROJ + (size_t)(rt * 128 + r0) * P1LD + 384 + co;
        const AT* b0 = wkv + (size_t)(h * 128 + r0) * 256 + co;
        gemm_core_g(lds, 8, a0, a0 + 64 * P1LD, b0, b0 + 64 * 256, acc);
      }
      acc_to_stage(lds, acc);
      EPI_BEGIN
        int tok = rt * 128 + row, b, kpos;
        const float rk = 1.f;
        if (tok < NCTX) { b = tok >> 8; kpos = tok & 255; } else { int tt = tok - NCTX; b = tt >> 12; kpos = CTXL + (tt & 4095); }
        float4 o = make_float4(v.x * rk, v.y * rk, v.z * rk, v.w * rk);
        if (c4 < 64) st4bf(p.Kb + ((size_t)(b * 16 + h) * KVL + kpos) * 96 + c4, o);
        else if (c4 < 96) *(u32x2*)(p.Kb + ((size_t)(b * 16 + h) * KVL + kpos) * 96 + c4) = *(const u32x2*)(p.KR + (size_t)tok * 32 + c4 - 64);
      EPI_END
      {
        int tok0 = rt * 128, b, kp0;
        if (tok0 < NCTX) { b = tok0 >> 8; kp0 = tok0 & 255; } else { int tt = tok0 - NCTX; b = tt >> 12; kp0 = CTXL + (tt & 4095); }
        for (int e_ = tidx(); e_ < 64 * 32; e_ += 256) {
          int dv = e_ >> 5, r4 = (e_ & 31) << 2;
          float x0 = stage[(r4 + 0) * ST_LD + 64 + dv];
          float x1 = stage[(r4 + 1) * ST_LD + 64 + dv];
          float x2 = stage[(r4 + 2) * ST_LD + 64 + dv];
          float x3 = stage[(r4 + 3) * ST_LD + 64 + dv];
          st4bf(p.Vt + ((size_t)(b * 16 + h) * 64 + dv) * KVL + kp0 + r4, make_float4(x0, x1, x2, x3));
        }
      }
    }
  }
}

__device__ __forceinline__ void ph_T2_f(const Params& p, int l, int bid, int nb, char* lds) {
  const int tid = tidx(), lane = tid & 63, wid = tid >> 6, fr = lane & 15, fq = lane >> 4;
  float* rs = (float*)lds + wid * 16;
  const float* g = p.norm_g + (l * 2 + 1) * 1024;
  const unsigned short* Whi = p.WR + (size_t)(l * 2 + 0) * 128 * 48 * 8;
  const unsigned short* Wlo = p.WR + (size_t)(l * 2 + 1) * 128 * 48 * 8;
  const int ibeg = (l == 3) ? NCTX / 16 : 0;
  const int nitem = NTOK / 16;
  for (int item0 = ibeg + bid * 2; item0 < nitem; item0 += nb * 2) {
    const int item = min(item0 + (wid >> 1), nitem - 1);
    const bool live = item0 + (wid >> 1) < nitem;
    const int kh = wid & 1;
    const int tok0 = item * 16;
    const int mr = tok_modrow(tok0);
    const float* md = p.mod + ((size_t)l * 5 + mr) * 6144;
    float rstd;
    {
      float ss = 0.f;
#pragma unroll
      for (int ct = 0; ct < 8; ++ct) ss += p.SSQ[(size_t)ct * NTOK + tok0 + fr];
      rstd = rsqrtf(ss * (1.f / 1024.f) + EPSF);
    }
    const float* xr = p.X + (size_t)(tok0 + fr) * 1024 + fq * 8 + kh * 512;
    AT* hr = p.H + (size_t)(tok0 + fr) * 1024 + fq * 8 + kh * 512;
    f32x4 acc[3];
    acc[0] = (f32x4){0.f, 0.f, 0.f, 0.f}; acc[1] = acc[0]; acc[2] = acc[0];
    fx4 xa = *(const fx4*)(xr), xb = *(const fx4*)(xr + 4);
    const size_t wo0 = ((size_t)(kh * 64 + fq) * 48 + fr) * 8;
    bf16x8 wh0 = *(const bf16x8*)(Whi + wo0), wh1 = *(const bf16x8*)(Whi + wo0 + 128), wh2 = *(const bf16x8*)(Whi + wo0 + 256);
    bf16x8 wl0 = *(const bf16x8*)(Wlo + wo0), wl1 = *(const bf16x8*)(Wlo + wo0 + 128), wl2 = *(const bf16x8*)(Wlo + wo0 + 256);
#pragma unroll 2
    for (int s = 0; s < 16; ++s) {
      const int k0 = kh * 512 + s * 32 + fq * 8;
      const int sn = min(s + 1, 15);
      const fx4 xan = *(const fx4*)(xr + sn * 32), xbn = *(const fx4*)(xr + sn * 32 + 4);
      const size_t won = wo0 + (size_t)sn * 4 * 48 * 8;
      const bf16x8 wh0n = *(const bf16x8*)(Whi + won), wh1n = *(const bf16x8*)(Whi + won + 128), wh2n = *(const bf16x8*)(Whi + won + 256);
      const bf16x8 wl0n = *(const bf16x8*)(Wlo + won), wl1n = *(const bf16x8*)(Wlo + won + 128), wl2n = *(const bf16x8*)(Wlo + won + 256);
      const fx4 g0 = *(const fx4*)(g + k0), g1 = *(const fx4*)(g + k0 + 4);
      const fx4 c0 = *(const fx4*)(md + 4 * 1024 + k0), c1 = *(const fx4*)(md + 4 * 1024 + k0 + 4);
      const fx4 s0 = *(const fx4*)(md + 3 * 1024 + k0), s1 = *(const fx4*)(md + 3 * 1024 + k0 + 4);
      float h[8];
      h[0] = xa.x * rstd * g0.x * (1.f + c0.x) + s0.x; h[1] = xa.y * rstd * g0.y * (1.f + c0.y) + s0.y;
      h[2] = xa.z * rstd * g0.z * (1.f + c0.z) + s0.z; h[3] = xa.w * rstd * g0.w * (1.f + c0.w) + s0.w;
      h[4] = xb.x * rstd * g1.x * (1.f + c1.x) + s1.x; h[5] = xb.y * rstd * g1.y * (1.f + c1.y) + s1.y;
      h[6] = xb.z * rstd * g1.z * (1.f + c1.z) + s1.z; h[7] = xb.w * rstd * g1.w * (1.f + c1.w) + s1.w;
      u32x4 hi;
      hi.x = pk2(h[0], h[1]); hi.y = pk2(h[2], h[3]); hi.z = pk2(h[4], h[5]); hi.w = pk2(h[6], h[7]);
      if (live) *(u32x4*)(hr + s * 32) = hi;
      u32x4 lo;
      lo.x = pk2(h[0] - bf_lo(hi.x), h[1] - bf_hi(hi.x)); lo.y = pk2(h[2] - bf_lo(hi.y), h[3] - bf_hi(hi.y));
      lo.z = pk2(h[4] - bf_lo(hi.z), h[5] - bf_hi(hi.z)); lo.w = pk2(h[6] - bf_lo(hi.w), h[7] - bf_hi(hi.w));
      const bf16x8 ahi = *(bf16x8*)&hi, alo = *(bf16x8*)&lo;
      acc[0] = __builtin_amdgcn_mfma_f32_16x16x32_bf16(ahi, wh0, acc[0], 0, 0, 0);
      acc[0] = __builtin_amdgcn_mfma_f32_16x16x32_bf16(alo, wh0, acc[0], 0, 0, 0);
      acc[0] = __builtin_amdgcn_mfma_f32_16x16x32_bf16(ahi, wl0, acc[0], 0, 0, 0);
      acc[1] = __builtin_amdgcn_mfma_f32_16x16x32_bf16(ahi, wh1, acc[1], 0, 0, 0);
      acc[1] = __builtin_amdgcn_mfma_f32_16x16x32_bf16(alo, wh1, acc[1], 0, 0, 0);
      acc[1] = __builtin_amdgcn_mfma_f32_16x16x32_bf16(ahi, wl1, acc[1], 0, 0, 0);
      acc[2] = __builtin_amdgcn_mfma_f32_16x16x32_bf16(ahi, wh2, acc[2], 0, 0, 0);
      acc[2] = __builtin_amdgcn_mfma_f32_16x16x32_bf16(alo, wh2, acc[2], 0, 0, 0);
      acc[2] = __builtin_amdgcn_mfma_f32_16x16x32_bf16(ahi, wl2, acc[2], 0, 0, 0);
      xa = xan; xb = xbn; wh0 = wh0n; wh1 = wh1n; wh2 = wh2n; wl0 = wl0n; wl1 = wl1n; wl2 = wl2n;
    }
    float* lgp = (float*)(lds + 256) + (wid >> 1) * 16 * 48;
    __syncthreads();
    if (kh == 1) {
#pragma unroll
      for (int t = 0; t < 3; ++t)
#pragma unroll
        for (int j = 0; j < 4; ++j) lgp[(4 * fq + j) * 48 + t * 16 + fr] = acc[t][j];
    }
    __syncthreads();
    if (kh == 0) {
#pragma unroll
      for (int t = 0; t < 3; ++t)
#pragma unroll
        for (int j = 0; j < 4; ++j) lgp[(4 * fq + j) * 48 + t * 16 + fr] += acc[t][j];
    }
    float* lg = lgp;
    if (kh == 0 && live && lane < 16) {
      const float* my = lg + lane * 48;
      const int tok = tok0 + lane;
      const float* gb = p.grp_b + l * 4;
      int gs = 0; float gm = my[0] + gb[0];
      for (int j = 1; j < 4; ++j) { float t = my[j] + gb[j]; if (t > gm) { gm = t; gs = j; } }
      float gsum = 0.f;
      for (int j = 0; j < 4; ++j) gsum += expf(my[j] + gb[j] - gm);
      float gtop = 1.f / gsum;
      const float* wlp = my + 4 + gs * 8;
      const float* eb = p.exp_b + l * 32 + gs * 8;
      int i0 = 0; float m0 = wlp[0] + eb[0];
      for (int j = 1; j < 8; ++j) { float t = wlp[j] + eb[j]; if (t > m0) { m0 = t; i0 = j; } }
      int i1 = -1; float m1 = -3.4e38f;
      for (int j = 0; j < 8; ++j) { float t = wlp[j] + eb[j]; if (j != i0 && t > m1) { m1 = t; i1 = j; } }
      float e1 = expf(m1 - m0);
      float p0 = 1.f / (1.f + e1), p1 = e1 / (1.f + e1);
      p.re[tok * 2] = gs * 8 + i0; p.re[tok * 2 + 1] = gs * 8 + i1;
      p.rw[tok * 2] = gtop * p0; p.rw[tok * 2 + 1] = gtop * p1;
    }
  }
}

constexpr int NSEG = 272;
template <class LB>
__device__ __forceinline__ void gemm_core_Alds(char* lds, const char* abuf, int nk, LB& lb, f32x4 (&acc)[4][4]) {
  const int lane = tidx() & 63, wid = tidx() >> 6, wr = wid >> 1, wc = wid & 1, fr = lane & 15, fq = lane >> 4;
  int ao[4], bo[4];
#pragma unroll
  for (int t = 0; t < 4; ++t) { ao[t] = frag_off<false>(wr * 64, t, fr, fq); bo[t] = frag_off<LB::COL>(wc * 64, t, fr, fq); }
  lb.template fetch<0>(0); lb.template fetch<1>(1);
  __syncthreads();
  lb.template commit<0>(lds + FBUF_B0, 0); lb.template commit<1>(lds + FBUF_B0 + 8192, 1);
  __syncthreads();
  for (int kt = 0; kt < nk; kt += 2) {
    const int cur = (kt & 2) << 13;
    const bool more = kt + 2 < nk;
    if (more) { const int k0 = kt + 2; lb.template fetch<0>(k0); lb.template fetch<1>(k0 + 1); }
    mma_step(abuf + kt * 8192, lds + FBUF_B0 + cur, ao, bo, acc);
    mma_step(abuf + (kt + 1) * 8192, lds + FBUF_B0 + cur + 8192, ao, bo, acc);
    if (more) { const int nxt = cur ^ 16384; lb.template commit<0>(lds + FBUF_B0 + nxt, kt + 2); lb.template commit<1>(lds + FBUF_B0 + nxt + 8192, kt + 3); }
    __syncthreads();
  }
}
constexpr float LOG2E = 1.4426950408889634f;

template <bool FIN>
__device__ __forceinline__ void lru_local_f(const Params& p, int li, int b, int c, int kb, char* lds) {
  const int tid = tidx(), lane = tid & 63, wid = tid >> 6, fr = lane & 15, fq = lane >> 4;
  char* Ub = lds;
  char* Wb = lds + 16384;
  const int tok0 = chunk_tok0(b, c);
  const int seqbase = c < 2 ? b * CTXL : NCTX + b * SEQ;
  const int n = c < 2 ? CTXL : SEQ;
  const int t0 = tok0 - seqbase;
  __syncthreads();
#pragma unroll
  for (int i = 0; i < 4; ++i) {
    const int e = tid + 256 * i, pos = e >> 3, c8 = e & 7, ch0 = kb * 64 + c8 * 8, t = t0 + pos;
    float a[8];
    { fx4 b0 = *(const fx4*)(p.conv_b + li * 512 + ch0), b1 = *(const fx4*)(p.conv_b + li * 512 + ch0 + 4);
      a[0] = b0.x; a[1] = b0.y; a[2] = b0.z; a[3] = b0.w; a[4] = b1.x; a[5] = b1.y; a[6] = b1.z; a[7] = b1.w; }
#pragma unroll
    for (int tap = 0; tap < 4; ++tap) {
      const int tt = t + tap - 2;
      if (tt >= 0 && tt < n) {
        const u32x4 x = *(const u32x4*)(p.PROJ + (size_t)(seqbase + tt) * 3072 + 2048 + ch0);
        const float* w = p.conv_w + (li * 4 + tap) * 512 + ch0;
        const fx4 w0 = *(const fx4*)w, w1 = *(const fx4*)(w + 4);
        a[0] = fmaf(w0.x, bf_lo(x.x), a[0]); a[1] = fmaf(w0.y, bf_hi(x.x), a[1]); a[2] = fmaf(w0.z, bf_lo(x.y), a[2]); a[3] = fmaf(w0.w, bf_hi(x.y), a[3]);
        a[4] = fmaf(w1.x, bf_lo(x.z), a[4]); a[5] = fmaf(w1.y, bf_hi(x.z), a[5]); a[6] = fmaf(w1.z, bf_lo(x.w), a[6]); a[7] = fmaf(w1.w, bf_hi(x.w), a[7]);
      }
    }
    u32x4 o; o.x = pk2(a[0], a[1]); o.y = pk2(a[2], a[3]); o.z = pk2(a[4], a[5]); o.w = pk2(a[6], a[7]);
    *(u32x4*)(Ub + (c8 >> 2) * 8192 + row_off(pos, c8 & 3)) = o;
  }
  {
    const int half = tid & 1, n4 = (tid >> 1) & 31, ch = tid >> 6;
#pragma unroll
    for (int kt = 0; kt < 2; ++kt)
#pragma unroll
      for (int nh = 0; nh < 2; ++nh) {
        const int ncol = nh * 128 + 4 * n4, dg = ncol >> 6, j = ncol & 63, d = dg >> 1, g = dg & 1;
        const float* src = p.gate_w + ((size_t)(((li * 2 + d) * 2 + g) * 8 + kb) * 64 + (kt * 32 + ch * 8 + half * 4)) * 64 + j;
        const fx4 w0 = *(const fx4*)src, w1 = *(const fx4*)(src + 64), w2 = *(const fx4*)(src + 128), w3 = *(const fx4*)(src + 192);
        char* base = Wb + kt * 16384 + (ch * 256 + nh * 128) * 16 + half * 8;
        const int pe = col_perm(4 * n4) * 16;
        u32x2 tv;
        tv.x = pk2(w0.x, w1.x); tv.y = pk2(w2.x, w3.x); *(u32x2*)(base + pe) = tv;
        tv.x = pk2(w0.y, w1.y); tv.y = pk2(w2.y, w3.y); *(u32x2*)(base + (pe ^ 64) + 256) = tv;
        tv.x = pk2(w0.z, w1.z); tv.y = pk2(w2.z, w3.z); *(u32x2*)(base + pe + 128) = tv;
        tv.x = pk2(w0.w, w1.w); tv.y = pk2(w2.w, w3.w); *(u32x2*)(base + (pe ^ 64) + 384) = tv;
      }
  }
  __syncthreads();
  const int sbase = (c < 2 ? c * 8 : 16 + (c - 2) * 8) + wid * 2;
  __hip_bfloat16* ot = (__hip_bfloat16*)(lds + 49152);
#pragma unroll 1
  for (int d = 0; d < 2; ++d) {
    f32x4 acc[2][8];
#pragma unroll
    for (int m = 0; m < 2; ++m)
#pragma unroll
      for (int nn = 0; nn < 8; ++nn) acc[m][nn] = (f32x4){0.f, 0.f, 0.f, 0.f};
#pragma unroll
    for (int kt = 0; kt < 2; ++kt) {
      bf16x8 af0 = *(const bf16x8*)(Ub + kt * 8192 + row_off(wid * 32 + fr, fq));
      bf16x8 af1 = *(const bf16x8*)(Ub + kt * 8192 + row_off(wid * 32 + 16 + fr, fq));
#pragma unroll
      for (int nn = 0; nn < 8; ++nn) {
        bf16x8 bfv = *(const bf16x8*)(Wb + kt * 16384 + (fq * 256 + d * 128 + col_perm(nn * 16 + fr)) * 16);
        acc[0][nn] = __builtin_amdgcn_mfma_f32_16x16x32_bf16(af0, bfv, acc[0][nn], 0, 0, 0);
        acc[1][nn] = __builtin_amdgcn_mfma_f32_16x16x32_bf16(af1, bfv, acc[1][nn], 0, 0, 0);
      }
    }
#pragma unroll
    for (int q4 = 0; q4 < 4; ++q4) {
      const int chl = q4 * 16 + fr, ch = kb * 64 + chl;
      const float sp = softplus_f(-p.lam[(li * 2 + d) * 512 + ch]);
      const float br = p.gate_b[((li * 2 + d) * 2 + 0) * 512 + ch], bi = p.gate_b[((li * 2 + d) * 2 + 1) * 512 + ch];
#pragma unroll
      for (int mt = 0; mt < 2; ++mt) {
        float hv[4], Av[4], av[4], bv[4];
        float h = 0.f, A = 1.f;
#pragma unroll
        for (int s4 = 0; s4 < 4; ++s4) {
          const int jj = d ? 3 - s4 : s4;
          const int pos = wid * 32 + mt * 16 + fq * 4 + jj;
          const float r = __builtin_amdgcn_rcpf(1.f + __builtin_amdgcn_exp2f(-LOG2E * ((d ? acc[mt][q4][3 - s4] : acc[mt][q4][s4]) + br)));
          const float ig = __builtin_amdgcn_rcpf(1.f + __builtin_amdgcn_exp2f(-LOG2E * ((d ? acc[mt][4 + q4][3 - s4] : acc[mt][4 + q4][s4]) + bi)));
          const float uval = __bfloat162float(*(const __hip_bfloat16*)(Ub + (chl >> 5) * 8192 + row_off(pos, (chl & 31) >> 3) + (chl & 7) * 2));
          const float a = __builtin_amdgcn_exp2f(-8.f * LOG2E * r * sp);
          const float bt = __builtin_amdgcn_sqrtf(fmaxf(1.f - a * a, 0.f)) * (ig * uval);
          h = fmaf(a, h, bt); A *= a;
          if (d) { hv[3 - s4] = h; Av[3 - s4] = A; av[3 - s4] = a; bv[3 - s4] = bt; } else { hv[s4] = h; Av[s4] = A; av[s4] = a; bv[s4] = bt; }
        }
        float Ai = A, Hi = h;
#pragma unroll
        for (int st = 16; st <= 32; st <<= 1) {
          float Ao = d ? __shfl_down(Ai, st) : __shfl_up(Ai, st);
          float Ho = d ? __shfl_down(Hi, st) : __shfl_up(Hi, st);
          const bool has = d ? (fq + (st >> 4) <= 3) : (fq >= (st >> 4));
          if (has) { Hi = fmaf(Ai, Ho, Hi); Ai = Ai * Ao; }
        }
        float Ae = d ? __shfl_down(Ai, 16) : __shfl_up(Ai, 16);
        float He = d ? __shfl_down(Hi, 16) : __shfl_up(Hi, 16);
        const bool first = d ? (fq == 3) : (fq == 0);
        if (first) { Ae = 1.f; He = 0.f; }
        if (!FIN) {
          const bool last = d ? (fq == 0) : (fq == 3);
          if (last) {
            const size_t so = ((size_t)(d * 4 + b) * NSEG + sbase + mt) * 512 + ch;
            p.CHA[so] = Ai; p.CHH[so] = Hi;
          }
        } else {
          const float cin = p.CAR[((size_t)(d * 4 + b) * NSEG + sbase + mt) * 512 + ch];
          float hst = fmaf(Ae, cin, He);
#pragma unroll
          for (int s4 = 0; s4 < 4; ++s4) {
            hst = d ? fmaf(av[3 - s4], hst, bv[3 - s4]) : fmaf(av[s4], hst, bv[s4]);
            const int jj = d ? 3 - s4 : s4;
            const int pos = wid * 32 + mt * 16 + fq * 4 + jj;
            if (d == 0) ot[pos * 64 + chl] = __float2bfloat16(hst);
            else ot[pos * 64 + chl] = __float2bfloat16(__bfloat162float(ot[pos * 64 + chl]) + hst);
          }
        }
        (void)hv; (void)Av;
        __builtin_amdgcn_sched_barrier(0);
      }
    }
  }
  if (FIN) {
    __syncthreads();
    {
      const int row = tid >> 1, half = tid & 1;
      const u32x4* srcv = (const u32x4*)(ot + row * 64 + half * 32);
      const u32x4* yv = (const u32x4*)(p.PROJ + (size_t)(tok0 + row) * 3072 + 2560 + kb * 64 + half * 32);
      u32x4* dstv = (u32x4*)(p.MIX + (size_t)(tok0 + row) * 1024 + 512 + kb * 64 + half * 32);
#pragma unroll
      for (int q = 0; q < 4; ++q) {
        const u32x4 hh = srcv[q], yy = yv[q];
        u32x4 o;
        o.x = pk2(bf_lo(hh.x) * gelu_tanh_fast(bf_lo(yy.x)), bf_hi(hh.x) * gelu_tanh_fast(bf_hi(yy.x)));
        o.y = pk2(bf_lo(hh.y) * gelu_tanh_fast(bf_lo(yy.y)), bf_hi(hh.y) * gelu_tanh_fast(bf_hi(yy.y)));
        o.z = pk2(bf_lo(hh.z) * gelu_tanh_fast(bf_lo(yy.z)), bf_hi(hh.z) * gelu_tanh_fast(bf_hi(yy.z)));
        o.w = pk2(bf_lo(hh.w) * gelu_tanh_fast(bf_lo(yy.w)), bf_hi(hh.w) * gelu_tanh_fast(bf_hi(yy.w)));
        dstv[q] = o;
      }
    }
  }
}

__device__ __forceinline__ void ph_R1_f(const Params& p, int l, int bid, int nb, char* lds) {
  const int li = l >> 1;
  float* stage = (float*)lds;
  const int NRET = NBAT * 4 * NCH;
  const int NLRU = NBAT * NCH * 8;
  for (int item = bid; item < NRET + NLRU; item += nb) {
    if (item < NRET) {
      int c = item % NCH, bh = item / NCH, h = bh & 3, b = bh >> 2;
      const AT* base = p.PROJ + (size_t)chunk_tok0(b, c) * 3072 + h * 128;
#pragma unroll
      for (int d = 0; d < 2; ++d) {
        const float lg2 = -softplus_f(-p.ret_decay[(li * 2 + d) * 4 + h]) * LOG2E;
        f32x4 acc[4][4]; acc_zero(acc);
        LdColH<0> la; la.init(base + 1024, 3072, 0.f);
        if (d == 0) { LdColH<1> lb; lb.init(base + 512, 3072, lg2); gemm_core<LdColH<0>, LdColH<1>, 0, false>(lds, 4, la, lb, acc); }
        else        { LdColH<2> lb; lb.init(base + 512, 3072, lg2); gemm_core<LdColH<0>, LdColH<2>, 0, false>(lds, 4, la, lb, acc); }
        acc_to_stage(lds, acc);
        float* U = p.U + ((size_t)((b * 4 + h) * 2 + d) * NCH + c) * 16384;
        EPI_BEGIN
          *(float4*)(U + row * 128 + c4) = v;
        EPI_END
      }
    } else {
      int it = item - NRET;
      int kb = it & 7, c = (it >> 3) % NCH, b = it / (8 * NCH);
      lru_local_f<false>(p, li, b, c, kb, lds);
    }
  }
}
__device__ __forceinline__ void ph_R2_f(const Params& p, int l, int bid, int nb) {
  const int li = l >> 1;
  const bool lru_blk = bid >= nb - 16;
  int gtid = (lru_blk ? bid - (nb - 16) : bid) * 256 + tidx(), gsz = (lru_blk ? 16 : nb - 16) * 256;
  if (lru_blk)
  for (int i = gtid; i < 2 * 4 * 512; i += gsz) {
    int ch = i & 511, db = i >> 9, d = db >> 2;
    float carry = 0.f;
    const size_t base = (size_t)db * NSEG * 512 + ch;
#pragma unroll 16
    for (int idx = 0; idx < NSEG; ++idx) {
      int sg = d == 0 ? idx : (idx < 16 ? 15 - idx : NSEG + 15 - idx);
      size_t o = base + (size_t)sg * 512;
      p.CAR[o] = carry;
      carry = fmaf(p.CHA[o], carry, p.CHH[o]);
    }
  }
  if (!lru_blk)
  for (int i = gtid; i < 32 * 16384; i += gsz) {
    int el = i & 16383, bhd = i >> 14, d = bhd & 1, h = (bhd >> 1) & 3;
    float lg = -softplus_f(-p.ret_decay[(li * 2 + d) * 4 + h]);
    float dec = expf(lg * 128.f);
    const float* base = p.U + (size_t)bhd * NCH * 16384 + el;
    AT* sb = p.SB + (size_t)bhd * NCH * 16384 + el;
    float S = 0.f;
#pragma unroll 17
    for (int idx = 0; idx < NCH; ++idx) {
      int c = d == 0 ? idx : (idx < 2 ? 1 - idx : 35 - idx);
      float u = base[(size_t)c * 16384];
      sb[(size_t)c * 16384] = __float2bfloat16(S);
      S = fmaf(dec, S, u);
    }
  }
}
__device__ __forceinline__ void ph_R3_f(const Params& p, int l, int bid, int nb, char* lds) {
  const int li = l >> 1;
  float* stage = (float*)lds;
  const int lane = tidx() & 63, wid = tidx() >> 6, wr = wid >> 1, wc = wid & 1, fr = lane & 15, fq = lane >> 4;
  const int NRET = NBAT * 4 * NCH;
  char* Pb = lds;
  for (int item = bid; item < NRET + NBAT * NCH * 8; item += nb) {
    if (item < NRET) {
      int c = item % NCH, bh = item / NCH, h = bh & 3, b = bh >> 2;
      const int tok0 = chunk_tok0(b, c);
      const AT* base = p.PROJ + (size_t)tok0 * 3072 + h * 128;
      const float l0 = -softplus_f(-p.ret_decay[(li * 2 + 0) * 4 + h]) * LOG2E;
      const float l1 = -softplus_f(-p.ret_decay[(li * 2 + 1) * 4 + h]) * LOG2E;
      f32x4 acc[4][4]; acc_zero(acc);
      const int r0 = tidx() >> 2, co = glds_chunk_off();
      {
        const AT* k0 = base + 512 + (size_t)r0 * 3072 + co;
        const AT* q0 = base + (size_t)r0 * 3072 + co;
        gemm_core_g(lds, 4, k0, k0 + (size_t)64 * 3072, q0, q0 + (size_t)64 * 3072, acc);
      }
      float l0o = l0, l1o = l1;
      asm volatile("" : "+v"(l0o), "+v"(l1o));
#pragma unroll
      for (int mt = 0; mt < 4; ++mt)
#pragma unroll
        for (int nt = 0; nt < 4; ++nt) {
          const int m0 = wr * 64 + mt * 16 + fq * 4, j = wc * 64 + nt * 16 + fr;
          float pv[4];
#pragma unroll
          for (int q = 0; q < 4; ++q) {
            const int m = m0 + q;
            const int dd = j - m; const float ee = __builtin_amdgcn_exp2f((dd > 0 ? l0o : l1o) * (float)(dd > 0 ? dd : -dd)); const float M = dd == 0 ? 2.f : ee;
            pv[q] = acc[mt][nt][q] * M;
          }
          u32x2 o; o.x = pk2(pv[0], pv[1]); o.y = pk2(pv[2], pv[3]);
          *(u32x2*)(Pb + (m0 >> 5) * 8192 + row_off(j, (m0 & 31) >> 3) + (m0 & 7) * 2) = o;
        }
      acc_zero(acc);
      { LdColH<0> lb; lb.init(base + 1024, 3072, 0.f); gemm_core_Alds(lds, Pb, 4, lb, acc); }
#pragma unroll 1
      for (int d = 0; d < 2; ++d) {
        const float lx = d ? l1 : l0;
#pragma unroll
        for (int i = 0; i < 8; ++i) {
          const int idx = tidx() + 256 * i, row = idx >> 4, c16 = idx & 15;
          const u32x4 qv = *(const u32x4*)(base + (size_t)row * 3072 + c16 * 8);
          const float xi = __builtin_amdgcn_exp2f(lx * (float)(d ? 128 - row : row + 1));
          *(u32x4*)(Pb + (c16 >> 2) * 8192 + row_off(row, c16 & 3)) = scale8(qv, xi);
        }
        const AT* sb = p.SB + ((size_t)((b * 4 + h) * 2 + d) * NCH + c) * 16384;
        LdRow<false> lb; lb.init([&](int r) { return sb + (size_t)r * 128; });
        gemm_core_Alds(lds, Pb, 4, lb, acc);
      }
      acc_to_stage(lds, acc);
      EPI_BEGIN
        float ss = v.x * v.x + v.y * v.y + v.z * v.z + v.w * v.w;
        ss = half_sum(ss);
        float rs = rsqrtf(ss * (1.f / 128.f) + EPSF);
        int tok = tok0 + row;
        const u32x2 gg = *(const u32x2*)(p.PROJ + (size_t)tok * 3072 + 1536 + h * 128 + c4);
        float4 o = make_float4(v.x * rs * silu_fast(bf_lo(gg.x)), v.y * rs * silu_fast(bf_hi(gg.x)), v.z * rs * silu_fast(bf_lo(gg.y)), v.w * rs * silu_fast(bf_hi(gg.y)));
        st4bf(p.MIX + (size_t)tok * 1024 + h * 128 + c4, o);
      EPI_END
    } else {
      int it = item - NRET;
      int kb = it & 7, c = (it >> 3) % NCH, b = it / (8 * NCH);
      lru_local_f<true>(p, li, b, c, kb, lds);
    }
  }
}

constexpr int KROW = 240;
constexpr int VROW = 144;
constexpr int KT_BYTES = 64 * KROW;
constexpr int VT_BYTES = 64 * VROW;
__device__ __forceinline__ void ph_ATT_f(const Params& p, int l, int bid, int nb, char* lds) {
  const int tid = tidx(), lane = tid & 63, wid = tid >> 6, fr = lane & 15, fq = lane >> 4;
  char* Kl = lds;
  char* Vl = lds + 2 * KT_BYTES;
  int ko0, ko1, ko2, vo0, vo1, vg0, vg1;
  { int e = tid;       ko0 = (e / 12) * KROW + (e % 12) * 16; vo0 = (e >> 3) * VROW + (e & 7) * 16; vg0 = (e >> 3) * KVL + (e & 7) * 8;
    e = tid + 256;     ko1 = (e / 12) * KROW + (e % 12) * 16; vo1 = (e >> 3) * VROW + (e & 7) * 16; vg1 = (e >> 3) * KVL + (e & 7) * 8;
    e = tid + 512;     ko2 = (e / 12) * KROW + (e % 12) * 16; }
  const float qscale = 0.10206207261596577f * 1.4426950408889634f;
  const int NLAT = NBAT * 16 * 32, NCT = (l == 1) ? NBAT * 16 * 2 : 0;
  const int xq = bid / (nb >> 3);
  unsigned* qc = p.bar + 3456 + (((l >> 1) * 16 + xq) * 16);
  int* qs = (int*)(lds + MISC_OFF);
  const int per_lat = NLAT / 8, per_ct = NCT / 8;
  if (tid == 0) qs[0] = (int)xb_add(qc, 1u);
  __syncthreads();
  int qidx = qs[0];
  while (qidx < per_lat + per_ct) {
    const bool lat = qidx < per_lat;
    const int item = lat ? xq * per_lat + qidx : NLAT + xq * per_ct + (qidx - per_lat);
    int qnext = 0;
    if (tid == 0) qnext = (int)xb_add(qc, 1u);
    int qb, bh, ntile;
    if (lat) { qb = item & 31; bh = item >> 5; ntile = KVL / 64; } else { int it = item - NLAT; qb = it & 1; bh = it >> 1; ntile = CTXL / 64; }
    const int b = bh >> 4, h = bh & 15;
    const int q0 = qb * 128 + wid * 32;
    const AT* Qbase = p.Ql + (size_t)(lat ? NCTX + b * SEQ + q0 : b * CTXL + q0) * QLD + h * 96;
    bf16x8 qf[2][3];
#pragma unroll
    for (int qt = 0; qt < 2; ++qt)
#pragma unroll
      for (int s = 0; s < 3; ++s) {
        u32x4 raw = *(const u32x4*)(Qbase + (size_t)(qt * 16 + fr) * QLD + s * 32 + fq * 8);
        float f[8] = {bf_lo(raw.x), bf_hi(raw.x), bf_lo(raw.y), bf_hi(raw.y), bf_lo(raw.z), bf_hi(raw.z), bf_lo(raw.w), bf_hi(raw.w)};
        if (s == 2) {
          u32x4 oth;
          oth.x = __shfl_xor(raw.x, 32); oth.y = __shfl_xor(raw.y, 32); oth.z = __shfl_xor(raw.z, 32); oth.w = __shfl_xor(raw.w, 32);
          if (lat) {
            float g[8] = {bf_lo(oth.x), bf_hi(oth.x), bf_lo(oth.y), bf_hi(oth.y), bf_lo(oth.z), bf_hi(oth.z), bf_lo(oth.w), bf_hi(oth.w)};
            int fro = lane;
            asm volatile("" : "+v"(fro));
            const int t = (q0 + qt * 16 + (fro & 15)) * 16 + 8 * ((fro >> 4) & 1);
            const float* cp = p.cs2c + t;
            const float* sp = p.cs2s + t;
#pragma unroll
            for (int j = 0; j < 8; ++j) {
              float cs = cp[j], sn = sp[j];
              f[j] = (fq < 2) ? (f[j] * cs - g[j] * sn) : (g[j] * sn + f[j] * cs);
            }
          }
        }
        u32x4 o;
        o.x = pk2(f[0] * qscale, f[1] * qscale); o.y = pk2(f[2] * qscale, f[3] * qscale);
        o.z = pk2(f[4] * qscale, f[5] * qscale); o.w = pk2(f[6] * qscale, f[7] * qscale);
        qf[qt][s] = *(bf16x8*)&o;
      }
    float mrun[2] = {0.f, 0.f};
    f32x4 al[2] = {(f32x4){0.f, 0.f, 0.f, 0.f}, (f32x4){0.f, 0.f, 0.f, 0.f}};
    f32x4 ao[4][2];
#pragma unroll
    for (int dt = 0; dt < 4; ++dt) { ao[dt][0] = (f32x4){0.f, 0.f, 0.f, 0.f}; ao[dt][1] = (f32x4){0.f, 0.f, 0.f, 0.f}; }
    const char* Kg = (const char*)(p.Kb + (size_t)bh * KVL * 96);
    const AT* Vg = p.Vt + (size_t)bh * 64 * KVL;
    u32x4 kr0, kr1, kr2, vr0, vr1;
    kr0 = *(const u32x4*)(Kg + tid * 16); kr1 = *(const u32x4*)(Kg + (tid + 256) * 16); kr2 = *(const u32x4*)(Kg + (tid + 512) * 16);
    vr0 = *(const u32x4*)(Vg + vg0); vr1 = *(const u32x4*)(Vg + vg1);
    __syncthreads();
    *(u32x4*)(Kl + ko0) = kr0; *(u32x4*)(Kl + ko1) = kr1; *(u32x4*)(Kl + ko2) = kr2;
    *(u32x4*)(Vl + vo0) = vr0; *(u32x4*)(Vl + vo1) = vr1;
    __syncthreads();
    {
      const int t1 = min(1, ntile - 1);
      const char* kg = Kg + (size_t)t1 * 12288;
      kr0 = *(const u32x4*)(kg + tid * 16); kr1 = *(const u32x4*)(kg + (tid + 256) * 16); kr2 = *(const u32x4*)(kg + (tid + 512) * 16);
      vr0 = *(const u32x4*)(Vg + vg0 + t1 * 64); vr1 = *(const u32x4*)(Vg + vg1 + t1 * 64);
    }
    bf16x8 kf[2][4];
    {
      const char* kb = Kl + fr * KROW + fq * 16;
#pragma unroll
      for (int s = 0; s < 2; ++s)
#pragma unroll
        for (int k4 = 0; k4 < 4; ++k4) kf[s][k4] = *(const bf16x8*)(kb + k4 * 16 * KROW + s * 64);
    }
    auto tile_iter = [&](const int t, u32x4& xk0, u32x4& xk1, u32x4& xk2, u32x4& xv0, u32x4& xv1) __attribute__((always_inline)) {
      const int cur = t & 1;
      f32x4 as[4][2];
      {
        const f32x4 n0 = {-mrun[0], -mrun[0], -mrun[0], -mrun[0]}, n1 = {-mrun[1], -mrun[1], -mrun[1], -mrun[1]};
        const char* kb2 = Kl + cur * KT_BYTES + fr * KROW + fq * 16 + 128;
#pragma unroll
        for (int k4 = 0; k4 < 4; ++k4) {
          as[k4][0] = __builtin_amdgcn_mfma_f32_16x16x32_bf16(kf[0][k4], qf[0][0], n0, 0, 0, 0);
          as[k4][1] = __builtin_amdgcn_mfma_f32_16x16x32_bf16(kf[0][k4], qf[1][0], n1, 0, 0, 0);
        }
        __builtin_amdgcn_sched_barrier(0);
#pragma unroll
        for (int k4 = 0; k4 < 4; ++k4) kf[0][k4] = *(const bf16x8*)(kb2 + k4 * 16 * KROW);
        __builtin_amdgcn_sched_barrier(0);
#pragma unroll
        for (int k4 = 0; k4 < 4; ++k4) {
          as[k4][0] = __builtin_amdgcn_mfma_f32_16x16x32_bf16(kf[1][k4], qf[0][1], as[k4][0], 0, 0, 0);
          as[k4][1] = __builtin_amdgcn_mfma_f32_16x16x32_bf16(kf[1][k4], qf[1][1], as[k4][1], 0, 0, 0);
        }
#pragma unroll
        for (int k4 = 0; k4 < 4; ++k4) {
          as[k4][0] = __builtin_amdgcn_mfma_f32_16x16x32_bf16(kf[0][k4], qf[0][2], as[k4][0], 0, 0, 0);
          as[k4][1] = __builtin_amdgcn_mfma_f32_16x16x32_bf16(kf[0][k4], qf[1][2], as[k4][1], 0, 0, 0);
        }
      }
      __builtin_amdgcn_sched_barrier(0);
      bf16x8 vf[2][4];
      {
        const char* vb = Vl + cur * VT_BYTES + fr * VROW + fq * 8;
#pragma unroll
        for (int ks = 0; ks < 2; ++ks)
#pragma unroll
          for (int dt = 0; dt < 4; ++dt) {
            if (ks == 1 && dt >= 2) continue;
            u32x2 lo = *(const u32x2*)(vb + dt * 16 * VROW + ks * 64);
            u32x2 hi = *(const u32x2*)(vb + dt * 16 * VROW + ks * 64 + 32);
            u32x4 a4 = {lo.x, lo.y, hi.x, hi.y};
            vf[ks][dt] = *(bf16x8*)&a4;
          }
      }
      __builtin_amdgcn_sched_barrier(0);
      bf16x8 pf[2][2];
#pragma unroll
      for (int qt = 0; qt < 2; ++qt) {
        float mx = as[0][qt][0];
#pragma unroll
        for (int k4 = 0; k4 < 4; ++k4)
#pragma unroll
          for (int j = 0; j < 4; ++j) mx = fmaxf(mx, as[k4][qt][j]);
        if (t == 0 || __builtin_amdgcn_ballot_w64(mx > 8.f) != 0ull) {
          mx = fmaxf(mx, __shfl_xor(mx, 16));
          mx = fmaxf(mx, __shfl_xor(mx, 32));
          const float dl = (t == 0) ? mx : fmaxf(mx, 0.f);
          const float alpha = (t == 0) ? 1.f : __builtin_amdgcn_exp2f(-dl);
          mrun[qt] += dl;
          al[qt][0] *= alpha; al[qt][1] *= alpha; al[qt][2] *= alpha; al[qt][3] *= alpha;
#pragma unroll
          for (int dt = 0; dt < 4; ++dt) { ao[dt][qt][0] *= alpha; ao[dt][qt][1] *= alpha; ao[dt][qt][2] *= alpha; ao[dt][qt][3] *= alpha; }
#pragma unroll
          for (int k4 = 0; k4 < 4; ++k4) { as[k4][qt][0] -= dl; as[k4][qt][1] -= dl; as[k4][qt][2] -= dl; as[k4][qt][3] -= dl; }
        }
        float pv[4][4];
#pragma unroll
        for (int k4 = 0; k4 < 4; ++k4)
#pragma unroll
          for (int j = 0; j < 4; ++j) pv[k4][j] = __builtin_amdgcn_exp2f(as[k4][qt][j]);
#pragma unroll
        for (int ks = 0; ks < 2; ++ks) {
          u32x4 o;
          o.x = pk2(pv[2 * ks][0], pv[2 * ks][1]); o.y = pk2(pv[2 * ks][2], pv[2 * ks][3]);
          o.z = pk2(pv[2 * ks + 1][0], pv[2 * ks + 1][1]); o.w = pk2(pv[2 * ks + 1][2], pv[2 * ks + 1][3]);
          pf[qt][ks] = *(bf16x8*)&o;
        }
      }
      __builtin_amdgcn_sched_barrier(0);
      {
        const char* vb = Vl + cur * VT_BYTES + fr * VROW + fq * 8;
#pragma unroll
        for (int dt = 2; dt < 4; ++dt) {
          u32x2 lo = *(const u32x2*)(vb + dt * 16 * VROW + 64);
          u32x2 hi = *(const u32x2*)(vb + dt * 16 * VROW + 64 + 32);
          u32x4 a4 = {lo.x, lo.y, hi.x, hi.y};
          vf[1][dt] = *(bf16x8*)&a4;
        }
      }
      {
        char* kd = Kl + (cur ^ 1) * KT_BYTES; char* vd = Vl + (cur ^ 1) * VT_BYTES;
        *(u32x4*)(kd + ko0) = xk0; *(u32x4*)(kd + ko1) = xk1; *(u32x4*)(kd + ko2) = xk2;
        *(u32x4*)(vd + vo0) = xv0; *(u32x4*)(vd + vo1) = xv1;
        const int t3 = min(t + 2, ntile - 1);
        const char* kg = Kg + (size_t)t3 * 12288;
        xk0 = *(const u32x4*)(kg + tid * 16); xk1 = *(const u32x4*)(kg + (tid + 256) * 16); xk2 = *(const u32x4*)(kg + (tid + 512) * 16);
        xv0 = *(const u32x4*)(Vg + vg0 + t3 * 64); xv1 = *(const u32x4*)(Vg + vg1 + t3 * 64);
      }
      const u32x4 o4 = {0x3f803f80u, 0x3f803f80u, 0x3f803f80u, 0x3f803f80u};
      const bf16x8 ones = *(const bf16x8*)&o4;
#pragma unroll
      for (int dt = 0; dt < 4; ++dt) {
        ao[dt][0] = __builtin_amdgcn_mfma_f32_16x16x32_bf16(vf[0][dt], pf[0][0], ao[dt][0], 0, 0, 0);
        ao[dt][1] = __builtin_amdgcn_mfma_f32_16x16x32_bf16(vf[0][dt], pf[1][0], ao[dt][1], 0, 0, 0);
      }
      al[0] = __builtin_amdgcn_mfma_f32_16x16x32_bf16(ones, pf[0][0], al[0], 0, 0, 0);
      al[1] = __builtin_amdgcn_mfma_f32_16x16x32_bf16(ones, pf[1][0], al[1], 0, 0, 0);
      __builtin_amdgcn_sched_barrier(0);
      __syncthreads();
      {
        const char* kb = Kl + (cur ^ 1) * KT_BYTES + fr * KROW + fq * 16;
#pragma unroll
        for (int s = 0; s < 2; ++s)
#pragma unroll
          for (int k4 = 0; k4 < 4; ++k4) kf[s][k4] = *(const bf16x8*)(kb + k4 * 16 * KROW + s * 64);
      }
      __builtin_amdgcn_sched_barrier(0);
#pragma unroll
      for (int dt = 0; dt < 4; ++dt) {
        ao[dt][0] = __builtin_amdgcn_mfma_f32_16x16x32_bf16(vf[1][dt], pf[0][1], ao[dt][0], 0, 0, 0);
        ao[dt][1] = __builtin_amdgcn_mfma_f32_16x16x32_bf16(vf[1][dt], pf[1][1], ao[dt][1], 0, 0, 0);
      }
      al[0] = __builtin_amdgcn_mfma_f32_16x16x32_bf16(ones, pf[0][1], al[0], 0, 0, 0);
      al[1] = __builtin_amdgcn_mfma_f32_16x16x32_bf16(ones, pf[1][1], al[1], 0, 0, 0);
    };
    for (int t = 0; t < ntile; t += 2) {
      tile_iter(t, kr0, kr1, kr2, vr0, vr1);
      tile_iter(t + 1, kr0, kr1, kr2, vr0, vr1);
    }
#pragma unroll
    for (int qt = 0; qt < 2; ++qt) {
      const float inv = 1.f / al[qt][0];
      const int r = q0 + qt * 16 + fr;
      const int tok = lat ? NCTX + b * SEQ + r : b * CTXL + r;
      AT* dst = p.MIX + (size_t)tok * 1024 + h * 64 + 4 * fq;
#pragma unroll
      for (int dt = 0; dt < 4; ++dt) {
        u32x2 o; o.x = pk2(ao[dt][qt][0] * inv, ao[dt][qt][1] * inv); o.y = pk2(ao[dt][qt][2] * inv, ao[dt][qt][3] * inv);
        *(u32x2*)(dst + dt * 16) = o;
      }
    }
    __syncthreads();
    if (tid == 0) qs[0] = qnext;
    __syncthreads();
    qidx = qs[0];
  }
}
#endif

enum { PH_ADA1 = 0, PH_ADA2, PH_T1, PH_G1E, PH_R1, PH_R2, PH_R3, PH_G2E, PH_T2, PH_E1, PH_E2, PH_M1, PH_MN, PH_M2, PH_ATT, PH_M4, PH_FINAL, PH_RB };

#if EXACT
#define T1_CALL ph_T1(p, l, bid, nb);
#define FINAL_CALL ph_final(p, bid, nb);
#define T2_CALL ph_T2(p, l, bid, nb, lds);
#define R1_CALL ph_R1(p, l, bid, nb, lds);
#define R2_CALL ph_R2(p, l, bid, nb);
#define R3_CALL ph_R3(p, l, bid, nb, lds);
#define ATT_CALL ph_ATT(p, l, bid, nb, lds);
#define G1E_CALL ph_gemm_store(p, p.H, 1024, p.ab_w_in + (size_t)li * 1024 * 3072, 1024, 3072, p.PROJ, 3072, 0, bid, nb, lds);
#define G2E_CALL ph_gemm_resid(p, l, p.MIX, p.ab_w_out + (size_t)li * 1024 * 1024, 0, bid, nb, lds);
#define E1_CALL ph_E1(p, l, bid, nb, lds);
#define E2_CALL ph_E2(p, l, bid, nb, lds);
#define M1_CALL ph_gemm_store(p, p.H, 1024, p.mla_w_in + (size_t)li * 1024 * 672, 1024, 672, p.PROJ, P1LD, 0, bid, nb, lds);
#define M2_CALL ph_M2(p, l, bid, nb, lds);
#define M4_CALL ph_gemm_resid(p, l, p.MIX, p.mla_w_out + (size_t)li * 1024 * 1024, (l == 3) ? 8 : 0, bid, nb, lds);
#else
#define T1_CALL ph_T1_f(p, l, bid, nb);
#define FINAL_CALL ph_final_f(p, bid, nb);
#define T2_CALL ph_T2_f(p, l, bid, nb, lds);
#define R1_CALL ph_R1_f(p, l, bid, nb, lds);
#define R2_CALL ph_R2_f(p, l, bid, nb);
#define R3_CALL ph_R3_f(p, l, bid, nb, lds);
#define ATT_CALL ph_ATT_f(p, l, bid, nb, lds);
#define G1E_CALL ph_gemm_store_f<1>(p, p.H, 1024, p.WB + WB_ABIN + (size_t)li * 1024 * 3072, 1024, 3072, p.PROJ, 3072, bid, nb, lds);
#define G2E_CALL ph_gemm_resid_f(p, l, p.MIX, p.WB + WB_ABOUT + (size_t)li * 1024 * 1024, 0, bid, nb, lds);
#if E1_FAST == 2
#define E1_CALL ph_E1_g(p, l, bid, nb, lds);
#elif E1_FAST
#define E1_CALL ph_E1_f(p, l, bid, nb, lds);
#else
#define E1_CALL ph_E1(p, l, bid, nb, lds);
#endif
#define E2_CALL ph_E2_f(p, l, bid, nb, lds);
#define M1_CALL ph_gemm_store_f<0>(p, p.H, 1024, p.WB + WB_MIN + (size_t)li * 1024 * 672, 1024, 672, p.PROJ, P1LD, bid, nb, lds);
#define M2_CALL ph_M2_f(p, l, bid, nb, lds);
#define M4_CALL ph_gemm_resid_f(p, l, p.MIX, p.WB + WB_MOUT + (size_t)li * 1024 * 1024, (l == 3) ? 8 : 0, bid, nb, lds);
#endif
__device__ __forceinline__ void run_phase(const Params& p, int ph, int l, int bid, int nb, char* lds) {
  const int li = l >> 1;
  switch (ph) {
    case PH_ADA1: if constexpr (((PHMASK) >> PH_ADA1) & 1) { ph_ada1(p, bid, nb, lds);
#if !EXACT
      conv_dense_weights(p, bid, nb, lds);
      conv_moe_weights(p, bid, nb, lds);
#endif
    } break;
    case PH_ADA2: if constexpr (((PHMASK) >> PH_ADA2) & 1) { ph_ada2(p, bid, nb); } break;
    case PH_T1: if constexpr (((PHMASK) >> PH_T1) & 1) { T1_CALL } break;
    case PH_G1E: if constexpr (((PHMASK) >> PH_G1E) & 1) { G1E_CALL } break;
    case PH_R1: if constexpr (((PHMASK) >> PH_R1) & 1) { R1_CALL } break;
    case PH_R2: if constexpr (((PHMASK) >> PH_R2) & 1) { R2_CALL } break;
    case PH_R3: if constexpr (((PHMASK) >> PH_R3) & 1) { R3_CALL } break;
    case PH_G2E: if constexpr (((PHMASK) >> PH_G2E) & 1) { G2E_CALL } break;
    case PH_T2: if constexpr (((PHMASK) >> PH_T2) & 1) { T2_CALL } break;
    case PH_E1: if constexpr (((PHMASK) >> PH_E1) & 1) { E1_CALL } break;
    case PH_E2: if constexpr (((PHMASK) >> PH_E2) & 1) { E2_CALL } break;
    case PH_M1: if constexpr (((PHMASK) >> PH_M1) & 1) { M1_CALL } break;
    case PH_MN: if constexpr (((PHMASK) >> PH_MN) & 1) { ph_MN(p, l, bid, nb); } break;
    case PH_M2: if constexpr (((PHMASK) >> PH_M2) & 1) { M2_CALL } break;
    case PH_ATT: if constexpr (((PHMASK) >> PH_ATT) & 1) { ATT_CALL } break;
    case PH_M4: if constexpr (((PHMASK) >> PH_M4) & 1) { M4_CALL } break;
    case PH_FINAL: if constexpr (((PHMASK) >> PH_FINAL) & 1) { FINAL_CALL } break;
    case PH_RB: if constexpr (((PHMASK) >> PH_RB) & 1) { ph_RB(p, l, bid, nb, lds); } break;
  }
}

constexpr int NPHASE = 43;
__host__ __device__ __forceinline__ void decode_phase(int i, int& ph, int& l) {
  if (i == 0) { ph = PH_ADA1; l = 0; return; }
  if (i == 1) { ph = PH_ADA2; l = 0; return; }
  if (i == NPHASE - 1) { ph = PH_FINAL; l = 0; return; }
  int j = i - 2; l = j / 10; int s = j % 10;
  bool even = (l & 1) == 0;
  if (s == 0) ph = PH_T1;
  else if (s == 1) ph = even ? PH_G1E : PH_M1;
  else if (s == 2) ph = even ? PH_R1 : PH_MN;
  else if (s == 3) ph = even ? PH_R2 : PH_M2;
  else if (s == 4) ph = even ? PH_R3 : PH_ATT;
  else if (s == 5) ph = even ? PH_G2E : PH_M4;
  else if (s == 6) ph = PH_T2;
  else if (s == 7) ph = PH_RB;
  else if (s == 8) ph = PH_E1;
  else ph = PH_E2;
}

#if !MEGA
__global__ void __launch_bounds__(256 LB2) k_phase(Params p, int ph, int l) {
  __shared__ __attribute__((aligned(16))) char smem[LDS_BYTES];
  run_phase(p, ph, l, blockIdx.x, gridDim.x, smem);
}
#else
__global__ void __launch_bounds__(256 LB2) k_mega(Params p) {
  __shared__ __attribute__((aligned(16))) char smem[LDS_BYTES];
  volatile LAS unsigned* st = (volatile LAS unsigned*)(smem + MISC_OFF + 496);
  if (tidx() == 0) { st[0] = 0u; st[1] = 0u; st[2] = 0u; st[3] = 0u; }
  __syncthreads();
  XcdBarrier xb = xcd_barrier_post(p.bar, st);
  const int nb = gridDim.x;
  const int bid = blockIdx.x;
  const int vbid = (nb & 7) == 0 ? (int)(blockIdx.x & 7) * (nb >> 3) + (int)(blockIdx.x >> 3) : (int)blockIdx.x;
#ifndef XCDMASK
#define XCDMASK (1<<PH_ATT)
#endif
#ifndef HALFMASK
#define HALFMASK 0
#endif
#ifndef DUPMASK
#define DUPMASK 0
#endif
#define RUNP(PH, L) { run_phase(p, PH, L, (((XCDMASK) >> (PH)) & 1) ? vbid : bid, nb, smem); xcd_barrier(xb); if (((DUPMASK) >> (PH)) & 1) { run_phase(p, PH, L, bid, nb, smem); xcd_barrier(xb); } }
  RUNP(PH_ADA1, 0) RUNP(PH_ADA2, 0)
#pragma unroll 1
  for (int l = 0; l < 4; ++l) {
    RUNP(PH_T1, l)
    if ((l & 1) == 0) { RUNP(PH_G1E, l) RUNP(PH_R1, l) RUNP(PH_R2, l) RUNP(PH_R3, l) RUNP(PH_G2E, l) }
    else { RUNP(PH_M1, l) RUNP(PH_MN, l) RUNP(PH_M2, l) RUNP(PH_ATT, l) RUNP(PH_M4, l) }
    RUNP(PH_T2, l) RUNP(PH_RB, l) RUNP(PH_E1, l) RUNP(PH_E2, l)
  }
  run_phase(p, PH_FINAL, 0, bid, nb, smem);
}

#endif
static inline size_t al256(size_t x) { return (x + 255) & ~(size_t)255; }

extern "C" void kernel_launch(void* const* d_in, const int* in_sizes, int n_in, void* d_out, int out_size, void* d_ws, size_t ws_size, hipStream_t stream) {
  (void)in_sizes; (void)n_in; (void)out_size;
  Params p; memset(&p, 0, sizeof(p));
  const float** ins = (const float**)&p;
  for (int i = 0; i < 29; ++i) ins[i] = (const float*)d_in[i];
  p.out = (float*)d_out;
  char* w = (char*)d_ws; size_t off = 0;
  auto take = [&](size_t bytes) { char* r = w + off; off = al256(off + bytes); return r; };
  const size_t ZERO_BYTES = 16384;
  p.bar = (unsigned*)take(16384); p.cnt = (int*)take(4 * 32 * 32 * 4);
  p.mod = (float*)take((size_t)4 * 5 * 6144 * 4);
  p.modp = (float*)take((size_t)4 * 8 * 5 * 6144 * 4);
  p.cs1c = (float*)take(4096 * 64 * 4); p.cs1s = (float*)take(4096 * 64 * 4);
  p.cs2c = (float*)take(4096 * 16 * 4); p.cs2s = (float*)take(4096 * 16 * 4);
  p.re = (int*)take((size_t)NTOK * 2 * 4); p.rw = (float*)take((size_t)NTOK * 2 * 4);
  p.list = (int*)take((size_t)32 * NTOK * 4);
  p.RQ = (float*)take((size_t)NTOK * 4); p.RKV = (float*)take((size_t)NTOK * 4);
  p.KR = (AT*)take((size_t)NTOK * 32 * sizeof(AT));
  p.WB = (AT*)take(WB_TOTAL * sizeof(AT));
#if !EXACT
  p.WM = (AT*)take((size_t)3 * 128 * 1024 * 512 * sizeof(AT));
#endif
  p.SSQ = (float*)take((size_t)8 * NTOK * 4);
  p.WR = (unsigned short*)take((size_t)4 * 2 * 128 * 48 * 8 * 2);
  p.CHA = (float*)take((size_t)2 * 4 * 272 * 512 * 4); p.CHH = (float*)take((size_t)2 * 4 * 272 * 512 * 4); p.CAR = (float*)take((size_t)2 * 4 * 272 * 512 * 4);
  p.X = (float*)take((size_t)NTOK * 1024 * 4);
  p.H = (AT*)take((size_t)NTOK * 1024 * sizeof(AT));
  p.PROJ = (AT*)take((size_t)NTOK * 3072 * sizeof(AT));
  p.MIX = (AT*)take((size_t)NTOK * 1024 * sizeof(AT));
  p.Y = (AT*)take((size_t)NTOK * 2 * 1024 * sizeof(AT));
  size_t reg0 = off;
  p.U = (float*)take((size_t)32 * NCH * 16384 * 4);
  p.HL = (float*)take((size_t)2 * NTOK * 512 * 4);
  p.SB = (AT*)p.HL;
  p.AC = (float*)take((size_t)2 * NTOK * 512 * 4);
#if EXACT
  p.SCR = (float*)take((size_t)1024 * 16384 * 4);
#endif
  size_t hb_off = off;
  p.HB = (AT*)take((size_t)(NTOK * 2) * 512 * sizeof(AT));
#if EXACT
  p.HU = (AT*)take((size_t)(NTOK * 2) * 512 * sizeof(AT));
#endif
  size_t reg_end = off;
  off = reg0;
  p.Ql = (AT*)take((size_t)NTOK * QLD * sizeof(AT));
  p.Qc = p.Ql;
  p.Kb = (AT*)take((size_t)NBAT * 16 * KVL * 96 * sizeof(AT));
  p.Vb = (AT*)take((size_t)NBAT * 16 * KVL * 64 * sizeof(AT));
  p.Vt = p.Vb;
  if (off > reg_end) reg_end = off;
  (void)hb_off;
  if (reg_end > ws_size) { fprintf(stderr, "workspace too small: need %zu have %zu\n", reg_end, ws_size); return; }

  (void)hipMemsetAsync(d_ws, 0, ZERO_BYTES, stream);
#if MEGA
  static int grid_blocks = 0;
  if (!grid_blocks) {
    int dev = 0, cus = 0, per_cu = 0;
    hipGetDevice(&dev);
    hipDeviceGetAttribute(&cus, hipDeviceAttributeMultiprocessorCount, dev);
    hipOccupancyMaxActiveBlocksPerMultiprocessor(&per_cu, k_mega, 256, 0);
    if (per_cu > 2) per_cu = 2;
    if (per_cu < 1) per_cu = 1;
    grid_blocks = cus * per_cu;
  }
  void* args[] = {&p};
  hipError_t e = hipLaunchCooperativeKernel((void*)k_mega, dim3(grid_blocks), dim3(256), args, 0, stream);
  if (e != hipSuccess) fprintf(stderr, "cooperative launch failed: %s (grid %d)\n", hipGetErrorString(e), grid_blocks);
#else
  for (int i = 0; i < NPHASE; ++i) { int ph, l; decode_phase(i, ph, l); k_phase<<<1024, 256, 0, stream>>>(p, ph, l); }
#endif
}
```
